# Optimizing an MI355X kernel written in HIP

```python
import jax, jax.numpy as jnp
from jax import lax
import numpy as np

D_MODEL = 2048
BATCH = 2
SEQ = 4096
DEPTH = 1

MLA_HEADS = 8
MLA_Q_RANK = 512
MLA_KV_RANK = 256
MLA_NOPE = 128
MLA_ROPE = 64
MLA_V = 128
ROPE_THETA = 10000.0
Q_BLOCK = 128
GLA_HEADS = 4
GLA_DK = D_MODEL // 2 // GLA_HEADS
GLA_DV = D_MODEL // GLA_HEADS
GLA_GATE_RANK = 16
GLA_TAU = 16.0
GLA_CHUNK = 64
D_FF = 5632
CONV_WIDTH = 3
EPS = 1e-6

IN_SIZES = (MLA_Q_RANK, MLA_KV_RANK, MLA_ROPE,
            GLA_HEADS * GLA_DK, GLA_HEADS * GLA_DK, GLA_HEADS * GLA_DV,
            GLA_GATE_RANK, GLA_HEADS * GLA_DV,
            D_MODEL, D_MODEL)
IN_OFFSETS = tuple(int(v) for v in np.cumsum(IN_SIZES)[:-1])
D_IN = int(sum(IN_SIZES))

kernel_name = 'hybrid_mla_gla_convffn_block'


def rmsnorm(x, w):
    x32 = x.astype(jnp.float32)
    y = x32 * lax.rsqrt(jnp.mean(x32 * x32, axis=-1, keepdims=True) + EPS)
    return (y * w.astype(jnp.float32)).astype(x.dtype)


def rope_tables(positions):
    inv = 1.0 / (ROPE_THETA ** (jnp.arange(0, MLA_ROPE, 2, dtype=jnp.float32) / MLA_ROPE))
    ang = positions.astype(jnp.float32)[..., None] * inv
    return jnp.cos(ang), jnp.sin(ang)


def apply_rope(x, cos, sin):
    x32 = x.astype(jnp.float32)
    x1, x2 = jnp.split(x32, 2, axis=-1)
    out = jnp.concatenate([x1 * cos - x2 * sin, x2 * cos + x1 * sin], axis=-1)
    return out.astype(x.dtype)


def mla_branch(q_lat, kv_lat, k_rope, positions, g_q, w_q_up, g_kv, w_kv_up):
    B, S, _ = q_lat.shape
    q = (rmsnorm(q_lat, g_q) @ w_q_up).reshape(B, S, MLA_HEADS, MLA_NOPE + MLA_ROPE)
    kv = (rmsnorm(kv_lat, g_kv) @ w_kv_up).reshape(B, S, MLA_HEADS, MLA_NOPE + MLA_V)
    q_nope, q_pe = q[..., :MLA_NOPE], q[..., MLA_NOPE:]
    k_nope, v = kv[..., :MLA_NOPE], kv[..., MLA_NOPE:]
    cos, sin = rope_tables(positions)
    q_pe = apply_rope(q_pe, cos[:, :, None, :], sin[:, :, None, :])
    k_pe = apply_rope(k_rope, cos, sin)
    scale = (MLA_NOPE + MLA_ROPE) ** -0.5
    nb = S // Q_BLOCK
    key_idx = jnp.arange(S)

    def blocks(t):
        return jnp.moveaxis(t.reshape((B, nb, Q_BLOCK) + t.shape[2:]), 1, 0)

    def attend(args):
        qn, qp, start = args
        s = (jnp.einsum('bqhd,bkhd->bhqk', qn, k_nope).astype(jnp.float32)
             + jnp.einsum('bqhr,bkr->bhqk', qp, k_pe).astype(jnp.float32)) * scale
        q_idx = start + jnp.arange(Q_BLOCK)
        mask = key_idx[None, :] <= q_idx[:, None]
        s = jnp.where(mask, s, -jnp.inf)
        p = jax.nn.softmax(s, axis=-1).astype(v.dtype)
        return jnp.einsum('bhqk,bkhd->bqhd', p, v)

    starts = jnp.arange(nb) * Q_BLOCK
    o = lax.map(attend, (blocks(q_nope), blocks(q_pe), starts))
    return jnp.moveaxis(o, 0, 1).reshape(B, S, MLA_HEADS * MLA_V)


def gla_branch(q, k, v, gate_lr, out_gate, w_gate_up, b_gate, g_out):
    B, S, _ = q.shape
    dtype = q.dtype
    nc = S // GLA_CHUNK
    log_a = jax.nn.log_sigmoid((gate_lr @ w_gate_up + b_gate).astype(jnp.float32)) / GLA_TAU

    def heads(t, d):
        return t.reshape(B, nc, GLA_CHUNK, GLA_HEADS, d).transpose(1, 0, 3, 2, 4).astype(jnp.float32)

    qc = heads(q * (GLA_DK ** -0.5), GLA_DK)
    kc = heads(k, GLA_DK)
    vc = heads(v, GLA_DV)
    gc = heads(log_a, GLA_DK)
    causal = jnp.tril(jnp.ones((GLA_CHUNK, GLA_CHUNK), dtype=bool))[:, :, None]

    def step(state, inp):
        qi, ki, vi, gi = inp
        b = jnp.cumsum(gi, axis=-2)
        inter = jnp.einsum('bhcd,bhde->bhce', qi * jnp.exp(b), state)
        diff = b[:, :, :, None, :] - b[:, :, None, :, :]
        decay = jnp.where(causal, jnp.exp(jnp.where(causal, diff, 0.0)), 0.0)
        attn = jnp.einsum('bhid,bhjd,bhijd->bhij', qi, ki, decay)
        intra = jnp.einsum('bhij,bhje->bhie', attn, vi)
        b_last = b[:, :, -1:, :]
        state = (jnp.exp(b_last[:, :, 0, :])[..., None] * state
                 + jnp.einsum('bhcd,bhce->bhde', ki * jnp.exp(b_last - b), vi))
        return state, inter + intra

    s0 = jnp.zeros((B, GLA_HEADS, GLA_DK, GLA_DV), jnp.float32)
    _, o = lax.scan(step, s0, (qc, kc, vc, gc))
    o = o.transpose(1, 0, 3, 2, 4).reshape(B, S, GLA_HEADS, GLA_DV)
    o = rmsnorm(o, g_out).reshape(B, S, GLA_HEADS * GLA_DV).astype(dtype)
    return o * jax.nn.silu(out_gate)


def conv_ffn(h, w_up, conv_w, conv_b, w_down):
    S = h.shape[1]
    u = h @ w_up
    up = jnp.pad(u, ((0, 0), (CONV_WIDTH - 1, 0), (0, 0)))
    acc = up[:, 0:S] * conv_w[0]
    for i in range(1, CONV_WIDTH):
        acc = acc + up[:, i:i + S] * conv_w[i]
    acc = acc + conv_b
    a, val = jnp.split(acc, 2, axis=-1)
    return (jax.nn.gelu(a, approximate=True) * val) @ w_down


def setup_inputs(seed: int = 0) -> dict:
    key = jax.random.key(seed)
    ks = jax.random.split(key, 24)

    def dense(k, shape):
        return jax.random.normal(k, (DEPTH,) + shape, jnp.float32) * (shape[0] ** -0.5)

    def gain(k, n):
        return 1.0 + 0.02 * jax.random.normal(k, (DEPTH, n), jnp.float32)

    def bias(k, n):
        return 0.01 * jax.random.normal(k, (DEPTH, n), jnp.float32)

    return {
        'x': jax.random.normal(ks[0], (BATCH, SEQ, D_MODEL), jnp.float32),
        'c': jax.random.normal(ks[1], (BATCH, D_MODEL), jnp.float32),
        'positions': jnp.broadcast_to(jnp.arange(SEQ, dtype=jnp.int32), (BATCH, SEQ)),
        'w_ada': dense(ks[2], (D_MODEL, 6 * D_MODEL)),
        'b_ada': bias(ks[3], 6 * D_MODEL),
        'g_pre_mix': gain(ks[4], D_MODEL),
        'w_in': dense(ks[5], (D_MODEL, D_IN)),
        'g_q_lat': gain(ks[6], MLA_Q_RANK),
        'w_q_up': dense(ks[7], (MLA_Q_RANK, MLA_HEADS * (MLA_NOPE + MLA_ROPE))),
        'g_kv_lat': gain(ks[8], MLA_KV_RANK),
        'w_kv_up': dense(ks[9], (MLA_KV_RANK, MLA_HEADS * (MLA_NOPE + MLA_V))),
        'w_gla_gate_up': dense(ks[10], (GLA_GATE_RANK, GLA_HEADS * GLA_DK)),
        'b_gla_gate': bias(ks[11], GLA_HEADS * GLA_DK),
        'g_gla_out': gain(ks[12], GLA_DV),
        'w_branch_a': dense(ks[13], (MLA_HEADS * MLA_V, D_MODEL)),
        'w_branch_b': dense(ks[14], (GLA_HEADS * GLA_DV, D_MODEL)),
        'w_mix_out': dense(ks[15], (D_MODEL, D_MODEL)),
        'g_post_mix': gain(ks[16], D_MODEL),
        'g_pre_ffn': gain(ks[17], D_MODEL),
        'w_ffn_up': dense(ks[18], (D_MODEL, 2 * D_FF)),
        'conv_w': jax.random.normal(ks[19], (DEPTH, CONV_WIDTH, 2 * D_FF), jnp.float32) * (CONV_WIDTH ** -0.5),
        'conv_b': bias(ks[20], 2 * D_FF),
        'w_ffn_down': dense(ks[21], (D_FF, D_MODEL)),
        'g_post_ffn': gain(ks[22], D_MODEL),
    }


def reference(x, c, positions, w_ada, b_ada, g_pre_mix, w_in, g_q_lat, w_q_up, g_kv_lat,
              w_kv_up, w_gla_gate_up, b_gla_gate, g_gla_out, w_branch_a, w_branch_b,
              w_mix_out, g_post_mix, g_pre_ffn, w_ffn_up, conv_w, conv_b, w_ffn_down,
              g_post_ffn):
    c_act = jax.nn.silu(c)
    for l in range(DEPTH):
        mod = (c_act @ w_ada[l] + b_ada[l])[:, None, :]
        shift_m, scale_m, gate_m, shift_f, scale_f, gate_f = jnp.split(mod, 6, axis=-1)

        h = rmsnorm(x, g_pre_mix[l]) * (1 + scale_m) + shift_m
        z = h @ w_in[l]
        (q_lat, kv_lat, k_rope, gq, gk, gv, g_lr, g_og, gate_a, gate_b) = jnp.split(z, IN_OFFSETS, axis=-1)
        y_a = mla_branch(q_lat, kv_lat, k_rope, positions, g_q_lat[l], w_q_up[l],
                         g_kv_lat[l], w_kv_up[l]) @ w_branch_a[l]
        y_b = gla_branch(gq, gk, gv, g_lr, g_og, w_gla_gate_up[l], b_gla_gate[l],
                         g_gla_out[l]) @ w_branch_b[l]
        merged = jax.nn.sigmoid(gate_a) * y_a + jax.nn.sigmoid(gate_b) * y_b
        y = merged @ w_mix_out[l]
        x = x + gate_m * rmsnorm(y, g_post_mix[l])

        h = rmsnorm(x, g_pre_ffn[l]) * (1 + scale_f) + shift_f
        f = conv_ffn(h, w_ffn_up[l], conv_w[l], conv_b[l], w_ffn_down[l])
        x = x + gate_f * rmsnorm(f, g_post_ffn[l])
    return x
```

```cpp
#include <hip/hip_runtime.h>
#include <hip/hip_bf16.h>
#include <cstdint>
#include <cstdio>

typedef unsigned short bf16_t;
constexpr int NB = 2, SEQ = 4096, DM = 2048, MTOK = NB * SEQ;
constexpr int DIN = 11088, LDZ = 11264;
constexpr int OFF_QLAT = 0, OFF_KVLAT = 512, OFF_KROPE = 768, OFF_GQ = 832, OFF_GK = 1856, OFF_GV = 2880, OFF_GLR = 4928, OFF_GOG = 4944, OFF_GA = 6992, OFF_GB = 9040;
constexpr int DFF = 5632, DFF2 = 11264;
constexpr float EPSN = 1e-6f;
constexpr float QK_C2 = 0.07216878364870322f * 1.4426950408889634f;
constexpr size_t MiB = 1u << 20;
constexpr size_t WS_CTL = 0, WS_MOD = 1 * MiB, WS_RSTD = 1 * MiB + 512 * 1024, WS_CS = 2 * MiB, WS_PART = 4 * MiB;
constexpr size_t WS_WQ = 8 * MiB, WS_WKV = 10 * MiB, WS_WA = 12 * MiB, WS_WB = 16 * MiB, WS_WMIX = 24 * MiB;
constexpr size_t WS_WIN = 32 * MiB, WS_Z = 76 * MiB, WS_H = 252 * MiB, WS_Q = 284 * MiB, WS_K = 308 * MiB, WS_V = 332 * MiB, WS_OM = 348 * MiB, WS_OG = 364 * MiB, WS_MISC = 396 * MiB;
constexpr size_t WS_MERGED = WS_WIN, WS_Y = WS_Z, WS_ACT_N = 284 * MiB  , WS_UQ = 196 * MiB  , WS_F = 196 * MiB, WS_T1 = WS_H;

__device__ __forceinline__ float bf2f(bf16_t v) { return __uint_as_float(((unsigned)v) << 16); }
__device__ __forceinline__ bf16_t f2bf(float f) { unsigned u = __float_as_uint(f); return (bf16_t)((u + 0x7fffu + ((u >> 16) & 1u)) >> 16); }
__device__ __forceinline__ float sigmoidf_(float x) { return 1.f / (1.f + __expf(-x)); }
__device__ __forceinline__ float siluf_(float x) { return x / (1.f + __expf(-x)); }
__device__ __forceinline__ float gelu_tanh(float a) { const float u = 0.7978845608028654f * (a + 0.044715f * a * a * a); return 0.5f * a * (1.f + tanhf(u)); }
__device__ __forceinline__ int rope_pos(int d) { return d < 32 ? (8 * (d >> 2) + (d & 3)) : (8 * ((d - 32) >> 2) + 4 + (d & 3)); }

__device__ __forceinline__ float block_sum256(float v, float* red) {
#pragma unroll
    for (int o = 32; o > 0; o >>= 1) v += __shfl_xor(v, o);
    __syncthreads();
    if ((threadIdx.x & 63) == 0) red[threadIdx.x >> 6] = v;
    __syncthreads();
    return red[0] + red[1] + red[2] + red[3];
}

__global__ void __launch_bounds__(256) n_mod(const float* c, const float* w_ada, const float* b_ada, float* mod) {
    __shared__ float ca[2][DM];
    for (int i = threadIdx.x; i < 2 * DM; i += 256) ca[i / DM][i % DM] = siluf_(c[i]);
    __syncthreads();
    const int j = blockIdx.x * 256 + threadIdx.x;
    float a0 = b_ada[j], a1 = a0;
    for (int k = 0; k < DM; ++k) { const float w = w_ada[(size_t)k * 12288 + j]; a0 += ca[0][k] * w; a1 += ca[1][k] * w; }
    mod[j] = a0; mod[12288 + j] = a1;
}
__global__ void __launch_bounds__(256) n_cs(const int* pos, float2* cs) {
    const int idx = blockIdx.x * 256 + threadIdx.x; const int m = idx >> 5, i = idx & 31;
    const float inv = 1.0f / powf(10000.0f, (float)(2 * i) / 64.0f);
    const float ang = (float)pos[m] * inv;
    float s, c; sincosf(ang, &s, &c); cs[idx] = make_float2(c, s);
}
__global__ void __launch_bounds__(256) n_normmod(const float* x, const float* g, const float* mod, int off_shift, int off_scale, bf16_t* h) {
    __shared__ float red[4];
    const int m = blockIdx.x, b = m / SEQ; const float* xr = x + (size_t)m * DM;
    float v[8], s = 0.f;
#pragma unroll
    for (int i = 0; i < 8; ++i) { v[i] = xr[threadIdx.x + i * 256]; s += v[i] * v[i]; }
    const float rstd = rsqrtf(block_sum256(s, red) / DM + EPSN);
#pragma unroll
    for (int i = 0; i < 8; ++i) { const int k = threadIdx.x + i * 256;
        h[(size_t)m * DM + k] = f2bf(v[i] * rstd * g[k] * (1.f + mod[b * 12288 + off_scale + k]) + mod[b * 12288 + off_shift + k]); }
}
template <class Epi>
__global__ void __launch_bounds__(256) n_gemm(const bf16_t* A, int lda, const float* W, int ldw, const float* ks, int M0, int M1, int N, int K, Epi epi) {
    __shared__ float As[16][68]; __shared__ float Ws[16][68];
    const int tx = threadIdx.x & 15, ty = threadIdx.x >> 4;
    const int m0 = M0 + blockIdx.y * 64, n0 = blockIdx.x * 64;
    float acc[4][4];
#pragma unroll
    for (int i = 0; i < 4; ++i)
#pragma unroll
        for (int j = 0; j < 4; ++j) acc[i][j] = 0.f;
    for (int k0 = 0; k0 < K; k0 += 16) {
#pragma unroll
        for (int i = 0; i < 4; ++i) { const int e = threadIdx.x + i * 256, r = e >> 4, kk = e & 15, m = m0 + r;
            float a = (m < M1) ? bf2f(A[(size_t)m * lda + k0 + kk]) : 0.f; if (ks) a *= ks[k0 + kk]; As[kk][r] = a; }
#pragma unroll
        for (int i = 0; i < 4; ++i) { const int e = threadIdx.x + i * 256, kk = e >> 6, cc = e & 63, n = n0 + cc;
            Ws[kk][cc] = (n < N) ? W[(size_t)(k0 + kk) * ldw + n] : 0.f; }
        __syncthreads();
#pragma unroll
        for (int kk = 0; kk < 16; ++kk) {
            float a[4], b[4];
#pragma unroll
            for (int i = 0; i < 4; ++i) { a[i] = As[kk][ty * 4 + i]; b[i] = Ws[kk][tx * 4 + i]; }
#pragma unroll
            for (int i = 0; i < 4; ++i)
#pragma unroll
                for (int j = 0; j < 4; ++j) acc[i][j] += a[i] * b[j];
        }
        __syncthreads();
    }
#pragma unroll
    for (int i = 0; i < 4; ++i)
#pragma unroll
        for (int j = 0; j < 4; ++j) { const int m = m0 + ty * 4 + i, n = n0 + tx * 4 + j; if (m < M1 && n < N) epi(m, n, acc[i][j]); }
}
struct EpiStore { bf16_t* C; int ldc; int row_off; __device__ void operator()(int m, int n, float v) const { C[(size_t)(m - row_off) * ldc + n] = f2bf(v); } };
struct EpiQ { bf16_t* Q; const float* rstd; __device__ void operator()(int m, int n, float v) const { Q[(size_t)m * 1536 + n] = f2bf(v * rstd[m]); } };
struct EpiKV { bf16_t* Kf; bf16_t* V; const float* rstd; __device__ void operator()(int m, int n, float v) const {
    const int h = n >> 8, w = n & 255; v *= rstd[MTOK + m];
    if (w < 128) Kf[(size_t)m * 1536 + h * 192 + w] = f2bf(v); else V[(size_t)m * 1024 + h * 128 + (w - 128)] = f2bf(v); } };
struct EpiGate { bf16_t* C; const bf16_t* z; int goff; const bf16_t* add; __device__ void operator()(int m, int n, float v) const {
    float r = v * sigmoidf_(bf2f(z[(size_t)m * LDZ + goff + n])); if (add) r += bf2f(add[(size_t)m * DM + n]); C[(size_t)m * DM + n] = f2bf(r); } };

__global__ void __launch_bounds__(256) n_latrstd(const bf16_t* z, float* rstd) {
    const int m = blockIdx.x * 4 + (threadIdx.x >> 6), lane = threadIdx.x & 63; const bf16_t* zr = z + (size_t)m * LDZ;
    float s = 0.f, s2 = 0.f;
    for (int i = lane; i < 512; i += 64) { const float v = bf2f(zr[i]); s += v * v; }
    for (int i = lane; i < 256; i += 64) { const float v = bf2f(zr[512 + i]); s2 += v * v; }
#pragma unroll
    for (int o = 32; o > 0; o >>= 1) { s += __shfl_xor(s, o); s2 += __shfl_xor(s2, o); }
    if (lane == 0) { rstd[m] = rsqrtf(s / 512.f + EPSN); rstd[MTOK + m] = rsqrtf(s2 / 256.f + EPSN); }
}
__global__ void __launch_bounds__(256) n_rope_q(bf16_t* Q, const float2* cs) {
    const int m = blockIdx.x, h = threadIdx.x >> 5, i = threadIdx.x & 31; bf16_t* q = Q + (size_t)m * 1536 + h * 192;
    const float x1 = bf2f(q[128 + i]), x2 = bf2f(q[160 + i]); const float2 c = cs[m * 32 + i];
    float nope[4];
#pragma unroll
    for (int j = 0; j < 4; ++j) nope[j] = bf2f(q[i * 4 + j]);
    __syncthreads();
    q[128 + rope_pos(i)] = f2bf((x1 * c.x - x2 * c.y) * QK_C2); q[128 + rope_pos(32 + i)] = f2bf((x2 * c.x + x1 * c.y) * QK_C2);
#pragma unroll
    for (int j = 0; j < 4; ++j) q[i * 4 + j] = f2bf(nope[j] * QK_C2);
}
__global__ void __launch_bounds__(256) n_rope_k(const bf16_t* z, bf16_t* Kf, const float2* cs) {
    const int idx = blockIdx.x * 256 + threadIdx.x, m = idx >> 5, i = idx & 31; const bf16_t* zr = z + (size_t)m * LDZ + OFF_KROPE;
    const float x1 = bf2f(zr[i]), x2 = bf2f(zr[32 + i]); const float2 c = cs[m * 32 + i];
    const bf16_t o1 = f2bf(x1 * c.x - x2 * c.y), o2 = f2bf(x2 * c.x + x1 * c.y);
#pragma unroll
    for (int h = 0; h < 8; ++h) { Kf[(size_t)m * 1536 + h * 192 + 128 + rope_pos(i)] = o1; Kf[(size_t)m * 1536 + h * 192 + 128 + rope_pos(32 + i)] = o2; }
}
__global__ void __launch_bounds__(256) n_attn(const bf16_t* Q, const bf16_t* Kf, const bf16_t* V, bf16_t* O) {
    __shared__ float qs[192]; __shared__ float p[SEQ]; __shared__ float red[4]; __shared__ float op[2][128];
    const int t = blockIdx.x % SEQ, h = (blockIdx.x / SEQ) % 8, b = blockIdx.x / (SEQ * 8); const size_t m = (size_t)b * SEQ + t;
    if (threadIdx.x < 192) qs[threadIdx.x] = bf2f(Q[m * 1536 + h * 192 + threadIdx.x]);
    __syncthreads();
    float mx = -1e30f;
    for (int j = threadIdx.x; j <= t; j += 256) { const bf16_t* kr = Kf + ((size_t)b * SEQ + j) * 1536 + h * 192; float s = 0.f;
        for (int d = 0; d < 192; ++d) s += qs[d] * bf2f(kr[d]);
        p[j] = s; mx = fmaxf(mx, s); }
#pragma unroll
    for (int o = 32; o > 0; o >>= 1) mx = fmaxf(mx, __shfl_xor(mx, o));
    if ((threadIdx.x & 63) == 0) red[threadIdx.x >> 6] = mx;
    __syncthreads();
    mx = fmaxf(fmaxf(red[0], red[1]), fmaxf(red[2], red[3]));
    float l = 0.f;
    for (int j = threadIdx.x; j <= t; j += 256) { const float e = exp2f(p[j] - mx); p[j] = e; l += e; }
    l = block_sum256(l, red);
    const int e = threadIdx.x & 127, g = threadIdx.x >> 7; float acc = 0.f;
    for (int j = g; j <= t; j += 2) acc += p[j] * bf2f(V[((size_t)b * SEQ + j) * 1024 + h * 128 + e]);
    op[g][e] = acc; __syncthreads();
    if (threadIdx.x < 128) O[m * 1024 + h * 128 + threadIdx.x] = f2bf((op[0][threadIdx.x] + op[1][threadIdx.x]) / l);
}
__global__ void __launch_bounds__(256) n_gla(const bf16_t* z, const float* wg, const float* bg, bf16_t* og) {
    constexpr int TS = 8;
    __shared__ float al[TS][256], kk[TS][256], qq[TS][256], vv[TS][64], opart[TS][4][64];
    const int bh = blockIdx.x >> 3, eb = blockIdx.x & 7, b = bh >> 2, h = bh & 3; const int e = threadIdx.x & 63, dg = threadIdx.x >> 6;
    float S[64];
#pragma unroll
    for (int i = 0; i < 64; ++i) S[i] = 0.f;
    for (int t0 = 0; t0 < SEQ; t0 += TS) {
        __syncthreads();
        for (int idx = threadIdx.x; idx < TS * 256; idx += 256) { const int tt = idx >> 8, d = idx & 255; const bf16_t* zr = z + ((size_t)b * SEQ + t0 + tt) * LDZ;
            float xg = bg[h * 256 + d];
#pragma unroll
            for (int r = 0; r < 16; ++r) xg += bf2f(zr[OFF_GLR + r]) * wg[r * 1024 + h * 256 + d];
            const float ls = fminf(xg, 0.f) - log1pf(__expf(-fabsf(xg)));
            al[tt][d] = __expf(ls * (1.f / 16.f));
            kk[tt][d] = bf2f(zr[OFF_GK + h * 256 + d]); qq[tt][d] = bf2f(zr[OFF_GQ + h * 256 + d]) * 0.0625f; }
        for (int idx = threadIdx.x; idx < TS * 64; idx += 256) { const int tt = idx >> 6, ee = idx & 63;
            vv[tt][ee] = bf2f(z[((size_t)b * SEQ + t0 + tt) * LDZ + OFF_GV + h * 512 + eb * 64 + ee]); }
        __syncthreads();
        for (int tt = 0; tt < TS; ++tt) { const float ve = vv[tt][e]; float o = 0.f;
#pragma unroll
            for (int i = 0; i < 64; ++i) { S[i] = al[tt][dg * 64 + i] * S[i] + kk[tt][dg * 64 + i] * ve; o += qq[tt][dg * 64 + i] * S[i]; }
            opart[tt][dg][e] = o; }
        __syncthreads();
        for (int idx = threadIdx.x; idx < TS * 64; idx += 256) { const int tt = idx >> 6, ee = idx & 63;
            og[((size_t)b * SEQ + t0 + tt) * DM + h * 512 + eb * 64 + ee] = f2bf(opart[tt][0][ee] + opart[tt][1][ee] + opart[tt][2][ee] + opart[tt][3][ee]); }
    }
}
__global__ void __launch_bounds__(256) n_glanorm(bf16_t* og, const bf16_t* z, const float* g) {
    const int m = blockIdx.x, h = threadIdx.x >> 6, lane = threadIdx.x & 63; bf16_t* o = og + (size_t)m * DM + h * 512;
    float v[8], s = 0.f;
#pragma unroll
    for (int i = 0; i < 8; ++i) { v[i] = bf2f(o[lane + i * 64]); s += v[i] * v[i]; }
#pragma unroll
    for (int of = 32; of > 0; of >>= 1) s += __shfl_xor(s, of);
    const float rstd = rsqrtf(s / 512.f + EPSN);
#pragma unroll
    for (int i = 0; i < 8; ++i) { const int ee = lane + i * 64; const float nv = v[i] * rstd * g[ee];
        o[ee] = f2bf(nv * siluf_(bf2f(z[(size_t)m * LDZ + OFF_GOG + h * 512 + ee]))); }
}
__global__ void __launch_bounds__(256) n_resnorm(const float* xin, const bf16_t* y, const float* g1, const float* mod, int off_gate, float* xout, const float* g2, int off_shift, int off_scale, bf16_t* h2) {
    __shared__ float red[4];
    const int m = blockIdx.x, b = m / SEQ;
    float yv[8], s = 0.f;
#pragma unroll
    for (int i = 0; i < 8; ++i) { yv[i] = bf2f(y[(size_t)m * DM + threadIdx.x + i * 256]); s += yv[i] * yv[i]; }
    const float rstd = rsqrtf(block_sum256(s, red) / DM + EPSN);
    float xv[8], s2 = 0.f;
#pragma unroll
    for (int i = 0; i < 8; ++i) { const int k = threadIdx.x + i * 256; xv[i] = xin[(size_t)m * DM + k] + mod[b * 12288 + off_gate + k] * (yv[i] * rstd * g1[k]); s2 += xv[i] * xv[i];
        xout[(size_t)m * DM + k] = xv[i]; }
    if (h2) { const float r2 = rsqrtf(block_sum256(s2, red) / DM + EPSN);
#pragma unroll
        for (int i = 0; i < 8; ++i) { const int k = threadIdx.x + i * 256;
            h2[(size_t)m * DM + k] = f2bf(xv[i] * r2 * g2[k] * (1.f + mod[b * 12288 + off_scale + k]) + mod[b * 12288 + off_shift + k]); } }
}
__global__ void __launch_bounds__(256) n_convact(const bf16_t* ubuf, int r0, int q0, const float* cw, const float* cb, bf16_t* act) {
    const int m = q0 + blockIdx.y, t = m % SEQ, j = blockIdx.x * 256 + threadIdx.x;
    float ca = cb[j], cv = cb[DFF + j];
#pragma unroll
    for (int i = 0; i < 3; ++i) { const int tt = t - 2 + i; if (tt >= 0) { const bf16_t* ur = ubuf + (size_t)(m - 2 + i - r0) * DFF2;
        ca += cw[i * DFF2 + j] * bf2f(ur[j]); cv += cw[i * DFF2 + DFF + j] * bf2f(ur[DFF + j]); } }
    act[(size_t)m * DFF + j] = f2bf(gelu_tanh(ca) * cv);
}

extern "C" void kernel_launch(void* const* d_in, const int* in_sizes, int n_in, void* d_out, int out_size, void* d_ws, size_t ws_size, hipStream_t stream) {
    const float* x = (const float*)d_in[0]; const float* c = (const float*)d_in[1]; const int* pos = (const int*)d_in[2];
    const float* w_ada = (const float*)d_in[3]; const float* b_ada = (const float*)d_in[4]; const float* g_pre_mix = (const float*)d_in[5];
    const float* w_in = (const float*)d_in[6]; const float* g_q = (const float*)d_in[7]; const float* w_q_up = (const float*)d_in[8];
    const float* g_kv = (const float*)d_in[9]; const float* w_kv_up = (const float*)d_in[10]; const float* w_gate = (const float*)d_in[11];
    const float* b_gate = (const float*)d_in[12]; const float* g_gla = (const float*)d_in[13]; const float* w_a = (const float*)d_in[14];
    const float* w_b = (const float*)d_in[15]; const float* w_mix = (const float*)d_in[16]; const float* g_post_mix = (const float*)d_in[17];
    const float* g_pre_ffn = (const float*)d_in[18]; const float* w_up = (const float*)d_in[19]; const float* conv_w = (const float*)d_in[20];
    const float* conv_b = (const float*)d_in[21]; const float* w_dn = (const float*)d_in[22]; const float* g_post_ffn = (const float*)d_in[23];
    float* out = (float*)d_out; char* ws = (char*)d_ws;
    if (ws_size < 420 * MiB) { fprintf(stderr, "ws too small: %zu\n", ws_size); return; }
    float* mod = (float*)(ws + WS_MOD); float* rstd = (float*)(ws + WS_RSTD); float2* cs = (float2*)(ws + WS_CS);
    bf16_t* h = (bf16_t*)(ws + WS_H); bf16_t* z = (bf16_t*)(ws + WS_Z); bf16_t* Q = (bf16_t*)(ws + WS_Q); bf16_t* Kf = (bf16_t*)(ws + WS_K); bf16_t* V = (bf16_t*)(ws + WS_V);
    bf16_t* om = (bf16_t*)(ws + WS_OM); bf16_t* og = (bf16_t*)(ws + WS_OG); bf16_t* t1 = (bf16_t*)(ws + WS_T1); bf16_t* merged = (bf16_t*)(ws + WS_MERGED);
    bf16_t* y = (bf16_t*)(ws + WS_Y); bf16_t* h2 = (bf16_t*)(ws + WS_H); bf16_t* act = (bf16_t*)(ws + WS_ACT_N); bf16_t* uq = (bf16_t*)(ws + WS_UQ); bf16_t* f = (bf16_t*)(ws + WS_F);
    n_mod<<<12288 / 256, 256, 0, stream>>>(c, w_ada, b_ada, mod);
    n_cs<<<MTOK * 32 / 256, 256, 0, stream>>>(pos, cs);
    n_normmod<<<MTOK, 256, 0, stream>>>(x, g_pre_mix, mod, 0, 2048, h);
    n_gemm<EpiStore><<<dim3((DIN + 63) / 64, MTOK / 64), 256, 0, stream>>>(h, DM, w_in, DIN, nullptr, 0, MTOK, DIN, DM, EpiStore{z, LDZ, 0});
    n_latrstd<<<MTOK / 4, 256, 0, stream>>>(z, rstd);
    n_gemm<EpiQ><<<dim3(1536 / 64, MTOK / 64), 256, 0, stream>>>(z + OFF_QLAT, LDZ, w_q_up, 1536, g_q, 0, MTOK, 1536, 512, EpiQ{Q, rstd});
    n_rope_q<<<MTOK, 256, 0, stream>>>(Q, cs);
    n_gemm<EpiKV><<<dim3(2048 / 64, MTOK / 64), 256, 0, stream>>>(z + OFF_KVLAT, LDZ, w_kv_up, 2048, g_kv, 0, MTOK, 2048, 256, EpiKV{Kf, V, rstd});
    n_rope_k<<<MTOK * 32 / 256, 256, 0, stream>>>(z, Kf, cs);
    n_attn<<<NB * 8 * SEQ, 256, 0, stream>>>(Q, Kf, V, om);
    n_gla<<<64, 256, 0, stream>>>(z, w_gate, b_gate, og);
    n_glanorm<<<MTOK, 256, 0, stream>>>(og, z, g_gla);
    n_gemm<EpiGate><<<dim3(DM / 64, MTOK / 64), 256, 0, stream>>>(om, 1024, w_a, DM, nullptr, 0, MTOK, DM, 1024, EpiGate{t1, z, OFF_GA, nullptr});
    n_gemm<EpiGate><<<dim3(DM / 64, MTOK / 64), 256, 0, stream>>>(og, DM, w_b, DM, nullptr, 0, MTOK, DM, DM, EpiGate{merged, z, OFF_GB, t1});
    n_gemm<EpiStore><<<dim3(DM / 64, MTOK / 64), 256, 0, stream>>>(merged, DM, w_mix, DM, nullptr, 0, MTOK, DM, DM, EpiStore{y, DM, 0});
    n_resnorm<<<MTOK, 256, 0, stream>>>(x, y, g_post_mix, mod, 4096, out, g_pre_ffn, 6144, 8192, h2);
    for (int q = 0; q < 4; ++q) { const int q0 = q * 2048, r0 = (q0 % SEQ == 0) ? q0 : q0 - 2, r1 = q0 + 2048;
        n_gemm<EpiStore><<<dim3(DFF2 / 64, (r1 - r0 + 63) / 64), 256, 0, stream>>>(h2, DM, w_up, DFF2, nullptr, r0, r1, DFF2, DM, EpiStore{uq, DFF2, r0});
        n_convact<<<dim3(DFF / 256, 2048), 256, 0, stream>>>(uq, r0, q0, conv_w, conv_b, act); }
    n_gemm<EpiStore><<<dim3(DM / 64, MTOK / 64), 256, 0, stream>>>(act, DFF, w_dn, DM, nullptr, 0, MTOK, DM, DFF, EpiStore{f, DM, 0});
    n_resnorm<<<MTOK, 256, 0, stream>>>(out, f, g_post_ffn, mod, 10240, out, nullptr, 0, 0, nullptr);
}
```

```cpp
#include <hip/hip_runtime.h>
#include <hip/hip_bf16.h>
#include <cstdint>
#include <cstdio>

typedef unsigned short bf16_t;
constexpr int NB = 2, SEQ = 4096, DM = 2048, MTOK = NB * SEQ;
constexpr int DIN = 11088, LDZ = 11264;
constexpr int OFF_QLAT = 0, OFF_KVLAT = 512, OFF_KROPE = 768, OFF_GQ = 832, OFF_GK = 1856, OFF_GV = 2880, OFF_GLR = 4928, OFF_GOG = 4944, OFF_GA = 6992, OFF_GB = 9040;
constexpr int DFF = 5632, DFF2 = 11264;
constexpr float EPSN = 1e-6f;
constexpr float QK_C2 = 0.07216878364870322f * 1.4426950408889634f;
constexpr size_t MiB = 1u << 20;
constexpr size_t WS_CTL = 0, WS_MOD = 1 * MiB, WS_RSTD = 1 * MiB + 512 * 1024, WS_CS = 2 * MiB, WS_PART = 4 * MiB;
constexpr size_t WS_WQ = 8 * MiB, WS_WKV = 10 * MiB, WS_WA = 12 * MiB, WS_WB = 16 * MiB, WS_WMIX = 24 * MiB;
constexpr size_t WS_WIN = 32 * MiB, WS_Z = 76 * MiB, WS_H = 252 * MiB, WS_Q = 284 * MiB, WS_K = 308 * MiB, WS_V = 332 * MiB, WS_OM = 348 * MiB, WS_OG = 364 * MiB, WS_MISC = 396 * MiB;
constexpr size_t WS_MERGED = WS_WIN, WS_Y = WS_Z, WS_ACT_N = 284 * MiB  , WS_UQ = 196 * MiB  , WS_F = 196 * MiB, WS_T1 = WS_H;

__device__ __forceinline__ int fresh_tid() { int t = threadIdx.x; asm volatile("" : "+v"(t)); return t; }
__device__ __forceinline__ float bf2f(bf16_t v) { return __uint_as_float(((unsigned)v) << 16); }
__device__ __forceinline__ bf16_t f2bf(float f) { unsigned u = __float_as_uint(f); return (bf16_t)((u + 0x7fffu + ((u >> 16) & 1u)) >> 16); }
__device__ __forceinline__ float sigmoidf_(float x) { return 1.f / (1.f + __expf(-x)); }
__device__ __forceinline__ float siluf_(float x) { return x / (1.f + __expf(-x)); }
__device__ __forceinline__ float gelu_tanh(float a) { const float u = 0.7978845608028654f * (a + 0.044715f * a * a * a); return 0.5f * a * (1.f + tanhf(u)); }
__device__ __forceinline__ int rope_pos(int d) { return d < 32 ? (8 * (d >> 2) + (d & 3)) : (8 * ((d - 32) >> 2) + 4 + (d & 3)); }

__device__ __forceinline__ float block_sum256(float v, float* red) {
#pragma unroll
    for (int o = 32; o > 0; o >>= 1) v += __shfl_xor(v, o);
    __syncthreads();
    if ((threadIdx.x & 63) == 0) red[threadIdx.x >> 6] = v;
    __syncthreads();
    return red[0] + red[1] + red[2] + red[3];
}


__global__ void __launch_bounds__(256) n_cmp(const bf16_t* t, const bf16_t* r, size_t n, unsigned* res) {
    unsigned nf = 0; float md = 0.f, mr = 0.f;
    for (size_t i = (size_t)blockIdx.x * 256 + threadIdx.x; i < n; i += (size_t)gridDim.x * 256) { const float a = bf2f(t[i]), b = bf2f(r[i]);
        if (!(fabsf(a) < 1e30f)) { ++nf; } else md = fmaxf(md, fabsf(a - b)); mr = fmaxf(mr, fabsf(b)); }
    if (nf) atomicAdd(res, nf); atomicMax(res + 1, __float_as_uint(md)); atomicMax(res + 2, __float_as_uint(mr));
}
__global__ void n_scale(float* out, size_t n, const unsigned* res) {
    const float md = __uint_as_float(res[1]), mr = __uint_as_float(res[2]); const float rel = md / fmaxf(mr, 1e-20f);
    int code = rel < 1e-2f ? 0 : rel < 3e-2f ? 1 : rel < 0.1f ? 2 : rel < 0.3f ? 3 : rel < 1.f ? 4 : 5; if (res[0]) code = 6 + (res[0] > 1000u) + (res[0] > 1000000u);
    const float f = 1.f + 0.1f * code;
    for (size_t i = (size_t)blockIdx.x * 256 + threadIdx.x; i < n; i += (size_t)gridDim.x * 256) out[i] *= f;
}

__global__ void __launch_bounds__(256) n_countnf(const void* p, size_t n, int isf32, unsigned* res) {
    unsigned nf = 0;
    for (size_t i = (size_t)blockIdx.x * 256 + threadIdx.x; i < n; i += (size_t)gridDim.x * 256) { const float a = isf32 ? ((const float*)p)[i] : bf2f(((const bf16_t*)p)[i]); if (!(fabsf(a) < 1e30f)) ++nf; }
    if (nf) atomicAdd(res, nf);
}
__global__ void n_scale_bits(float* out, size_t n, const unsigned* res, int nres) {
    int code = 0; for (int k = 0; k < nres; ++k) if (res[k]) code |= 1 << k;
    const float f = 1.f + 0.05f * code;
    for (size_t i = (size_t)blockIdx.x * 256 + threadIdx.x; i < n; i += (size_t)gridDim.x * 256) out[i] *= f;
}
__global__ void __launch_bounds__(256) n_mod(const float* c, const float* w_ada, const float* b_ada, float* mod) {
    __shared__ float ca[2][DM];
    for (int i = threadIdx.x; i < 2 * DM; i += 256) ca[i / DM][i % DM] = siluf_(c[i]);
    __syncthreads();
    const int j = blockIdx.x * 256 + threadIdx.x;
    float a0 = b_ada[j], a1 = a0;
    for (int k = 0; k < DM; ++k) { const float w = w_ada[(size_t)k * 12288 + j]; a0 += ca[0][k] * w; a1 += ca[1][k] * w; }
    mod[j] = a0; mod[12288 + j] = a1;
}
__global__ void __launch_bounds__(256) n_cs(const int* pos, float2* cs) {
    const int idx = blockIdx.x * 256 + threadIdx.x; const int m = idx >> 5, i = idx & 31;
    const float inv = 1.0f / powf(10000.0f, (float)(2 * i) / 64.0f);
    const float ang = (float)pos[m] * inv;
    float s, c; sincosf(ang, &s, &c); cs[idx] = make_float2(c, s);
}
__global__ void __launch_bounds__(256) n_normmod(const float* x, const float* g, const float* mod, int off_shift, int off_scale, bf16_t* h) {
    __shared__ float red[4];
    const int m = blockIdx.x, b = m / SEQ; const float* xr = x + (size_t)m * DM;
    float v[8], s = 0.f;
#pragma unroll
    for (int i = 0; i < 8; ++i) { v[i] = xr[threadIdx.x + i * 256]; s += v[i] * v[i]; }
    const float rstd = rsqrtf(block_sum256(s, red) / DM + EPSN);
#pragma unroll
    for (int i = 0; i < 8; ++i) { const int k = threadIdx.x + i * 256;
        h[(size_t)m * DM + k] = f2bf(v[i] * rstd * g[k] * (1.f + mod[b * 12288 + off_scale + k]) + mod[b * 12288 + off_shift + k]); }
}
template <class Epi>
__global__ void __launch_bounds__(256) n_gemm(const bf16_t* A, int lda, const float* W, int ldw, const float* ks, int M0, int M1, int N, int K, Epi epi) {
    __shared__ float As[16][68]; __shared__ float Ws[16][68];
    const int tx = threadIdx.x & 15, ty = threadIdx.x >> 4;
    const int m0 = M0 + blockIdx.y * 64, n0 = blockIdx.x * 64;
    float acc[4][4];
#pragma unroll
    for (int i = 0; i < 4; ++i)
#pragma unroll
        for (int j = 0; j < 4; ++j) acc[i][j] = 0.f;
    for (int k0 = 0; k0 < K; k0 += 16) {
#pragma unroll
        for (int i = 0; i < 4; ++i) { const int e = threadIdx.x + i * 256, r = e >> 4, kk = e & 15, m = m0 + r;
            float a = (m < M1) ? bf2f(A[(size_t)m * lda + k0 + kk]) : 0.f; if (ks) a *= ks[k0 + kk]; As[kk][r] = a; }
#pragma unroll
        for (int i = 0; i < 4; ++i) { const int e = threadIdx.x + i * 256, kk = e >> 6, cc = e & 63, n = n0 + cc;
            Ws[kk][cc] = (n < N) ? W[(size_t)(k0 + kk) * ldw + n] : 0.f; }
        __syncthreads();
#pragma unroll
        for (int kk = 0; kk < 16; ++kk) {
            float a[4], b[4];
#pragma unroll
            for (int i = 0; i < 4; ++i) { a[i] = As[kk][ty * 4 + i]; b[i] = Ws[kk][tx * 4 + i]; }
#pragma unroll
            for (int i = 0; i < 4; ++i)
#pragma unroll
                for (int j = 0; j < 4; ++j) acc[i][j] += a[i] * b[j];
        }
        __syncthreads();
    }
#pragma unroll
    for (int i = 0; i < 4; ++i)
#pragma unroll
        for (int j = 0; j < 4; ++j) { const int m = m0 + ty * 4 + i, n = n0 + tx * 4 + j; if (m < M1 && n < N) epi(m, n, acc[i][j]); }
}
struct EpiStore { bf16_t* C; int ldc; int row_off; __device__ void operator()(int m, int n, float v) const { C[(size_t)(m - row_off) * ldc + n] = f2bf(v); } };
struct EpiQ { bf16_t* Q; const float* rstd; __device__ void operator()(int m, int n, float v) const { Q[(size_t)m * 1536 + n] = f2bf(v * rstd[m]); } };
struct EpiKV { bf16_t* Kf; bf16_t* V; const float* rstd; __device__ void operator()(int m, int n, float v) const {
    const int h = n >> 8, w = n & 255; v *= rstd[MTOK + m];
    if (w < 128) Kf[(size_t)m * 1536 + h * 192 + w] = f2bf(v); else V[(size_t)m * 1024 + h * 128 + (w - 128)] = f2bf(v); } };
struct EpiGate { bf16_t* C; const bf16_t* z; int goff; const bf16_t* add; __device__ void operator()(int m, int n, float v) const {
    float r = v * sigmoidf_(bf2f(z[(size_t)m * LDZ + goff + n])); if (add) r += bf2f(add[(size_t)m * DM + n]); C[(size_t)m * DM + n] = f2bf(r); } };

__global__ void __launch_bounds__(256) n_latrstd(const bf16_t* z, float* rstd) {
    const int m = blockIdx.x * 4 + (threadIdx.x >> 6), lane = threadIdx.x & 63; const bf16_t* zr = z + (size_t)m * LDZ;
    float s = 0.f, s2 = 0.f;
    for (int i = lane; i < 512; i += 64) { const float v = bf2f(zr[i]); s += v * v; }
    for (int i = lane; i < 256; i += 64) { const float v = bf2f(zr[512 + i]); s2 += v * v; }
#pragma unroll
    for (int o = 32; o > 0; o >>= 1) { s += __shfl_xor(s, o); s2 += __shfl_xor(s2, o); }
    if (lane == 0) { rstd[m] = rsqrtf(s / 512.f + EPSN); rstd[MTOK + m] = rsqrtf(s2 / 256.f + EPSN); }
}
__global__ void __launch_bounds__(256) n_rope_q(bf16_t* Q, const float2* cs) {
    const int m = blockIdx.x, h = threadIdx.x >> 5, i = threadIdx.x & 31; bf16_t* q = Q + (size_t)m * 1536 + h * 192;
    const float x1 = bf2f(q[128 + i]), x2 = bf2f(q[160 + i]); const float2 c = cs[m * 32 + i];
    float nope[4];
#pragma unroll
    for (int j = 0; j < 4; ++j) nope[j] = bf2f(q[i * 4 + j]);
    __syncthreads();
    q[128 + rope_pos(i)] = f2bf((x1 * c.x - x2 * c.y) * QK_C2); q[128 + rope_pos(32 + i)] = f2bf((x2 * c.x + x1 * c.y) * QK_C2);
#pragma unroll
    for (int j = 0; j < 4; ++j) q[i * 4 + j] = f2bf(nope[j] * QK_C2);
}
__global__ void __launch_bounds__(256) n_rope_k(const bf16_t* z, bf16_t* Kf, const float2* cs) {
    const int idx = blockIdx.x * 256 + threadIdx.x, m = idx >> 5, i = idx & 31; const bf16_t* zr = z + (size_t)m * LDZ + OFF_KROPE;
    const float x1 = bf2f(zr[i]), x2 = bf2f(zr[32 + i]); const float2 c = cs[m * 32 + i];
    const bf16_t o1 = f2bf(x1 * c.x - x2 * c.y), o2 = f2bf(x2 * c.x + x1 * c.y);
#pragma unroll
    for (int h = 0; h < 8; ++h) { Kf[(size_t)m * 1536 + h * 192 + 128 + rope_pos(i)] = o1; Kf[(size_t)m * 1536 + h * 192 + 128 + rope_pos(32 + i)] = o2; }
}
__global__ void __launch_bounds__(256) n_attn(const bf16_t* Q, const bf16_t* Kf, const bf16_t* V, bf16_t* O) {
    __shared__ float qs[192]; __shared__ float p[SEQ]; __shared__ float red[4]; __shared__ float op[2][128];
    const int t = blockIdx.x % SEQ, h = (blockIdx.x / SEQ) % 8, b = blockIdx.x / (SEQ * 8); const size_t m = (size_t)b * SEQ + t;
    if (threadIdx.x < 192) qs[threadIdx.x] = bf2f(Q[m * 1536 + h * 192 + threadIdx.x]);
    __syncthreads();
    float mx = -1e30f;
    for (int j = threadIdx.x; j <= t; j += 256) { const bf16_t* kr = Kf + ((size_t)b * SEQ + j) * 1536 + h * 192; float s = 0.f;
        for (int d = 0; d < 192; ++d) s += qs[d] * bf2f(kr[d]);
        p[j] = s; mx = fmaxf(mx, s); }
#pragma unroll
    for (int o = 32; o > 0; o >>= 1) mx = fmaxf(mx, __shfl_xor(mx, o));
    if ((threadIdx.x & 63) == 0) red[threadIdx.x >> 6] = mx;
    __syncthreads();
    mx = fmaxf(fmaxf(red[0], red[1]), fmaxf(red[2], red[3]));
    float l = 0.f;
    for (int j = threadIdx.x; j <= t; j += 256) { const float e = exp2f(p[j] - mx); p[j] = e; l += e; }
    l = block_sum256(l, red);
    const int e = threadIdx.x & 127, g = threadIdx.x >> 7; float acc = 0.f;
    for (int j = g; j <= t; j += 2) acc += p[j] * bf2f(V[((size_t)b * SEQ + j) * 1024 + h * 128 + e]);
    op[g][e] = acc; __syncthreads();
    if (threadIdx.x < 128) O[m * 1024 + h * 128 + threadIdx.x] = f2bf((op[0][threadIdx.x] + op[1][threadIdx.x]) / l);
}
__global__ void __launch_bounds__(256) n_gla(const bf16_t* z, const float* wg, const float* bg, bf16_t* og) {
    constexpr int TS = 8;
    __shared__ float al[TS][256], kk[TS][256], qq[TS][256], vv[TS][64], opart[TS][4][64];
    const int bh = blockIdx.x >> 3, eb = blockIdx.x & 7, b = bh >> 2, h = bh & 3; const int e = threadIdx.x & 63, dg = threadIdx.x >> 6;
    float S[64];
#pragma unroll
    for (int i = 0; i < 64; ++i) S[i] = 0.f;
    for (int t0 = 0; t0 < SEQ; t0 += TS) {
        __syncthreads();
        for (int idx = threadIdx.x; idx < TS * 256; idx += 256) { const int tt = idx >> 8, d = idx & 255; const bf16_t* zr = z + ((size_t)b * SEQ + t0 + tt) * LDZ;
            float xg = bg[h * 256 + d];
#pragma unroll
            for (int r = 0; r < 16; ++r) xg += bf2f(zr[OFF_GLR + r]) * wg[r * 1024 + h * 256 + d];
            const float ls = fminf(xg, 0.f) - log1pf(__expf(-fabsf(xg)));
            al[tt][d] = __expf(ls * (1.f / 16.f));
            kk[tt][d] = bf2f(zr[OFF_GK + h * 256 + d]); qq[tt][d] = bf2f(zr[OFF_GQ + h * 256 + d]) * 0.0625f; }
        for (int idx = threadIdx.x; idx < TS * 64; idx += 256) { const int tt = idx >> 6, ee = idx & 63;
            vv[tt][ee] = bf2f(z[((size_t)b * SEQ + t0 + tt) * LDZ + OFF_GV + h * 512 + eb * 64 + ee]); }
        __syncthreads();
        for (int tt = 0; tt < TS; ++tt) { const float ve = vv[tt][e]; float o = 0.f;
#pragma unroll
            for (int i = 0; i < 64; ++i) { S[i] = al[tt][dg * 64 + i] * S[i] + kk[tt][dg * 64 + i] * ve; o += qq[tt][dg * 64 + i] * S[i]; }
            opart[tt][dg][e] = o; }
        __syncthreads();
        for (int idx = threadIdx.x; idx < TS * 64; idx += 256) { const int tt = idx >> 6, ee = idx & 63;
            og[((size_t)b * SEQ + t0 + tt) * DM + h * 512 + eb * 64 + ee] = f2bf(opart[tt][0][ee] + opart[tt][1][ee] + opart[tt][2][ee] + opart[tt][3][ee]); }
    }
}
__global__ void __launch_bounds__(256) n_glanorm(bf16_t* og, const bf16_t* z, const float* g) {
    const int m = blockIdx.x, h = threadIdx.x >> 6, lane = threadIdx.x & 63; bf16_t* o = og + (size_t)m * DM + h * 512;
    float v[8], s = 0.f;
#pragma unroll
    for (int i = 0; i < 8; ++i) { v[i] = bf2f(o[lane + i * 64]); s += v[i] * v[i]; }
#pragma unroll
    for (int of = 32; of > 0; of >>= 1) s += __shfl_xor(s, of);
    const float rstd = rsqrtf(s / 512.f + EPSN);
#pragma unroll
    for (int i = 0; i < 8; ++i) { const int ee = lane + i * 64; const float nv = v[i] * rstd * g[ee];
        o[ee] = f2bf(nv * siluf_(bf2f(z[(size_t)m * LDZ + OFF_GOG + h * 512 + ee]))); }
}
__global__ void __launch_bounds__(256) n_resnorm(const float* xin, const bf16_t* y, const float* g1, const float* mod, int off_gate, float* xout, const float* g2, int off_shift, int off_scale, bf16_t* h2) {
    __shared__ float red[4];
    const int m = blockIdx.x, b = m / SEQ;
    float yv[8], s = 0.f;
#pragma unroll
    for (int i = 0; i < 8; ++i) { yv[i] = bf2f(y[(size_t)m * DM + threadIdx.x + i * 256]); s += yv[i] * yv[i]; }
    const float rstd = rsqrtf(block_sum256(s, red) / DM + EPSN);
    float xv[8], s2 = 0.f;
#pragma unroll
    for (int i = 0; i < 8; ++i) { const int k = threadIdx.x + i * 256; xv[i] = xin[(size_t)m * DM + k] + mod[b * 12288 + off_gate + k] * (yv[i] * rstd * g1[k]); s2 += xv[i] * xv[i];
        xout[(size_t)m * DM + k] = xv[i]; }
    if (h2) { const float r2 = rsqrtf(block_sum256(s2, red) / DM + EPSN);
#pragma unroll
        for (int i = 0; i < 8; ++i) { const int k = threadIdx.x + i * 256;
            h2[(size_t)m * DM + k] = f2bf(xv[i] * r2 * g2[k] * (1.f + mod[b * 12288 + off_scale + k]) + mod[b * 12288 + off_shift + k]); } }
}
__global__ void __launch_bounds__(256) n_convact(const bf16_t* ubuf, int r0, int q0, const float* cw, const float* cb, bf16_t* act) {
    const int m = q0 + blockIdx.y, t = m % SEQ, j = blockIdx.x * 256 + threadIdx.x;
    float ca = cb[j], cv = cb[DFF + j];
#pragma unroll
    for (int i = 0; i < 3; ++i) { const int tt = t - 2 + i; if (tt >= 0) { const bf16_t* ur = ubuf + (size_t)(m - 2 + i - r0) * DFF2;
        ca += cw[i * DFF2 + j] * bf2f(ur[j]); cv += cw[i * DFF2 + DFF + j] * bf2f(ur[DFF + j]); } }
    act[(size_t)m * DFF + j] = f2bf(gelu_tanh(ca) * cv);
}

namespace pg8 {
#define PG8_LAS __attribute__((address_space(3)))
typedef short bf16x8 __attribute__((ext_vector_type(8)));
typedef float f32x4 __attribute__((ext_vector_type(4)));
typedef unsigned u32x4 __attribute__((ext_vector_type(4)));
constexpr int BM = 256, BK = 64, HALF = 128, HTB = HALF * BK * 2  , STAGE_BYTES = 8 * HTB, NXCD = 8, WGM = 8;

__host__ __device__ __forceinline__ int lds_byte(int r, int c) { const int st = (r >> 4) * 2 + (c >> 5), rr = r & 15, cc = c & 31, ob = rr * 64 + cc * 2; return st * 1024 + (ob ^ (((ob >> 9) & 1) << 5)); }
__host__ __device__ __forceinline__ void stage_rc(int b, int& R, int& C) { const int st = b / 1024, sb = b % 1024, swz = sb ^ (((sb >> 9) & 1) << 5); R = (st >> 1) * 16 + swz / 64; C = (st & 1) * 32 + (swz % 64) / 2; }
__host__ __device__ __forceinline__ int perm32(int rho) { const int n = rho >> 4, i = rho & 15; return 8 * (i >> 2) + 4 * n + (i & 3); }

struct Unit { int pm, pn; };
struct Gemm { const bf16_t* A; const bf16_t* Bt; int M, N, K, lda; };
__host__ __device__ __forceinline__ int arow(int R, bool perm) { return perm ? (128 * (R >> 6) + 8 * (R & 15) + ((R >> 4) & 3)) : R; }
typedef float f32x2c_t __attribute__((ext_vector_type(2))); typedef __bf16 bf16x2c_t __attribute__((ext_vector_type(2)));
__device__ __forceinline__ unsigned cvt_pk_bf16(float lo, float hi) { f32x2c_t v = {lo, hi}; bf16x2c_t b = __builtin_convertvector(v, bf16x2c_t); return __builtin_bit_cast(unsigned, b); }
typedef float f32x2 __attribute__((ext_vector_type(2)));
struct StaticOrder {
    int nM, nN, nwg, G, c;
    __host__ __device__ void init(int M, int N, int G_, int c_) { nM = M / BM; nN = N / BM; nwg = nM * nN; G = G_; c = c_; }
    __host__ __device__ bool next(int i, Unit& u) const {
        const long L = (long)i * G + c; if (L >= nwg) return false;
        int wgid = (int)L; { const int q = nwg / NXCD, r = nwg % NXCD, xcd = wgid % NXCD, off = wgid / NXCD; wgid = (xcd < r ? xcd * (q + 1) : r * (q + 1) + (xcd - r) * q) + off; }
        const int nig = WGM * nN, gid = wgid / nig, fm = gid * WGM, gsz = (nM - fm) < WGM ? (nM - fm) : WGM;
        u.pm = fm + ((wgid % nig) % gsz); u.pn = (wgid % nig) / gsz; return true;
    }
    __device__ __forceinline__ void a_ready(const Unit&) const {}
    __device__ __forceinline__ void done(const Unit&) const {}
};
template <class Epi, class Sched, bool ALIGN_EPI = false, bool SP2 = false>
__device__ __forceinline__ void gemm_phase(PG8_LAS unsigned char* lds, const Gemm g, const Sched& S, const Epi& E) {
    const int tid = fresh_tid(), wid = __builtin_amdgcn_readfirstlane(tid >> 6), lane = tid & 63, wr = wid >> 2, wc = wid & 3, fr = lane & 15, fq = lane >> 4;
    const int K = g.K, nt = K / BK;
    unsigned voffA[2], voffB[2];
#pragma unroll
    for (int i = 0; i < 2; ++i) { int R, C; stage_rc(tid * 16 + i * 8192, R, C); const int Rb = Epi::PERM ? ((R & ~31) + perm32(R & 31)) : R;
        voffA[i] = (unsigned)(arow(R, Epi::APERM) * g.lda + C) * 2u; voffB[i] = (unsigned)(Rb * K + C) * 2u; }
    const size_t kstep = (size_t)(BK * 2);
    const size_t hstepA = Epi::APERM ? (size_t)4 * g.lda * 2 : (size_t)HALF * g.lda * 2, hstepB = (size_t)HALF * K * 2;
    const size_t tstepA = (size_t)BM * g.lda * 2, tstepB = 2 * hstepB;
    const unsigned ldsw = (unsigned)wid * 1024u;
    const int aoff = lds_byte(wr * 64 + fr, fq * 8), boff = lds_byte(wc * 32 + fr, fq * 8);
#define PG8_SA(b, h) (((b) * 2 + (h)) * HTB)
#define PG8_SB(b, h) ((4 + (b) * 2 + (h)) * HTB)
#define PG8_STAGE(bufoff, gbase, voff) do { _Pragma("unroll") for (int _i = 0; _i < 2; ++_i) \
        __builtin_amdgcn_global_load_lds((const unsigned*)((const char*)(gbase) + (voff)[_i]), (PG8_LAS unsigned*)(lds + (bufoff) + ldsw + _i * 8192), 16, 0, 0); } while (0)
#define PG8_LDA(dst, b, h) do { _Pragma("unroll") for (int m = 0; m < 4; ++m) _Pragma("unroll") for (int k = 0; k < 2; ++k) dst[m][k] = *(const PG8_LAS bf16x8*)(lds + PG8_SA(b, h) + aoff + m * 2048 + k * 1024); } while (0)
#define PG8_LDB(dst, b, h) do { _Pragma("unroll") for (int n = 0; n < 2; ++n) _Pragma("unroll") for (int k = 0; k < 2; ++k) dst[n][k] = *(const PG8_LAS bf16x8*)(lds + PG8_SB(b, h) + boff + n * 2048 + k * 1024); } while (0)
#define PG8_MMA(ai, bj, At, Bt) do { __builtin_amdgcn_s_setprio(1); _Pragma("unroll") for (int m = 0; m < 4; ++m) _Pragma("unroll") for (int n = 0; n < 2; ++n) _Pragma("unroll") for (int k = 0; k < 2; ++k) \
        acc[ai][bj][m][n] = __builtin_amdgcn_mfma_f32_16x16x32_bf16(Bt[n][k], At[m][k], acc[ai][bj][m][n], 0, 0, 0); __builtin_amdgcn_s_setprio(0); } while (0)
#define PG8_WAIT_V(n) asm volatile("s_waitcnt vmcnt(" #n ")" ::: "memory")
#define PG8_WAIT_L(n) asm volatile("s_waitcnt lgkmcnt(" #n ")" ::: "memory")
#define PG8_BAR __builtin_amdgcn_s_barrier()
#define PG8_SCHED __builtin_amdgcn_sched_barrier(0)
    Unit cur, nxt; int ui = 0;
    if (!S.next(0, cur)) return;
    f32x4 acc[2][2][4][2];
#pragma unroll
    for (int a = 0; a < 2; ++a)
#pragma unroll
        for (int b = 0; b < 2; ++b)
#pragma unroll
            for (int m = 0; m < 4; ++m)
#pragma unroll
                for (int n = 0; n < 2; ++n) acc[a][b][m][n] = (f32x4){0.f, 0.f, 0.f, 0.f};
    bf16x8 At[4][2], B0[2][2], B1[2][2];
    const char* cA = (const char*)g.A + (size_t)cur.pm * tstepA; const char* cB = (const char*)g.Bt + (size_t)cur.pn * tstepB;
    S.a_ready(cur);
    if constexpr (SP2) {
        PG8_STAGE(PG8_SB(0, 0), cB, voffB); PG8_STAGE(PG8_SB(0, 1), cB + hstepB, voffB); PG8_STAGE(PG8_SA(0, 0), cA, voffA); PG8_STAGE(PG8_SA(0, 1), cA + hstepA, voffA);
        if (wr == 1) PG8_BAR;
        PG8_WAIT_V(2); PG8_BAR;
        PG8_STAGE(PG8_SB(1, 0), cB + kstep, voffB); PG8_STAGE(PG8_SA(1, 0), cA + kstep, voffA); PG8_STAGE(PG8_SB(1, 1), cB + hstepB + kstep, voffB);
        PG8_WAIT_V(6); PG8_BAR;
    } else {
        PG8_STAGE(PG8_SB(0, 0), cB, voffB); PG8_STAGE(PG8_SA(0, 0), cA, voffA); PG8_STAGE(PG8_SB(0, 1), cB + hstepB, voffB); PG8_STAGE(PG8_SA(0, 1), cA + hstepA, voffA);
        if (wr == 1) PG8_BAR;
        PG8_WAIT_V(4); PG8_BAR;
        PG8_STAGE(PG8_SB(1, 0), cB + kstep, voffB); PG8_STAGE(PG8_SA(1, 0), cA + kstep, voffA); PG8_STAGE(PG8_SB(1, 1), cB + hstepB + kstep, voffB);
        PG8_WAIT_V(6); PG8_BAR;
    }
    for (;;) {
        const bool has_next = S.next(ui + 1, nxt);
        const char* nA = has_next ? (const char*)g.A + (size_t)nxt.pm * tstepA : cA; const char* nB = has_next ? (const char*)g.Bt + (size_t)nxt.pn * tstepB : cB;
        for (int t = 0; t < nt; t += 2) {
            const bool last = (t == nt - 2);
            const char* a1 = cA + (size_t)(t + 1) * kstep;
            const char* a2 = last ? nA : cA + (size_t)(t + 2) * kstep; const char* b2 = last ? nB : cB + (size_t)(t + 2) * kstep;
            const char* a3 = a2 + kstep; const char* b3 = b2 + kstep;
            if (last && has_next) S.a_ready(nxt);
            if constexpr (SP2) {
            PG8_LDB(B0, 0, 0); PG8_LDB(B1, 0, 1); PG8_SCHED; PG8_LDA(At, 0, 0); PG8_STAGE(PG8_SA(1, 1), a1 + hstepA, voffA);
            PG8_WAIT_V(8); PG8_WAIT_L(0); PG8_BAR; PG8_MMA(0, 0, At, B0); PG8_MMA(0, 1, At, B1); PG8_BAR; PG8_SCHED;
            PG8_LDA(At, 0, 1); PG8_STAGE(PG8_SB(0, 0), b2, voffB); PG8_STAGE(PG8_SB(0, 1), b2 + hstepB, voffB); PG8_STAGE(PG8_SA(0, 0), a2, voffA);
            PG8_WAIT_V(8); PG8_WAIT_L(0); PG8_BAR; PG8_MMA(1, 0, At, B0); PG8_MMA(1, 1, At, B1); PG8_BAR; PG8_SCHED;
            PG8_LDB(B0, 1, 0); PG8_LDB(B1, 1, 1); PG8_SCHED; PG8_LDA(At, 1, 0); PG8_STAGE(PG8_SA(0, 1), a2 + hstepA, voffA);
            PG8_WAIT_V(8); PG8_WAIT_L(0); PG8_BAR; PG8_MMA(0, 0, At, B0); PG8_MMA(0, 1, At, B1); PG8_BAR; PG8_SCHED;
            PG8_LDA(At, 1, 1); PG8_STAGE(PG8_SB(1, 0), b3, voffB); PG8_STAGE(PG8_SB(1, 1), b3 + hstepB, voffB); PG8_STAGE(PG8_SA(1, 0), a3, voffA);
            PG8_WAIT_V(8); PG8_WAIT_L(0); PG8_BAR; PG8_MMA(1, 0, At, B0); PG8_MMA(1, 1, At, B1); PG8_BAR; PG8_SCHED;
            } else {
            PG8_LDB(B0, 0, 0); PG8_SCHED; PG8_LDA(At, 0, 0); PG8_STAGE(PG8_SA(1, 1), a1 + hstepA, voffA);
            PG8_WAIT_L(8); PG8_BAR; PG8_WAIT_L(0); PG8_MMA(0, 0, At, B0); PG8_BAR; PG8_SCHED;
            PG8_LDB(B1, 0, 1); PG8_STAGE(PG8_SB(0, 0), b2, voffB);
            PG8_BAR; PG8_WAIT_L(0); PG8_MMA(0, 1, At, B1); PG8_BAR;
            PG8_LDA(At, 0, 1); PG8_STAGE(PG8_SA(0, 0), a2, voffA);
            PG8_BAR; PG8_WAIT_L(0); PG8_MMA(1, 0, At, B0); PG8_BAR; PG8_SCHED;
            PG8_STAGE(PG8_SB(0, 1), b2 + hstepB, voffB);
            PG8_WAIT_V(6); PG8_BAR; PG8_MMA(1, 1, At, B1); PG8_BAR;
            PG8_LDB(B0, 1, 0); PG8_SCHED; PG8_LDA(At, 1, 0); PG8_STAGE(PG8_SA(0, 1), a2 + hstepA, voffA);
            PG8_WAIT_L(8); PG8_BAR; PG8_WAIT_L(0); PG8_MMA(0, 0, At, B0); PG8_BAR; PG8_SCHED;
            PG8_LDB(B1, 1, 1); PG8_STAGE(PG8_SB(1, 0), b3, voffB);
            PG8_BAR; PG8_WAIT_L(0); PG8_MMA(0, 1, At, B1); PG8_BAR;
            PG8_LDA(At, 1, 1); PG8_STAGE(PG8_SA(1, 0), a3, voffA);
            PG8_BAR; PG8_WAIT_L(0); PG8_MMA(1, 0, At, B0); PG8_BAR; PG8_SCHED;
            PG8_STAGE(PG8_SB(1, 1), b3 + hstepB, voffB);
            PG8_WAIT_V(6); PG8_BAR; PG8_MMA(1, 1, At, B1); PG8_BAR;
            }
        }
        if constexpr (ALIGN_EPI) { if (wr == 0) PG8_BAR; }
        if constexpr (!Epi::AFTER_DRAIN) { E(acc, cur, wr, wc, fr, fq); S.done(cur); }
        if (!has_next) break;
#pragma unroll
        for (int a = 0; a < 2; ++a)
#pragma unroll
            for (int b = 0; b < 2; ++b)
#pragma unroll
                for (int m = 0; m < 4; ++m)
#pragma unroll
                    for (int n = 0; n < 2; ++n) acc[a][b][m][n] = (f32x4){0.f, 0.f, 0.f, 0.f};
        cur = nxt; cA = nA; cB = nB; ++ui;
        if constexpr (ALIGN_EPI) { if (wr == 1) PG8_BAR; }
    }
    PG8_WAIT_V(0);
    if constexpr (!ALIGN_EPI) { if (wr == 0) PG8_BAR; }
    PG8_BAR;
    if constexpr (Epi::AFTER_DRAIN) { E.fused(acc, cur, wr, wc, fr, fq, lds, wid, lane); S.done(cur); }
#undef PG8_SA
#undef PG8_SB
#undef PG8_STAGE
#undef PG8_LDA
#undef PG8_LDB
#undef PG8_MMA
#undef PG8_WAIT_V
#undef PG8_WAIT_L
#undef PG8_BAR
#undef PG8_SCHED
}
}

#define GAS __attribute__((address_space(1)))
#define LAS __attribute__((address_space(3)))
typedef unsigned v4u __attribute__((ext_vector_type(4)));
typedef float f32x4 __attribute__((ext_vector_type(4)));
typedef GAS unsigned gu32;
#define RLX_AGENT __ATOMIC_RELAXED, __HIP_MEMORY_SCOPE_AGENT
#define LDS_WAIT() asm volatile("s_waitcnt lgkmcnt(0)" ::: "memory")
#define VM_WAIT() asm volatile("s_waitcnt vmcnt(0)" ::: "memory")
constexpr int NWAVES = 8;
constexpr int RING_BYTES = 131072, LDSCTL_OFF = RING_BYTES, MISC_OFF = LDSCTL_OFF + 320, LDS_BYTES = 147456;
constexpr int CW_BAR = 4096, CW_ADA = 16384  ;
__device__ __forceinline__ unsigned pk2(float lo, float hi) { return (unsigned)f2bf(lo) | ((unsigned)f2bf(hi) << 16); }

#define XB_TMO      128
#define XB_XCNT(j)  (256  + 64 * (j))
#define XB_XSUB(j)  (1280 + 64 * (j))
#define XB_XGEN(j)  (2304 + 64 * (j))
#define XB_TOP      3328
#define XB_TOPGEN   3392
#define XCD_BAR_WORDS 3456
#define XB_SPIN_CAP (1u << 18)

__device__ __forceinline__ unsigned xb_ld(unsigned* p)              { return __hip_atomic_load(p, __ATOMIC_RELAXED, __HIP_MEMORY_SCOPE_AGENT); }
__device__ __forceinline__ unsigned xb_add(unsigned* p, unsigned v) { return __hip_atomic_fetch_add(p, v, __ATOMIC_RELAXED, __HIP_MEMORY_SCOPE_AGENT); }
__device__ __forceinline__ unsigned xb_xcc_id() { return (unsigned)__builtin_amdgcn_s_getreg((3 << 11) | 20) & 0xFu; }
#define XB_SPIN(cond, bar) do { unsigned _sp = 0; while (cond) { __builtin_amdgcn_s_sleep(1); \
    if ((++_sp & 255u) == 0u) { if (xb_ld(&(bar)[XB_TMO])) break; if (_sp > XB_SPIN_CAP) { atomicAdd(&(bar)[XB_TMO], 1u); break; } } } } while (0)

struct XcdBarrier {
    unsigned* bar; unsigned x;
    volatile LAS unsigned* st;
};

__device__ __forceinline__ XcdBarrier xcd_barrier_post(unsigned* bar, volatile LAS unsigned* st) {
    XcdBarrier b; b.bar = bar; b.x = xb_xcc_id(); b.st = st;
    if (threadIdx.x == 0) (void)xb_add(&bar[XB_XCNT(b.x)], 1u);
    return b;
}
__device__ __forceinline__ void xcd_barrier_complete(unsigned* bar, unsigned x, unsigned& nloc, unsigned& nx) {
    const unsigned G = gridDim.x * gridDim.y * gridDim.z;
    unsigned sum, cnt, mine, sp = 0u;
    for (;;) {
        sum = 0u; cnt = 0u; mine = 0u;
#pragma unroll
        for (unsigned j = 0; j < 16; ++j) { const unsigned c = xb_ld(&bar[XB_XCNT(j)]); sum += c; cnt += (c > 0u) ? 1u : 0u; mine = (j == x) ? c : mine; }
        if (sum == G) break;
        __builtin_amdgcn_s_sleep(1);
        if ((++sp & 255u) == 0u) { if (xb_ld(&bar[XB_TMO])) break; if (sp > XB_SPIN_CAP) { atomicAdd(&bar[XB_TMO], 1u); break; } }
    }
    nloc = mine > 0u ? mine : 1u; nx = cnt > 0u ? cnt : 1u;
}

__device__ __forceinline__ void xcd_barrier(const XcdBarrier& b) {
    asm volatile("s_waitcnt vmcnt(0)" ::: "memory");
    __syncthreads();
    if (threadIdx.x == 0) {
        unsigned* bar = b.bar;
        __builtin_amdgcn_s_waitcnt(0);
        unsigned nloc = b.st[0], nx = b.st[1];
        if (nloc == 0u) { xcd_barrier_complete(bar, b.x, nloc, nx); b.st[0] = nloc; b.st[1] = nx; }
        const unsigned old = xb_add(&bar[XB_XSUB(b.x)], 1u);
        const unsigned gen = old / nloc;
        if (old + 1u == (gen + 1u) * nloc) {
            __builtin_amdgcn_fence(__ATOMIC_RELEASE, "agent");
            asm volatile("s_waitcnt vmcnt(0)" ::: "memory");
            const unsigned og = xb_add(&bar[XB_TOP], 1u);
            const unsigned tg = og / nx;
            if (og + 1u == (tg + 1u) * nx) xb_add(&bar[XB_TOPGEN], 1u);
            else XB_SPIN(xb_ld(&bar[XB_TOPGEN]) == tg, bar);
            __builtin_amdgcn_fence(__ATOMIC_ACQUIRE, "agent");
            xb_add(&bar[XB_XGEN(b.x)], 1u);
            asm volatile("s_waitcnt vmcnt(0)" ::: "memory");
        } else {
            XB_SPIN(xb_ld(&bar[XB_XGEN(b.x)]) == gen, bar);
            __builtin_amdgcn_fence(__ATOMIC_ACQUIRE, "agent");
            asm volatile("s_waitcnt vmcnt(0)" ::: "memory");
        }
    }
    __syncthreads();
}


__device__ __forceinline__ float wave_sum(float v) {
#pragma unroll
    for (int o = 1; o < 64; o <<= 1) v += __shfl_xor(v, o);
    return v;
}

struct Args { const void* in[24]; float* out; unsigned char* ws; int ph_lo, ph_hi; };

__device__ __forceinline__ void p0_ada(const float* c, const float* w_ada, const float* b_ada, float* part, float* mod, unsigned* cnt, int gw, int NGW, int lane) {
    for (int it = gw; it < 48 * 32; it += NGW) {
        const int cg = it % 48, ks = it / 48, k0 = ks * 64;
        const float c0 = siluf_(c[k0 + lane]), c1 = siluf_(c[DM + k0 + lane]);
        f32x4 a0 = {0.f, 0.f, 0.f, 0.f}, a1 = {0.f, 0.f, 0.f, 0.f};
        const f32x4* wp = (const f32x4*)(w_ada + (size_t)k0 * 12288 + cg * 256) + lane;
#pragma unroll 8
        for (int kk = 0; kk < 64; ++kk) { const f32x4 w = wp[(size_t)kk * 3072]; const float s0 = __shfl(c0, kk), s1 = __shfl(c1, kk); a0 += s0 * w; a1 += s1 * w; }
        f32x4* pp = (f32x4*)(part + (size_t)ks * 2 * 12288 + cg * 256) + lane;
        pp[0] = a0; pp[3072] = a1;
        VM_WAIT();
        __builtin_amdgcn_fence(__ATOMIC_RELEASE, "agent");
        VM_WAIT();
        unsigned t = 0; if (lane == 0) t = __hip_atomic_fetch_add(cnt + cg * 64, 1u, RLX_AGENT);
        t = __builtin_amdgcn_readfirstlane(t);
        if (t == 31u) {
            __builtin_amdgcn_fence(__ATOMIC_ACQUIRE, "agent");
            VM_WAIT();
            f32x4 s0 = *((const f32x4*)(b_ada + cg * 256) + lane), s1 = s0;
            for (int j = 0; j < 32; ++j) { const f32x4* q = (const f32x4*)(part + (size_t)j * 2 * 12288 + cg * 256) + lane; s0 += q[0]; s1 += q[3072]; }
            *((f32x4*)(mod + cg * 256) + lane) = s0; *((f32x4*)(mod + 12288 + cg * 256) + lane) = s1;
        }
    }
}
__device__ __forceinline__ void p0_cs(const int* pos, float2* cs, int gw, int NGW, int lane) {
    for (int it = gw; it < MTOK * 32 / 64; it += NGW) { const int idx = it * 64 + lane, m = idx >> 5, i = idx & 31;
        const float inv = 1.0f / powf(10000.0f, (float)(2 * i) / 64.0f); const float ang = (float)pos[m] * inv;
        float s, c; sincosf(ang, &s, &c); cs[idx] = make_float2(c, s); }
}
template <class SrcCol>
__device__ __forceinline__ void tr_item(const float* W, int K, int Nsrc, bf16_t* WT, LAS float* scr, int kb, int nb, int lane, SrcCol sc, const float* kgain, float scale) {
    const int k0 = 64 * kb, n0 = 32 * nb; const int ncol = sc(n0 + (lane & 31));
#pragma unroll 8
    for (int i = 0; i < 32; ++i) { const int kk = 2 * i + (lane >> 5); float v = ncol >= 0 ? W[(size_t)(k0 + kk) * Nsrc + ncol] : 0.f; if (kgain) v *= kgain[k0 + kk]; scr[kk * 33 + (lane & 31)] = v * scale; }
    LDS_WAIT(); asm volatile("" ::: "memory");
    const int c = lane & 7;
#pragma unroll
    for (int j = 0; j < 4; ++j) { const int n = (lane >> 3) + 8 * j; const LAS float* s = scr + (8 * c) * 33 + n;
        v4u o; o.x = pk2(s[0 * 33], s[1 * 33]); o.y = pk2(s[2 * 33], s[3 * 33]); o.z = pk2(s[4 * 33], s[5 * 33]); o.w = pk2(s[6 * 33], s[7 * 33]);
        *(v4u*)(WT + (size_t)(n0 + n) * K + k0 + 8 * c) = o; }
    LDS_WAIT(); asm volatile("" ::: "memory");
}
struct ScNat { int N; __device__ int operator()(int n) const { return n < N ? n : -1; } };
struct ScQ { __device__ int operator()(int n) const { const int h = n / 192, w = n % 192; if (w < 128) return n; const int p = w - 128, g = p >> 3, e = p & 7; return h * 192 + 128 + (e < 4 ? 4 * g + e : 32 + 4 * g + (e - 4)); } };
struct ScUp { __device__ int operator()(int n) const { const int pn = n >> 8, r = n & 255; return r < 128 ? 128 * pn + r : DFF + 128 * pn + (r - 128); } };
template <class SrcCol>
__device__ __forceinline__ void tr_matrix(const float* W, int K, int Nsrc, int Ndst, bf16_t* WT, LAS float* scr, int& cursor, int gw, int NGW, int lane, SrcCol sc, const float* kgain, float scale) {
    const int nblk = Ndst / 32, nitems = (K / 64) * nblk;
    int it = gw - cursor % NGW; if (it < 0) it += NGW;
    for (; it < nitems; it += NGW) tr_item(W, K, Nsrc, WT, scr, it / nblk, it % nblk, lane, sc, kgain, scale);
    cursor += nitems;
}

namespace pg8 {
struct EpiZ {
    static constexpr bool PERM = true, AFTER_DRAIN = false, APERM = false;
    bf16_t* Z; float* statq; float* statkv;
    __device__ __forceinline__ void operator()(const f32x4 (&acc)[2][2][4][2], const Unit& u, int wr, int wc, int fr, int fq) const {
        const int row0 = u.pm * BM + wr * 64 + fr, col0 = u.pn * BM + wc * 32 + 8 * fq;
#pragma unroll
        for (int ai = 0; ai < 2; ++ai)
#pragma unroll
            for (int m = 0; m < 4; ++m) { const int row = row0 + ai * HALF + m * 16; bf16_t* rowp = Z + (size_t)row * LDZ + col0; float ss = 0.f;
#pragma unroll
                for (int bj = 0; bj < 2; ++bj) { const f32x4 v0 = acc[ai][bj][m][0], v1 = acc[ai][bj][m][1];
                    u32x4 w; w.x = cvt_pk_bf16(v0[0], v0[1]); w.y = cvt_pk_bf16(v0[2], v0[3]); w.z = cvt_pk_bf16(v1[0], v1[1]); w.w = cvt_pk_bf16(v1[2], v1[3]);
                    *(u32x4*)(rowp + bj * HALF) = w;
                    ss += (v0[0] * v0[0] + v0[1] * v0[1]) + (v0[2] * v0[2] + v0[3] * v0[3]) + (v1[0] * v1[0] + v1[1] * v1[1]) + (v1[2] * v1[2] + v1[3] * v1[3]); }
                if (u.pn < 3) { ss += __shfl_xor(ss, 16); ss += __shfl_xor(ss, 32);
                    if (fq == 0) { if (u.pn < 2) statq[row * 8 + u.pn * 4 + wc] = ss; else statkv[row * 4 + wc] = ss; } } }
    }
};
}


namespace pg8 {
__device__ __forceinline__ u32x4 pack8(const f32x4 v0, const f32x4 v1) { u32x4 w; w.x = cvt_pk_bf16(v0[0], v0[1]); w.y = cvt_pk_bf16(v0[2], v0[3]); w.z = cvt_pk_bf16(v1[0], v1[1]); w.w = cvt_pk_bf16(v1[2], v1[3]); return w; }
__device__ __forceinline__ void unpack8(const u32x4 w, f32x4& a, f32x4& b) {
    a[0] = __uint_as_float(w.x << 16); a[1] = __uint_as_float(w.x & 0xffff0000u); a[2] = __uint_as_float(w.y << 16); a[3] = __uint_as_float(w.y & 0xffff0000u);
    b[0] = __uint_as_float(w.z << 16); b[1] = __uint_as_float(w.z & 0xffff0000u); b[2] = __uint_as_float(w.w << 16); b[3] = __uint_as_float(w.w & 0xffff0000u); }
struct EpiStoreB {
    static constexpr bool PERM = true, AFTER_DRAIN = false, APERM = false;
    bf16_t* C; int ldc;
    __device__ __forceinline__ void operator()(const f32x4 (&acc)[2][2][4][2], const Unit& u, int wr, int wc, int fr, int fq) const {
        const int row0 = u.pm * BM + wr * 64 + fr, col0 = u.pn * BM + wc * 32 + 8 * fq;
#pragma unroll
        for (int ai = 0; ai < 2; ++ai)
#pragma unroll
            for (int m = 0; m < 4; ++m) { bf16_t* rowp = C + (size_t)(row0 + ai * HALF + m * 16) * ldc + col0;
#pragma unroll
                for (int bj = 0; bj < 2; ++bj) *(u32x4*)(rowp + bj * HALF) = pack8(acc[ai][bj][m][0], acc[ai][bj][m][1]); }
    }
};
struct EpiQo {
    static constexpr bool PERM = true, AFTER_DRAIN = false, APERM = false;
    bf16_t* Q; const float* statq; const float2* cs;
    __device__ __forceinline__ void operator()(const f32x4 (&acc)[2][2][4][2], const Unit& u, int wr, int wc, int fr, int fq) const {
        const int row0 = u.pm * BM + wr * 64 + fr, col0 = u.pn * BM + wc * 32 + 8 * fq;
#pragma unroll
        for (int ai = 0; ai < 2; ++ai)
#pragma unroll
            for (int m = 0; m < 4; ++m) { const int row = row0 + ai * HALF + m * 16; bf16_t* rowp = Q + (size_t)row * 1536 + col0;
                const f32x4 s0 = *(const f32x4*)(statq + row * 8), s1 = *(const f32x4*)(statq + row * 8 + 4);
                const float rstd = rsqrtf(((s0[0] + s0[1]) + (s0[2] + s0[3]) + (s1[0] + s1[1]) + (s1[2] + s1[3])) * (1.f / 512.f) + EPSN);
#pragma unroll
                for (int bj = 0; bj < 2; ++bj) { f32x4 v0 = acc[ai][bj][m][0] * rstd, v1 = acc[ai][bj][m][1] * rstd;
                    const int hw = (u.pn * BM + bj * HALF + wc * 32) % 192;
                    if (hw >= 128) { const int g = ((hw - 128) >> 3) + fq; const float2* c = cs + row * 32 + 4 * g;
#pragma unroll
                        for (int j = 0; j < 4; ++j) { const float2 cc = c[j]; const float x1 = v0[j], x2 = v1[j]; v0[j] = x1 * cc.x - x2 * cc.y; v1[j] = x2 * cc.x + x1 * cc.y; } }
                    *(u32x4*)(rowp + bj * HALF) = pack8(v0, v1); } }
    }
};
struct EpiKVo {
    static constexpr bool PERM = true, AFTER_DRAIN = false, APERM = false;
    bf16_t* Kf; bf16_t* V; const float* statkv;
    __device__ __forceinline__ void operator()(const f32x4 (&acc)[2][2][4][2], const Unit& u, int wr, int wc, int fr, int fq) const {
        const int row0 = u.pm * BM + wr * 64 + fr, c0 = wc * 32 + 8 * fq;
#pragma unroll
        for (int ai = 0; ai < 2; ++ai)
#pragma unroll
            for (int m = 0; m < 4; ++m) { const int row = row0 + ai * HALF + m * 16;
                const f32x4 s0 = *(const f32x4*)(statkv + row * 4);
                const float rstd = rsqrtf(((s0[0] + s0[1]) + (s0[2] + s0[3])) * (1.f / 256.f) + EPSN);
                *(u32x4*)(Kf + (size_t)row * 1536 + u.pn * 192 + c0) = pack8(acc[ai][0][m][0] * rstd, acc[ai][0][m][1] * rstd);
                *(u32x4*)(V + (size_t)row * 1024 + u.pn * 128 + c0) = pack8(acc[ai][1][m][0] * rstd, acc[ai][1][m][1] * rstd); }
    }
};
struct EpiGateo {
    static constexpr bool PERM = true, AFTER_DRAIN = false, APERM = false;
    bf16_t* C; const bf16_t* z; int goff; const bf16_t* add;
    __device__ __forceinline__ void operator()(const f32x4 (&acc)[2][2][4][2], const Unit& u, int wr, int wc, int fr, int fq) const {
        const int row0 = u.pm * BM + wr * 64 + fr, col0 = u.pn * BM + wc * 32 + 8 * fq;
#pragma unroll
        for (int ai = 0; ai < 2; ++ai)
#pragma unroll
            for (int m = 0; m < 4; ++m) { const int row = row0 + ai * HALF + m * 16;
#pragma unroll
                for (int bj = 0; bj < 2; ++bj) { const int col = col0 + bj * HALF;
                    f32x4 g0, g1; unpack8(*(const u32x4*)(z + (size_t)row * LDZ + goff + col), g0, g1);
                    f32x4 v0 = acc[ai][bj][m][0], v1 = acc[ai][bj][m][1];
#pragma unroll
                    for (int j = 0; j < 4; ++j) { v0[j] *= sigmoidf_(g0[j]); v1[j] *= sigmoidf_(g1[j]); }
                    if (add) { f32x4 a0, a1; unpack8(*(const u32x4*)(add + (size_t)row * DM + col), a0, a1); v0 += a0; v1 += a1; }
                    *(u32x4*)(C + (size_t)row * DM + col) = pack8(v0, v1); } }
    }
};
}

__device__ __forceinline__ void ph_kpe(const bf16_t* z, bf16_t* Kf, const float2* cs, int gw, int NGW, int lane) {
    for (int m2 = gw; m2 < MTOK / 2; m2 += NGW) { const int m = m2 * 2 + (lane >> 5), i = lane & 31; const bf16_t* zr = z + (size_t)m * LDZ + OFF_KROPE;
        const float x1 = bf2f(zr[i]), x2 = bf2f(zr[32 + i]); const float2 c = cs[m * 32 + i];
        const bf16_t o1 = f2bf(x1 * c.x - x2 * c.y), o2 = f2bf(x2 * c.x + x1 * c.y); const int p1 = rope_pos(i), p2 = rope_pos(32 + i);
#pragma unroll
        for (int h = 0; h < 8; ++h) { Kf[(size_t)m * 1536 + h * 192 + 128 + p1] = o1; Kf[(size_t)m * 1536 + h * 192 + 128 + p2] = o2; } }
}
__device__ __forceinline__ void ph_glanorm(bf16_t* og, const bf16_t* z, const float* g, int gw, int NGW, int lane) {
    const f32x4 ga = *((const f32x4*)g + lane * 2), gb = *((const f32x4*)g + lane * 2 + 1);
    for (int it = gw; it < MTOK * 4; it += NGW) { const int m = it >> 2, h = it & 3; bf16_t* o = og + (size_t)m * DM + h * 512 + lane * 8;
        f32x4 a, b, za, zb; pg8::unpack8(*(const pg8::u32x4*)o, a, b); pg8::unpack8(*(const pg8::u32x4*)(z + (size_t)m * LDZ + OFF_GOG + h * 512 + lane * 8), za, zb);
        float s = (a[0] * a[0] + a[1] * a[1]) + (a[2] * a[2] + a[3] * a[3]) + (b[0] * b[0] + b[1] * b[1]) + (b[2] * b[2] + b[3] * b[3]);
        const float rstd = rsqrtf(wave_sum(s) * (1.f / 512.f) + EPSN);
#pragma unroll
        for (int j = 0; j < 4; ++j) { a[j] = a[j] * rstd * ga[j] * siluf_(za[j]); b[j] = b[j] * rstd * gb[j] * siluf_(zb[j]); }
        *(pg8::u32x4*)o = pg8::pack8(a, b); }
}
template <bool H2>
__device__ __forceinline__ void ph_resnorm(const float* xin, const bf16_t* y, const float* g1, const float* mod, int off_gate, float* xout, const float* g2, int off_shift, int off_scale, bf16_t* h2, int gw, int NGW, int lane) {
    for (int m = gw; m < MTOK; m += NGW) { const float* mb = mod + (m / SEQ) * 12288;
        f32x4 ya[4], yb[4]; float s = 0.f;
#pragma unroll
        for (int j = 0; j < 4; ++j) { pg8::unpack8(*(const pg8::u32x4*)(y + (size_t)m * DM + 8 * (lane + 64 * j)), ya[j], yb[j]);
            s += (ya[j][0] * ya[j][0] + ya[j][1] * ya[j][1]) + (ya[j][2] * ya[j][2] + ya[j][3] * ya[j][3]) + (yb[j][0] * yb[j][0] + yb[j][1] * yb[j][1]) + (yb[j][2] * yb[j][2] + yb[j][3] * yb[j][3]); }
        const float rstd = rsqrtf(wave_sum(s) * (1.f / DM) + EPSN); float s2 = 0.f;
#pragma unroll
        for (int j = 0; j < 4; ++j) { const int e = 8 * (lane + 64 * j);
            const f32x4 xa = *(const f32x4*)(xin + (size_t)m * DM + e), xb = *(const f32x4*)(xin + (size_t)m * DM + e + 4);
            ya[j] = xa + *(const f32x4*)(mb + off_gate + e) * (ya[j] * rstd * *(const f32x4*)(g1 + e));
            yb[j] = xb + *(const f32x4*)(mb + off_gate + e + 4) * (yb[j] * rstd * *(const f32x4*)(g1 + e + 4));
            *(f32x4*)(xout + (size_t)m * DM + e) = ya[j]; *(f32x4*)(xout + (size_t)m * DM + e + 4) = yb[j];
            s2 += (ya[j][0] * ya[j][0] + ya[j][1] * ya[j][1]) + (ya[j][2] * ya[j][2] + ya[j][3] * ya[j][3]) + (yb[j][0] * yb[j][0] + yb[j][1] * yb[j][1]) + (yb[j][2] * yb[j][2] + yb[j][3] * yb[j][3]); }
        if (H2) { const float r2 = rsqrtf(wave_sum(s2) * (1.f / DM) + EPSN);
#pragma unroll
            for (int j = 0; j < 4; ++j) { const int e = 8 * (lane + 64 * j);
                const f32x4 ha = ya[j] * r2 * *(const f32x4*)(g2 + e) * (1.f + *(const f32x4*)(mb + off_scale + e)) + *(const f32x4*)(mb + off_shift + e);
                const f32x4 hb = yb[j] * r2 * *(const f32x4*)(g2 + e + 4) * (1.f + *(const f32x4*)(mb + off_scale + e + 4)) + *(const f32x4*)(mb + off_shift + e + 4);
                *(pg8::u32x4*)(h2 + (size_t)m * DM + e) = pg8::pack8(ha, hb); } } }
}
__device__ __forceinline__ void ph_convact(const bf16_t* u, const float* cw, const float* cb, bf16_t* act, int gw, int NGW, int lane) {
    for (int m = gw; m < MTOK; m += NGW) { const int t = m % SEQ;
        for (int i = 0; i < 11; ++i) { const int j = 8 * (lane + 64 * i);
            f32x4 ca0 = *(const f32x4*)(cb + j), ca1 = *(const f32x4*)(cb + j + 4), cv0 = *(const f32x4*)(cb + DFF + j), cv1 = *(const f32x4*)(cb + DFF + j + 4);
#pragma unroll
            for (int k = 0; k < 3; ++k) { if (t - 2 + k >= 0) { const bf16_t* ur = u + (size_t)(m - 2 + k) * DFF2; f32x4 a0, a1, v0, v1;
                pg8::unpack8(*(const pg8::u32x4*)(ur + j), a0, a1); pg8::unpack8(*(const pg8::u32x4*)(ur + DFF + j), v0, v1);
                ca0 += *(const f32x4*)(cw + k * DFF2 + j) * a0; ca1 += *(const f32x4*)(cw + k * DFF2 + j + 4) * a1;
                cv0 += *(const f32x4*)(cw + k * DFF2 + DFF + j) * v0; cv1 += *(const f32x4*)(cw + k * DFF2 + DFF + j + 4) * v1; } }
#pragma unroll
            for (int q = 0; q < 4; ++q) { ca0[q] = gelu_tanh(ca0[q]) * cv0[q]; ca1[q] = gelu_tanh(ca1[q]) * cv1[q]; }
            *(pg8::u32x4*)(act + (size_t)m * DFF + j) = pg8::pack8(ca0, ca1); } }
}
namespace pg8 {
struct EpiU {
    static constexpr bool PERM = true, AFTER_DRAIN = false, APERM = false;
    bf16_t* U;
    __device__ __forceinline__ void operator()(const f32x4 (&acc)[2][2][4][2], const Unit& u, int wr, int wc, int fr, int fq) const {
        const int row0 = u.pm * BM + wr * 64 + fr, c0 = u.pn * 128 + wc * 32 + 8 * fq;
#pragma unroll
        for (int ai = 0; ai < 2; ++ai)
#pragma unroll
            for (int m = 0; m < 4; ++m) { bf16_t* rowp = U + (size_t)(row0 + ai * HALF + m * 16) * DFF2 + c0;
                *(u32x4*)(rowp) = pack8(acc[ai][0][m][0], acc[ai][0][m][1]); *(u32x4*)(rowp + DFF) = pack8(acc[ai][1][m][0], acc[ai][1][m][1]); }
    }
};
}
namespace att {
typedef short bf16x8 __attribute__((ext_vector_type(8)));
typedef short s16x4 __attribute__((ext_vector_type(4)));
typedef float f32x16 __attribute__((ext_vector_type(16)));
typedef __attribute__((address_space(3))) const unsigned char* lcp;
constexpr int KROW = 400, VROW = 320, KBYTES = 64 * KROW, VBYTES = 64 * VROW, BUFB = KBYTES + VBYTES;
constexpr size_t WS_ATTP = 396 * MiB, WS_ATTML = 412 * MiB;
__device__ __forceinline__ int crow(int r, int hi) { return (r & 3) + 8 * (r >> 2) + 4 * hi; }
__device__ __forceinline__ s16x4 vtr(lcp p) { typedef short v4i16_t __attribute__((ext_vector_type(4))); return __builtin_bit_cast(s16x4, __builtin_amdgcn_ds_read_tr16_b64_v4i16((__attribute__((address_space(3))) v4i16_t*)p)); }
__device__ __forceinline__ float hswap_max(float x) { auto rr = __builtin_amdgcn_permlane32_swap(__float_as_uint(x), __float_as_uint(x), false, false); return fmaxf(__uint_as_float(rr[0]), __uint_as_float(rr[1])); }
__device__ __forceinline__ float hswap_add(float x) { auto rr = __builtin_amdgcn_permlane32_swap(__float_as_uint(x), __float_as_uint(x), false, false); return __uint_as_float(rr[0]) + __uint_as_float(rr[1]); }
__device__ __forceinline__ bf16x8 packp(const f32x16& p, int b) { pg8::u32x4 w; w.x = pg8::cvt_pk_bf16(p[b], p[b + 1]); w.y = pg8::cvt_pk_bf16(p[b + 2], p[b + 3]); w.z = pg8::cvt_pk_bf16(p[b + 4], p[b + 5]); w.w = pg8::cvt_pk_bf16(p[b + 6], p[b + 7]); return __builtin_bit_cast(bf16x8, w); }

__device__ __forceinline__ void segment(LAS unsigned char* L, const bf16_t* Q, const bf16_t* Kf, const bf16_t* V, int b, int h, int qblk, int t0, int t1, bf16_t* outp, int ostride, float2* ml, int wave, int lane_) {
    const int tid = fresh_tid(), lane = tid & 63, r32 = lane & 31, hh = lane >> 5;
    const size_t rowbase = (size_t)b * SEQ; const int R0 = qblk * 256, qrow = R0 + 32 * wave + r32;
    bf16x8 qf[12];
    { const bf16_t* qp = Q + (rowbase + qrow) * 1536 + h * 192 + 8 * hh;
#pragma unroll
      for (int d0 = 0; d0 < 12; ++d0) qf[d0] = *(const bf16x8*)(qp + 16 * d0); }
    f32x16 O[4];
#pragma unroll
    for (int d0 = 0; d0 < 4; ++d0)
#pragma unroll
        for (int r = 0; r < 16; ++r) O[d0][r] = 0.f;
    float m = -1e30f, l = 0.f;
    const int srow = tid >> 3, sch = tid & 7;
    const int kgo = srow * 1536 + sch * 8, klo = srow * KROW + sch * 16, vgo = srow * 1024 + sch * 8, vlo = KBYTES + srow * VROW + sch * 16;
    const bf16_t* Kh = Kf + rowbase * 1536 + h * 192; const bf16_t* Vh = V + rowbase * 1024 + h * 128;
    pg8::u32x4 sk[3], sv[2];
#define ATT_LOAD(t) do { _Pragma("unroll") for (int i = 0; i < 3; ++i) sk[i] = *(const pg8::u32x4*)(Kh + (size_t)(t) * 64 * 1536 + kgo + 64 * i); \
                         _Pragma("unroll") for (int i = 0; i < 2; ++i) sv[i] = *(const pg8::u32x4*)(Vh + (size_t)(t) * 64 * 1024 + vgo + 64 * i); } while (0)
#define ATT_WRITE(buf) do { _Pragma("unroll") for (int i = 0; i < 3; ++i) *(LAS pg8::u32x4*)(L + (buf) * BUFB + klo + 128 * i) = sk[i]; \
                            _Pragma("unroll") for (int i = 0; i < 2; ++i) *(LAS pg8::u32x4*)(L + (buf) * BUFB + vlo + 128 * i) = sv[i]; } while (0)
    ATT_LOAD(t0); ATT_WRITE(0); __syncthreads();
    int cur = 0;
    for (int t = t0; t < t1; ++t) {
        const bool more = (t + 1 < t1);
        if (more) ATT_LOAD(t + 1);
        if (64 * t <= R0 + 32 * wave + 31) {
            lcp Kb = (lcp)(L + cur * BUFB); lcp Vb = Kb + KBYTES;
            f32x16 p0, p1;
#pragma unroll
            for (int r = 0; r < 16; ++r) { p0[r] = 0.f; p1[r] = 0.f; }
            lcp ka = Kb + r32 * KROW + hh * 16;
#pragma unroll
            for (int d0 = 0; d0 < 12; ++d0) { const bf16x8 k0 = *(const __attribute__((address_space(3))) bf16x8*)(ka + d0 * 32), k1 = *(const __attribute__((address_space(3))) bf16x8*)(ka + 32 * KROW + d0 * 32);
                p0 = __builtin_amdgcn_mfma_f32_32x32x16_bf16(k0, qf[d0], p0, 0, 0, 0); p1 = __builtin_amdgcn_mfma_f32_32x32x16_bf16(k1, qf[d0], p1, 0, 0, 0); }
            if (64 * t + 63 > R0 + 32 * wave) {
                const float NEG = -__builtin_inff();
#pragma unroll
                for (int r = 0; r < 16; ++r) { const int key = 64 * t + crow(r, hh); if (key > qrow) p0[r] = NEG; if (key + 32 > qrow) p1[r] = NEG; }
            }
            float mx = fmaxf(p0[0], p1[0]);
#pragma unroll
            for (int r = 1; r < 16; ++r) mx = fmaxf(mx, fmaxf(p0[r], p1[r]));
            mx = hswap_max(mx);
            if (__any(mx > m)) { const float mn = fmaxf(m, mx), alpha = __builtin_amdgcn_exp2f(m - mn); m = mn; l *= alpha;
#pragma unroll
                for (int d0 = 0; d0 < 4; ++d0)
#pragma unroll
                    for (int r = 0; r < 16; ++r) O[d0][r] *= alpha; }
            float ps = 0.f;
#pragma unroll
            for (int r = 0; r < 16; ++r) { p0[r] = __builtin_amdgcn_exp2f(p0[r] - m); p1[r] = __builtin_amdgcn_exp2f(p1[r] - m); ps += p0[r] + p1[r]; }
            l += ps;
            bf16x8 pf[4]; pf[0] = packp(p0, 0); pf[1] = packp(p0, 8); pf[2] = packp(p1, 0); pf[3] = packp(p1, 8);
            lcp va = Vb + (4 * hh + ((lane & 15) >> 2)) * VROW + (16 * ((lane >> 4) & 1) + 4 * (lane & 3)) * 2;
#pragma unroll
            for (int d0 = 0; d0 < 4; ++d0)
#pragma unroll
                for (int ks = 0; ks < 4; ++ks) { const s16x4 lo = vtr(va + (16 * ks) * VROW + 64 * d0), hi = vtr(va + (16 * ks + 8) * VROW + 64 * d0);
                    const bf16x8 vf = {lo[0], lo[1], lo[2], lo[3], hi[0], hi[1], hi[2], hi[3]};
                    O[d0] = __builtin_amdgcn_mfma_f32_32x32x16_bf16(vf, pf[ks], O[d0], 0, 0, 0); }
        }
        if (more) ATT_WRITE(cur ^ 1);
        __syncthreads();
        cur ^= 1;
    }
#undef ATT_LOAD
#undef ATT_WRITE
    const float lt = hswap_add(l), inv = lt > 0.f ? 1.f / lt : 0.f;
    bf16_t* op = outp + (size_t)(32 * wave + r32) * ostride + 4 * hh;
#pragma unroll
    for (int d0 = 0; d0 < 4; ++d0)
#pragma unroll
        for (int g = 0; g < 4; ++g) { uint2 w; w.x = pg8::cvt_pk_bf16(O[d0][4 * g] * inv, O[d0][4 * g + 1] * inv); w.y = pg8::cvt_pk_bf16(O[d0][4 * g + 2] * inv, O[d0][4 * g + 3] * inv);
            *(uint2*)(op + 32 * d0 + 8 * g) = w; }
    if (ml && hh == 0) ml[32 * wave + r32] = make_float2(m, lt);
}
__device__ __forceinline__ void phase(LAS unsigned char* L, const bf16_t* Q, const bf16_t* Kf, const bf16_t* V, bf16_t* om, unsigned char* ws, int vcu, int G, int wave, int lane) {
    bf16_t* PO = (bf16_t*)(ws + WS_ATTP); float2* PML = (float2*)(ws + WS_ATTML);
    for (int c = vcu; c < 256; c += G) { const int bh = c >> 4, k = c & 15, qb = k >> 1, role = k & 1, H = 15 - qb, b = bh >> 3, h = bh & 7, hu = bh * 8 + (H - 8);
        if (role == 0) segment(L, Q, Kf, V, b, h, H, 0, 34, PO + (size_t)(0 * 128 + hu) * 256 * 128, 128, PML + (0 * 128 + hu) * 256, wave, lane);
        else { segment(L, Q, Kf, V, b, h, H, 34, 4 * H + 4, PO + (size_t)(1 * 128 + hu) * 256 * 128, 128, PML + (1 * 128 + hu) * 256, wave, lane);
               segment(L, Q, Kf, V, b, h, qb, 0, 4 * qb + 4, om + ((size_t)b * SEQ + 256 * qb) * 1024 + h * 128, 1024, nullptr, wave, lane); } }
}
__device__ __forceinline__ void combine(bf16_t* om, unsigned char* ws, int gw, int NGW, int lane) {
    const bf16_t* PO = (const bf16_t*)(ws + WS_ATTP); const float2* PML = (const float2*)(ws + WS_ATTML);
    for (int it = gw; it < 128 * 256; it += NGW) { const int hu = it >> 8, row = it & 255, bh = hu >> 3, H = 8 + (hu & 7), b = bh >> 3, h = bh & 7;
        const float2 a = PML[(0 * 128 + hu) * 256 + row], c = PML[(1 * 128 + hu) * 256 + row]; const float mm = fmaxf(a.x, c.x);
        const float w0 = a.y * __builtin_amdgcn_exp2f(a.x - mm), w1 = c.y * __builtin_amdgcn_exp2f(c.x - mm), inv = 1.f / (w0 + w1);
        const unsigned u0 = *(const unsigned*)(PO + ((size_t)(0 * 128 + hu) * 256 + row) * 128 + 2 * lane), u1 = *(const unsigned*)(PO + ((size_t)(1 * 128 + hu) * 256 + row) * 128 + 2 * lane);
        const float o0 = (w0 * __uint_as_float(u0 << 16) + w1 * __uint_as_float(u1 << 16)) * inv, o1 = (w0 * __uint_as_float(u0 & 0xffff0000u) + w1 * __uint_as_float(u1 & 0xffff0000u)) * inv;
        *(unsigned*)(om + ((size_t)b * SEQ + 256 * H + row) * 1024 + h * 128 + 2 * lane) = pg8::cvt_pk_bf16(o0, o1); }
}
}
namespace gla {
typedef short bf16x8 __attribute__((ext_vector_type(8)));
typedef float f32x16 __attribute__((ext_vector_type(16)));
typedef __attribute__((address_space(3))) const unsigned char* lcp;
constexpr size_t WS_QBP = 32 * MiB, WS_KLT = 48 * MiB, WS_AMAT = 64 * MiB, WS_EBL = 68 * MiB, WS_VT = 252 * MiB;
constexpr int PROW = 528;
constexpr int L_GL = 0, L_TOT = 4096, L_BLAST = 5120, L_QB = 8192, L_KB = L_QB + 64 * PROW, L_VS = L_KB + 64 * PROW;
__device__ __forceinline__ int crow(int r, int hi) { return (r & 3) + 8 * (r >> 2) + 4 * hi; }
__device__ __forceinline__ unsigned pk(float lo, float hi) { return pg8::cvt_pk_bf16(lo, hi); }
__device__ __forceinline__ bf16x8 packs(const f32x16& p, int b) { pg8::u32x4 w; w.x = pk(p[b], p[b + 1]); w.y = pk(p[b + 2], p[b + 3]); w.z = pk(p[b + 4], p[b + 5]); w.w = pk(p[b + 6], p[b + 7]); return __builtin_bit_cast(bf16x8, w); }

__device__ __forceinline__ void prep_item(LAS unsigned char* L, const bf16_t* z, const float* wg, const float* bg, unsigned char* ws, int bh, int c, int wave, int lane_) {
    const int tid = fresh_tid(), lane = tid & 63, b = bh >> 2, h = bh & 3; const size_t rb = (size_t)b * SEQ + 64 * c; const int ic = bh * 64 + c;
    bf16_t* qbp = (bf16_t*)(ws + WS_QBP); bf16_t* klT = (bf16_t*)(ws + WS_KLT); bf16_t* Amat = (bf16_t*)(ws + WS_AMAT); float* ebl = (float*)(ws + WS_EBL); bf16_t* vT = (bf16_t*)(ws + WS_VT);
    LAS float* GL = (LAS float*)(L + L_GL); LAS float* TOT = (LAS float*)(L + L_TOT); LAS float* BLAST = (LAS float*)(L + L_BLAST);
    for (int i = 0; i < 2; ++i) { const int idx = tid + 512 * i, tok = idx >> 4, r = idx & 15; GL[idx] = bf2f(z[(rb + tok) * LDZ + OFF_GLR + r]); }
    __syncthreads();
    const int d = tid & 255, half = tid >> 8;
    float wgc[16];
#pragma unroll
    for (int r = 0; r < 16; ++r) wgc[r] = wg[r * 1024 + h * 256 + d];
    const float bias = bg[h * 256 + d];
    float bl[32]; float run = 0.f;
#pragma unroll
    for (int i = 0; i < 32; ++i) { const int tok = 32 * half + i; float xg = bias;
#pragma unroll
        for (int r = 0; r < 16; ++r) xg += GL[tok * 16 + r] * wgc[r];
        const float ls = fminf(xg, 0.f) - __logf(1.f + __expf(-fabsf(xg)));
        run += ls * (1.f / 16.f); bl[i] = run; }
    if (half == 0) TOT[d] = run;
    __syncthreads();
    if (half == 1) { const float t0 = TOT[d];
#pragma unroll
        for (int i = 0; i < 32; ++i) bl[i] += t0;
        BLAST[d] = bl[31]; }
    __syncthreads();
    const float blast = BLAST[d];
    if (half == 0) ebl[ic * 256 + d] = __expf(blast);
#pragma unroll
    for (int g = 0; g < 4; ++g) { float klv[8];
#pragma unroll
        for (int j = 0; j < 8; ++j) { const int i = 8 * g + j, tok = 32 * half + i; const bf16_t* zr = z + (rb + tok) * LDZ;
            const float qv = bf2f(zr[OFF_GQ + h * 256 + d]), kv = bf2f(zr[OFF_GK + h * 256 + d]);
            *(LAS bf16_t*)(L + L_QB + tok * PROW + d * 2) = f2bf(qv * 0.0625f * __expf(bl[i]));
            *(LAS bf16_t*)(L + L_KB + tok * PROW + d * 2) = f2bf(kv * __expf(-bl[i]));
            klv[j] = kv * __expf(blast - bl[i]); }
        pg8::u32x4 w; w.x = pk(klv[0], klv[1]); w.y = pk(klv[2], klv[3]); w.z = pk(klv[4], klv[5]); w.w = pk(klv[6], klv[7]);
        *(pg8::u32x4*)(klT + ((size_t)ic * 256 + d) * 64 + 32 * half + 8 * g) = w; }
    __syncthreads();
#pragma unroll
    for (int i = 0; i < 4; ++i) { const int q = tid + 512 * i, tok = q >> 5, ch = q & 31, gi = ch >> 1, hq = ch & 1;
        typedef unsigned u32x2_t __attribute__((ext_vector_type(2))); const u32x2_t lo = *(const LAS u32x2_t*)(L + L_QB + tok * PROW + (16 * gi + 4 * hq) * 2), hi = *(const LAS u32x2_t*)(L + L_QB + tok * PROW + (16 * gi + 8 + 4 * hq) * 2);
        pg8::u32x4 w; w.x = lo.x; w.y = lo.y; w.z = hi.x; w.w = hi.y;
        *(pg8::u32x4*)(qbp + (rb + tok) * 1024 + h * 256 + 16 * gi + 8 * hq) = w; }
    if (wave < 4) { const int ti = wave >> 1, tj = wave & 1, r32 = lane & 31, hh = lane >> 5; f32x16 C;
#pragma unroll
        for (int r = 0; r < 16; ++r) C[r] = 0.f;
        if (tj <= ti) { lcp ka = (lcp)(L + L_KB + (32 * tj + r32) * PROW + hh * 16); lcp qa = (lcp)(L + L_QB + (32 * ti + r32) * PROW + hh * 16);
#pragma unroll
            for (int s = 0; s < 16; ++s) { const bf16x8 kf = *(const __attribute__((address_space(3))) bf16x8*)(ka + s * 32), qf = *(const __attribute__((address_space(3))) bf16x8*)(qa + s * 32);
                C = __builtin_amdgcn_mfma_f32_32x32x16_bf16(kf, qf, C, 0, 0, 0); } }
        const int irow = 32 * ti + r32;
#pragma unroll
        for (int g = 0; g < 4; ++g) { float v[4];
#pragma unroll
            for (int q = 0; q < 4; ++q) { const int j = 32 * tj + crow(4 * g + q, hh); v[q] = (j <= irow) ? C[4 * g + q] : 0.f; }
            uint2 w; w.x = pk(v[0], v[1]); w.y = pk(v[2], v[3]);
            *(uint2*)(Amat + ((size_t)ic * 64 + irow) * 64 + 32 * tj + 8 * g + 4 * hh) = w; } }
    for (int e0 = 0; e0 < 512; e0 += 256) {
#pragma unroll
        for (int i = 0; i < 4; ++i) { const int q = tid + 512 * i, tok = q >> 5, ch = q & 31;
            *(LAS pg8::u32x4*)(L + L_VS + tok * PROW + ch * 16) = *(const pg8::u32x4*)(z + (rb + tok) * LDZ + OFF_GV + h * 512 + e0 + ch * 8); }
        __syncthreads();
#pragma unroll
        for (int g = 0; g < 4; ++g) { unsigned short t8[8];
#pragma unroll
            for (int j = 0; j < 8; ++j) t8[j] = *(const LAS bf16_t*)(L + L_VS + (32 * half + 8 * g + j) * PROW + d * 2);
            pg8::u32x4 w; w.x = t8[0] | ((unsigned)t8[1] << 16); w.y = t8[2] | ((unsigned)t8[3] << 16); w.z = t8[4] | ((unsigned)t8[5] << 16); w.w = t8[6] | ((unsigned)t8[7] << 16);
            *(pg8::u32x4*)(vT + ((size_t)ic * 512 + e0 + d) * 64 + 32 * half + 8 * g) = w; }
        __syncthreads();
    }
}
__device__ __forceinline__ void prep_phase(LAS unsigned char* L, const bf16_t* z, const float* wg, const float* bg, unsigned char* ws, int vcu, int G, int wave, int lane) {
    for (int it = vcu; it < 512; it += G) prep_item(L, z, wg, bg, ws, it >> 6, it & 63, wave, lane);
}
__device__ __forceinline__ void scan_phase(unsigned char* ws, bf16_t* og, int vcu, int wave, int lane_) {
    if (vcu >= 16) return;
    const int lane = fresh_tid() & 63;
    const bf16_t* qbp = (const bf16_t*)(ws + WS_QBP); const bf16_t* klT = (const bf16_t*)(ws + WS_KLT); const bf16_t* Amat = (const bf16_t*)(ws + WS_AMAT); const float* ebl = (const float*)(ws + WS_EBL); const bf16_t* vT = (const bf16_t*)(ws + WS_VT);
    const int item = vcu * 8 + wave, bh = item >> 4, slice = item & 15, b = bh >> 2, h = bh & 3, r32 = lane & 31, hh = lane >> 5;
    f32x16 S[8];
#pragma unroll
    for (int dt = 0; dt < 8; ++dt)
#pragma unroll
        for (int r = 0; r < 16; ++r) S[dt][r] = 0.f;
    for (int c = 0; c < 64; ++c) { const size_t rb = (size_t)b * SEQ + 64 * c; const int ic = bh * 64 + c;
        bf16x8 vf[4];
#pragma unroll
        for (int ks = 0; ks < 4; ++ks) vf[ks] = *(const bf16x8*)(vT + ((size_t)ic * 512 + 32 * slice + r32) * 64 + 16 * ks + 8 * hh);
        f32x16 OT[2];
#pragma unroll
        for (int r = 0; r < 16; ++r) { OT[0][r] = 0.f; OT[1][r] = 0.f; }
        const bf16_t* qrow0 = qbp + (rb + r32) * 1024 + h * 256 + 8 * hh; const bf16_t* qrow1 = qrow0 + 32 * 1024;
#pragma unroll
        for (int dt = 0; dt < 8; ++dt)
#pragma unroll
            for (int s = 0; s < 2; ++s) { const bf16x8 sf = packs(S[dt], 8 * s);
                const bf16x8 q0 = *(const bf16x8*)(qrow0 + 32 * dt + 16 * s), q1 = *(const bf16x8*)(qrow1 + 32 * dt + 16 * s);
                OT[0] = __builtin_amdgcn_mfma_f32_32x32x16_bf16(sf, q0, OT[0], 0, 0, 0); OT[1] = __builtin_amdgcn_mfma_f32_32x32x16_bf16(sf, q1, OT[1], 0, 0, 0); }
        const bf16_t* arow0 = Amat + ((size_t)ic * 64 + r32) * 64 + 8 * hh; const bf16_t* arow1 = arow0 + 32 * 64;
#pragma unroll
        for (int ks = 0; ks < 4; ++ks) { if (ks < 2) OT[0] = __builtin_amdgcn_mfma_f32_32x32x16_bf16(vf[ks], *(const bf16x8*)(arow0 + 16 * ks), OT[0], 0, 0, 0);
            OT[1] = __builtin_amdgcn_mfma_f32_32x32x16_bf16(vf[ks], *(const bf16x8*)(arow1 + 16 * ks), OT[1], 0, 0, 0); }
#pragma unroll
        for (int i = 0; i < 2; ++i)
#pragma unroll
            for (int g = 0; g < 4; ++g) { uint2 w; w.x = pk(OT[i][4 * g], OT[i][4 * g + 1]); w.y = pk(OT[i][4 * g + 2], OT[i][4 * g + 3]);
                *(uint2*)(og + (rb + 32 * i + r32) * DM + h * 512 + 32 * slice + 8 * g + 4 * hh) = w; }
#pragma unroll
        for (int dt = 0; dt < 8; ++dt) {
#pragma unroll
            for (int g = 0; g < 4; ++g) { const f32x4 e = *(const f32x4*)(ebl + ic * 256 + 32 * dt + 8 * g + 4 * hh);
#pragma unroll
                for (int q = 0; q < 4; ++q) S[dt][4 * g + q] *= e[q]; }
#pragma unroll
            for (int ks = 0; ks < 4; ++ks) { const bf16x8 kf = *(const bf16x8*)(klT + ((size_t)ic * 256 + 32 * dt + r32) * 64 + 16 * ks + 8 * hh);
                S[dt] = __builtin_amdgcn_mfma_f32_32x32x16_bf16(kf, vf[ks], S[dt], 0, 0, 0); } }
    }
}
}
#ifndef DBG_SCAN
#define DBG_SCAN 0
#endif
#if DBG_SCAN
#define DBG_SCAN_OUT ((bf16_t*)(ws + WS_Q))
#else
#define DBG_SCAN_OUT og
#endif
constexpr size_t WS_WUP = WS_WIN, WS_WDN = 396 * MiB, WS_U = WS_Z;
__global__ void __launch_bounds__(NWAVES * 64, 2) mk_fwd(Args args) {
    extern __shared__ __attribute__((aligned(16))) unsigned char lds[];
    LAS unsigned char* L = (LAS unsigned char*)lds;
    volatile LAS unsigned* MISC = (volatile LAS unsigned*)(L + MISC_OFF);
    const int tid = threadIdx.x, wave = __builtin_amdgcn_readfirstlane(tid >> 6);
#define FL (fresh_tid() & 63)
    const int G = gridDim.x, bx = blockIdx.x; const int vcu = (G % 8 == 0) ? (bx % 8) * (G / 8) + bx / 8 : bx;
    const int gw = vcu * NWAVES + wave, NGW = G * NWAVES;
    unsigned char* ws = args.ws;
    gu32* ctl = (gu32*)(ws + WS_CTL);
    for (int u = tid; u < (LDS_BYTES - LDSCTL_OFF) / 4; u += NWAVES * 64) ((LAS unsigned*)(L + LDSCTL_OFF))[u] = 0u;
    __syncthreads();
    XcdBarrier bar = xcd_barrier_post((unsigned*)(ctl + CW_BAR), MISC + 8);
    const int lo = args.ph_lo, hi = args.ph_hi;
#define IN(k) (lo <= (k) && (k) < hi)
#define SEAM(k) do { if (IN(k) && IN((k) + 1)) xcd_barrier(bar); } while (0)
    const float* x = (const float*)args.in[0]; float* out = args.out;
    float* mod = (float*)(ws + WS_MOD); float2* cs = (float2*)(ws + WS_CS);
    float* statq = (float*)(ws + WS_RSTD); float* statkv = statq + MTOK * 8;
    bf16_t* hbuf = (bf16_t*)(ws + WS_H); bf16_t* z = (bf16_t*)(ws + WS_Z);
    bf16_t* Win_t = (bf16_t*)(ws + WS_WIN); bf16_t* Wq_t = (bf16_t*)(ws + WS_WQ); bf16_t* Wkv_t = (bf16_t*)(ws + WS_WKV);
    bf16_t* Wa_t = (bf16_t*)(ws + WS_WA); bf16_t* Wb_t = (bf16_t*)(ws + WS_WB); bf16_t* Wmix_t = (bf16_t*)(ws + WS_WMIX);
    bf16_t* Wup_t = (bf16_t*)(ws + WS_WUP); bf16_t* Wdn_t = (bf16_t*)(ws + WS_WDN);
    bf16_t* Q = (bf16_t*)(ws + WS_Q); bf16_t* Kf = (bf16_t*)(ws + WS_K); bf16_t* V = (bf16_t*)(ws + WS_V);
    bf16_t* om = (bf16_t*)(ws + WS_OM); bf16_t* og = (bf16_t*)(ws + WS_OG); bf16_t* t1 = (bf16_t*)(ws + WS_T1); bf16_t* merged = (bf16_t*)(ws + WS_MERGED);
    bf16_t* y = (bf16_t*)(ws + WS_Y); bf16_t* h2 = (bf16_t*)(ws + WS_H); bf16_t* act = (bf16_t*)(ws + WS_ACT_N); bf16_t* ubuf = (bf16_t*)(ws + WS_U); bf16_t* f = (bf16_t*)(ws + WS_F);

    if (IN(0)) { const int lane = FL;
        p0_ada((const float*)args.in[1], (const float*)args.in[3], (const float*)args.in[4], (float*)(ws + WS_PART), mod, (unsigned*)(ctl + CW_ADA), gw, NGW, FL);
        p0_cs((const int*)args.in[2], cs, gw, NGW, FL);
        LAS float* scr = (LAS float*)(L + wave * 16384);
        int cursor = 0;
        tr_matrix((const float*)args.in[6], DM, DIN, LDZ, Win_t, scr, cursor, gw, NGW, lane, ScNat{DIN}, nullptr, 1.f);
        tr_matrix((const float*)args.in[8], 512, 1536, 1536, Wq_t, scr, cursor, gw, NGW, lane, ScQ{}, (const float*)args.in[7], QK_C2);
        tr_matrix((const float*)args.in[10], 256, 2048, 2048, Wkv_t, scr, cursor, gw, NGW, lane, ScNat{2048}, (const float*)args.in[9], 1.f);
        tr_matrix((const float*)args.in[14], 1024, DM, DM, Wa_t, scr, cursor, gw, NGW, lane, ScNat{DM}, nullptr, 1.f);
        tr_matrix((const float*)args.in[15], DM, DM, DM, Wb_t, scr, cursor, gw, NGW, lane, ScNat{DM}, nullptr, 1.f);
        tr_matrix((const float*)args.in[16], DM, DM, DM, Wmix_t, scr, cursor, gw, NGW, lane, ScNat{DM}, nullptr, 1.f);
    }
    SEAM(0);
    if (IN(1)) {
        const float* g = (const float*)args.in[5]; const int lane = FL;
        for (int m = gw; m < MTOK; m += NGW) { const int b = m / SEQ; const f32x4* xr = (const f32x4*)(x + (size_t)m * DM) + lane;
            f32x4 v[8]; float s = 0.f;
#pragma unroll
            for (int j = 0; j < 8; ++j) { v[j] = xr[64 * j]; s += (v[j].x * v[j].x + v[j].y * v[j].y) + (v[j].z * v[j].z + v[j].w * v[j].w); }
            const float rstd = rsqrtf(wave_sum(s) * (1.f / DM) + EPSN);
            const f32x4* gp = (const f32x4*)g + lane; const f32x4* shp = (const f32x4*)(mod + b * 12288) + lane; const f32x4* scp = (const f32x4*)(mod + b * 12288 + 2048) + lane;
            unsigned long long* o8 = (unsigned long long*)(hbuf + (size_t)m * DM) + lane;
#pragma unroll
            for (int j = 0; j < 8; ++j) { const f32x4 r = v[j] * rstd * gp[64 * j] * (1.f + scp[64 * j]) + shp[64 * j];
                o8[64 * j] = (unsigned long long)pk2(r.x, r.y) | ((unsigned long long)pk2(r.z, r.w) << 32); } }
    }
    SEAM(1);
    if (IN(2)) {
        pg8::Gemm g{hbuf, Win_t, MTOK, LDZ, DM, DM}; pg8::StaticOrder S; S.init(MTOK, LDZ, G, bx);
        pg8::EpiZ E{z, statq, statkv};
        pg8::gemm_phase<pg8::EpiZ, pg8::StaticOrder, true, true>(L, g, S, E);
    }
    SEAM(2);
    if (IN(3)) {
        { pg8::Gemm g{z + OFF_QLAT, Wq_t, MTOK, 1536, 512, LDZ}; pg8::StaticOrder S; S.init(MTOK, 1536, G, bx);
          pg8::EpiQo E{Q, statq, cs}; pg8::gemm_phase<pg8::EpiQo, pg8::StaticOrder, true, true>(L, g, S, E); }
        { pg8::Gemm g{z + OFF_KVLAT, Wkv_t, MTOK, 2048, 256, LDZ}; pg8::StaticOrder S; S.init(MTOK, 2048, G, bx);
          pg8::EpiKVo E{Kf, V, statkv}; pg8::gemm_phase<pg8::EpiKVo, pg8::StaticOrder, true, true>(L, g, S, E); }
        ph_kpe(z, Kf, cs, gw, NGW, FL);
    }
    SEAM(3);
    if (IN(4)) gla::prep_phase(L, z, (const float*)args.in[11], (const float*)args.in[12], ws, vcu, G, wave, FL);
    SEAM(4);
    if (IN(5)) att::phase(L, Q, Kf, V, om, ws, vcu, G, wave, FL);
    SEAM(5);
    if (IN(6)) gla::scan_phase(ws, DBG_SCAN_OUT, vcu, wave, FL);
    SEAM(6);
    if (IN(7)) { att::combine(om, ws, gw, NGW, FL); ph_glanorm(og, z, (const float*)args.in[13], gw, NGW, FL); }
    SEAM(7);
    if (IN(8)) {
        { pg8::Gemm g{om, Wa_t, MTOK, DM, 1024, 1024}; pg8::StaticOrder S; S.init(MTOK, DM, G, bx);
          pg8::EpiGateo E{t1, z, OFF_GA, nullptr}; pg8::gemm_phase<pg8::EpiGateo, pg8::StaticOrder, true, true>(L, g, S, E); }
        { pg8::Gemm g{og, Wb_t, MTOK, DM, DM, DM}; pg8::StaticOrder S; S.init(MTOK, DM, G, bx);
          pg8::EpiGateo E{merged, z, OFF_GB, t1}; pg8::gemm_phase<pg8::EpiGateo, pg8::StaticOrder, true, true>(L, g, S, E); }
    }
    SEAM(8);
    if (IN(9)) { pg8::Gemm g{merged, Wmix_t, MTOK, DM, DM, DM}; pg8::StaticOrder S; S.init(MTOK, DM, G, bx);
        pg8::EpiStoreB E{y, DM}; pg8::gemm_phase<pg8::EpiStoreB, pg8::StaticOrder, true, true>(L, g, S, E); }
    SEAM(9);
    if (IN(10)) ph_resnorm<true>(x, y, (const float*)args.in[17], mod, 4096, out, (const float*)args.in[18], 6144, 8192, h2, gw, NGW, FL);
    SEAM(10);
    if (IN(11)) { const int lane = FL; LAS float* scr = (LAS float*)(L + wave * 16384); int cursor = 0;
        tr_matrix((const float*)args.in[19], DM, DFF2, DFF2, Wup_t, scr, cursor, gw, NGW, lane, ScUp{}, nullptr, 1.f);
        tr_matrix((const float*)args.in[22], DFF, DM, DM, Wdn_t, scr, cursor, gw, NGW, lane, ScNat{DM}, nullptr, 1.f); }
    SEAM(11);
    if (IN(12)) { pg8::Gemm g{h2, Wup_t, MTOK, DFF2, DM, DM}; pg8::StaticOrder S; S.init(MTOK, DFF2, G, bx);
        pg8::EpiU E{ubuf}; pg8::gemm_phase<pg8::EpiU, pg8::StaticOrder, true, true>(L, g, S, E); }
    SEAM(12);
    if (IN(13)) ph_convact(ubuf, (const float*)args.in[20], (const float*)args.in[21], act, gw, NGW, FL);
    SEAM(13);
    if (IN(14)) { pg8::Gemm g{act, Wdn_t, MTOK, DM, DFF, DFF}; pg8::StaticOrder S; S.init(MTOK, DM, G, bx);
        pg8::EpiStoreB E{f, DM}; pg8::gemm_phase<pg8::EpiStoreB, pg8::StaticOrder, true, true>(L, g, S, E); }
    SEAM(14);
    if (IN(15)) ph_resnorm<false>(out, f, (const float*)args.in[23], mod, 10240, out, nullptr, 0, 0, nullptr, gw, NGW, FL);
#undef IN
#undef SEAM
#undef FL
}

#ifndef OPT_MASK
#define OPT_MASK 0xFFFFu
#endif
static int mk_grid = 0;
static void launch_mk(void* const* d_in, float* out, void* ws, int lo, int hi, hipStream_t stream) {
    if (mk_grid == 0) {
        int dev = 0, cus = 0, per_cu = 0;
        (void)hipGetDevice(&dev); (void)hipDeviceGetAttribute(&cus, hipDeviceAttributeMultiprocessorCount, dev);
        (void)hipFuncSetAttribute((const void*)mk_fwd, hipFuncAttributeMaxDynamicSharedMemorySize, LDS_BYTES);
        (void)hipOccupancyMaxActiveBlocksPerMultiprocessor(&per_cu, (const void*)mk_fwd, NWAVES * 64, LDS_BYTES);
        if (per_cu < 1) { fprintf(stderr, "occupancy query says %d blocks/CU\n", per_cu); per_cu = 1; }
        if (per_cu > 1) per_cu = 1;
        mk_grid = cus * per_cu; (void)hipGetLastError();
    }
    (void)hipMemsetAsync((char*)ws + WS_CTL, 0, 1 * MiB, stream);
    Args a{}; for (int i = 0; i < 24; ++i) a.in[i] = d_in[i]; a.out = out; a.ws = (unsigned char*)ws; a.ph_lo = lo; a.ph_hi = hi;
    void* kargs[] = {&a};
    hipError_t e = hipLaunchCooperativeKernel((const void*)mk_fwd, dim3(mk_grid), dim3(NWAVES * 64), kargs, LDS_BYTES, stream);
    if (e != hipSuccess) fprintf(stderr, "cooperative launch failed: %s (grid %d)\n", hipGetErrorString(e), mk_grid);
}
extern "C" void kernel_launch(void* const* d_in, const int* in_sizes, int n_in, void* d_out, int out_size, void* d_ws, size_t ws_size, hipStream_t stream) {
    const float* x = (const float*)d_in[0]; const float* c = (const float*)d_in[1]; const int* pos = (const int*)d_in[2];
    const float* w_ada = (const float*)d_in[3]; const float* b_ada = (const float*)d_in[4]; const float* g_pre_mix = (const float*)d_in[5];
    const float* w_in = (const float*)d_in[6]; const float* g_q = (const float*)d_in[7]; const float* w_q_up = (const float*)d_in[8];
    const float* g_kv = (const float*)d_in[9]; const float* w_kv_up = (const float*)d_in[10]; const float* w_gate = (const float*)d_in[11];
    const float* b_gate = (const float*)d_in[12]; const float* g_gla = (const float*)d_in[13]; const float* w_a = (const float*)d_in[14];
    const float* w_b = (const float*)d_in[15]; const float* w_mix = (const float*)d_in[16]; const float* g_post_mix = (const float*)d_in[17];
    const float* g_pre_ffn = (const float*)d_in[18]; const float* w_up = (const float*)d_in[19]; const float* conv_w = (const float*)d_in[20];
    const float* conv_b = (const float*)d_in[21]; const float* w_dn = (const float*)d_in[22]; const float* g_post_ffn = (const float*)d_in[23];
    float* out = (float*)d_out; char* ws = (char*)d_ws;
    if (ws_size < 420 * MiB) { fprintf(stderr, "ws too small: %zu\n", ws_size); return; }
    float* mod = (float*)(ws + WS_MOD); float* rstd = (float*)(ws + WS_RSTD); float2* cs = (float2*)(ws + WS_CS);
    bf16_t* h = (bf16_t*)(ws + WS_H); bf16_t* z = (bf16_t*)(ws + WS_Z); bf16_t* Q = (bf16_t*)(ws + WS_Q); bf16_t* Kf = (bf16_t*)(ws + WS_K); bf16_t* V = (bf16_t*)(ws + WS_V);
    bf16_t* om = (bf16_t*)(ws + WS_OM); bf16_t* og = (bf16_t*)(ws + WS_OG); bf16_t* t1 = (bf16_t*)(ws + WS_T1); bf16_t* merged = (bf16_t*)(ws + WS_MERGED);
    bf16_t* y = (bf16_t*)(ws + WS_Y); bf16_t* h2 = (bf16_t*)(ws + WS_H); bf16_t* act = (bf16_t*)(ws + WS_ACT_N); bf16_t* uq = (bf16_t*)(ws + WS_UQ); bf16_t* f = (bf16_t*)(ws + WS_F);
    int pend_lo = -1, pend_hi = -1;
#define FLUSH() do { if (pend_lo >= 0) { launch_mk(d_in, out, d_ws, pend_lo, pend_hi, stream); pend_lo = -1; } } while (0)
#ifndef MK_SPLIT
#define MK_SPLIT 0
#endif
#define PHASE(p, ...) do { if ((OPT_MASK >> (p)) & 1u) { if (pend_lo >= 0 && (pend_hi != (p) || MK_SPLIT)) FLUSH(); if (pend_lo < 0) pend_lo = (p); pend_hi = (p) + 1; } else { FLUSH(); __VA_ARGS__ } } while (0)
    PHASE(0, { n_mod<<<12288 / 256, 256, 0, stream>>>(c, w_ada, b_ada, mod);
        n_cs<<<MTOK * 32 / 256, 256, 0, stream>>>(pos, cs); });
    PHASE(1, { n_normmod<<<MTOK, 256, 0, stream>>>(x, g_pre_mix, mod, 0, 2048, h); });
    PHASE(2, { n_gemm<EpiStore><<<dim3((DIN + 63) / 64, MTOK / 64), 256, 0, stream>>>(h, DM, w_in, DIN, nullptr, 0, MTOK, DIN, DM, EpiStore{z, LDZ, 0}); });
    PHASE(3, { n_latrstd<<<MTOK / 4, 256, 0, stream>>>(z, rstd);
        n_gemm<EpiQ><<<dim3(1536 / 64, MTOK / 64), 256, 0, stream>>>(z + OFF_QLAT, LDZ, w_q_up, 1536, g_q, 0, MTOK, 1536, 512, EpiQ{Q, rstd});
        n_rope_q<<<MTOK, 256, 0, stream>>>(Q, cs);
        n_gemm<EpiKV><<<dim3(2048 / 64, MTOK / 64), 256, 0, stream>>>(z + OFF_KVLAT, LDZ, w_kv_up, 2048, g_kv, 0, MTOK, 2048, 256, EpiKV{Kf, V, rstd});
        n_rope_k<<<MTOK * 32 / 256, 256, 0, stream>>>(z, Kf, cs); });
    PHASE(4, {  });
    PHASE(5, { n_attn<<<NB * 8 * SEQ, 256, 0, stream>>>(Q, Kf, V, om); });
    PHASE(6, { n_gla<<<64, 256, 0, stream>>>(z, w_gate, b_gate, og); });
#if DBG_SCAN
    FLUSH(); n_gla<<<64, 256, 0, stream>>>(z, w_gate, b_gate, og);
    (void)hipMemsetAsync(ws + WS_MOD + 256 * 1024, 0, 64, stream);
    { unsigned* res = (unsigned*)(ws + WS_MOD + 256 * 1024);
      n_countnf<<<1024, 256, 0, stream>>>(ws + 32 * MiB, (size_t)MTOK * 1024, 0, res + 0);
      n_countnf<<<1024, 256, 0, stream>>>(ws + 48 * MiB, (size_t)MTOK * 1024, 0, res + 1);
      n_countnf<<<1024, 256, 0, stream>>>(ws + 64 * MiB, (size_t)512 * 4096, 0, res + 2);
      n_countnf<<<1024, 256, 0, stream>>>(ws + 68 * MiB, (size_t)512 * 256, 1, res + 3);
      n_countnf<<<1024, 256, 0, stream>>>(ws + 252 * MiB, (size_t)MTOK * 2048, 0, res + 4); }
#endif
    PHASE(7, { n_glanorm<<<MTOK, 256, 0, stream>>>(og, z, g_gla); });
    PHASE(8, { n_gemm<EpiGate><<<dim3(DM / 64, MTOK / 64), 256, 0, stream>>>(om, 1024, w_a, DM, nullptr, 0, MTOK, DM, 1024, EpiGate{t1, z, OFF_GA, nullptr});
        n_gemm<EpiGate><<<dim3(DM / 64, MTOK / 64), 256, 0, stream>>>(og, DM, w_b, DM, nullptr, 0, MTOK, DM, DM, EpiGate{merged, z, OFF_GB, t1}); });
    PHASE(9, { n_gemm<EpiStore><<<dim3(DM / 64, MTOK / 64), 256, 0, stream>>>(merged, DM, w_mix, DM, nullptr, 0, MTOK, DM, DM, EpiStore{y, DM, 0}); });
    PHASE(10, { n_resnorm<<<MTOK, 256, 0, stream>>>(x, y, g_post_mix, mod, 4096, out, g_pre_ffn, 6144, 8192, h2); });
    PHASE(11, {  });
    PHASE(12, { for (int q = 0; q < 4; ++q) { const int q0 = q * 2048, r0 = (q0 % SEQ == 0) ? q0 : q0 - 2, r1 = q0 + 2048;
            n_gemm<EpiStore><<<dim3(DFF2 / 64, (r1 - r0 + 63) / 64), 256, 0, stream>>>(h2, DM, w_up, DFF2, nullptr, r0, r1, DFF2, DM, EpiStore{uq, DFF2, r0});
            n_convact<<<dim3(DFF / 256, 2048), 256, 0, stream>>>(uq, r0, q0, conv_w, conv_b, act); } });
    PHASE(13, {  });
    PHASE(14, { n_gemm<EpiStore><<<dim3(DM / 64, MTOK / 64), 256, 0, stream>>>(act, DFF, w_dn, DM, nullptr, 0, MTOK, DM, DFF, EpiStore{f, DM, 0}); });
    PHASE(15, { n_resnorm<<<MTOK, 256, 0, stream>>>(out, f, g_post_ffn, mod, 10240, out, nullptr, 0, 0, nullptr); });
    FLUSH();
#if DBG_SCAN
    n_scale_bits<<<1024, 256, 0, stream>>>(out, (size_t)MTOK * DM, (const unsigned*)(ws + WS_MOD + 256 * 1024), 5);
#endif
}
```

```cpp
#include <hip/hip_runtime.h>
#include <hip/hip_bf16.h>
#include <cstdint>
#include <cstdio>

typedef unsigned short bf16_t;
constexpr int NB = 2, SEQ = 4096, DM = 2048, MTOK = NB * SEQ;
constexpr int DIN = 11088, LDZ = 11264;
constexpr int OFF_QLAT = 0, OFF_KVLAT = 512, OFF_KROPE = 768, OFF_GQ = 832, OFF_GK = 1856, OFF_GV = 2880, OFF_GLR = 4928, OFF_GOG = 4944, OFF_GA = 6992, OFF_GB = 9040;
constexpr int DFF = 5632, DFF2 = 11264;
constexpr float EPSN = 1e-6f;
constexpr float QK_C2 = 0.07216878364870322f * 1.4426950408889634f;
constexpr size_t MiB = 1u << 20;
constexpr size_t WS_CTL = 0, WS_MOD = 1 * MiB, WS_RSTD = 1 * MiB + 512 * 1024, WS_CS = 2 * MiB, WS_PART = 4 * MiB;
constexpr size_t WS_WQ = 8 * MiB, WS_WKV = 10 * MiB, WS_WA = 12 * MiB, WS_WB = 16 * MiB, WS_WMIX = 24 * MiB;
constexpr size_t WS_WIN = 32 * MiB, WS_Z = 76 * MiB, WS_H = 252 * MiB, WS_Q = 284 * MiB, WS_K = 308 * MiB, WS_V = 332 * MiB, WS_OM = 348 * MiB, WS_OG = 364 * MiB, WS_MISC = 396 * MiB;
constexpr size_t WS_MERGED = WS_WIN, WS_Y = WS_Z, WS_ACT_N = 284 * MiB  , WS_UQ = 196 * MiB  , WS_F = 196 * MiB, WS_T1 = WS_H;

__device__ __forceinline__ int fresh_tid() { int t = threadIdx.x; asm volatile("" : "+v"(t)); return t; }
__device__ __forceinline__ float bf2f(bf16_t v) { return __uint_as_float(((unsigned)v) << 16); }
__device__ __forceinline__ bf16_t f2bf(float f) { unsigned u = __float_as_uint(f); return (bf16_t)((u + 0x7fffu + ((u >> 16) & 1u)) >> 16); }
__device__ __forceinline__ float sigmoidf_(float x) { return 1.f / (1.f + __expf(-x)); }
__device__ __forceinline__ float siluf_(float x) { return x / (1.f + __expf(-x)); }
__device__ __forceinline__ float gelu_tanh(float a) { const float u = 0.7978845608028654f * (a + 0.044715f * a * a * a); return 0.5f * a * (1.f + tanhf(u)); }
__device__ __forceinline__ int rope_pos(int d) { return d < 32 ? (8 * (d >> 2) + (d & 3)) : (8 * ((d - 32) >> 2) + 4 + (d & 3)); }

__device__ __forceinline__ float block_sum256(float v, float* red) {
#pragma unroll
    for (int o = 32; o > 0; o >>= 1) v += __shfl_xor(v, o);
    __syncthreads();
    if ((threadIdx.x & 63) == 0) red[threadIdx.x >> 6] = v;
    __syncthreads();
    return red[0] + red[1] + red[2] + red[3];
}


__global__ void __launch_bounds__(256) n_cmp(const bf16_t* t, const bf16_t* r, size_t n, unsigned* res) {
    unsigned nf = 0; float md = 0.f, mr = 0.f;
    for (size_t i = (size_t)blockIdx.x * 256 + threadIdx.x; i < n; i += (size_t)gridDim.x * 256) { const float a = bf2f(t[i]), b = bf2f(r[i]);
        if (!(fabsf(a) < 1e30f)) { ++nf; } else md = fmaxf(md, fabsf(a - b)); mr = fmaxf(mr, fabsf(b)); }
    if (nf) atomicAdd(res, nf); atomicMax(res + 1, __float_as_uint(md)); atomicMax(res + 2, __float_as_uint(mr));
}
__global__ void n_scale(float* out, size_t n, const unsigned* res) {
    const float md = __uint_as_float(res[1]), mr = __uint_as_float(res[2]); const float rel = md / fmaxf(mr, 1e-20f);
    int code = rel < 1e-2f ? 0 : rel < 3e-2f ? 1 : rel < 0.1f ? 2 : rel < 0.3f ? 3 : rel < 1.f ? 4 : 5; if (res[0]) code = 6 + (res[0] > 1000u) + (res[0] > 1000000u);
    const float f = 1.f + 0.1f * code;
    for (size_t i = (size_t)blockIdx.x * 256 + threadIdx.x; i < n; i += (size_t)gridDim.x * 256) out[i] *= f;
}

__global__ void __launch_bounds__(256) n_countnf(const void* p, size_t n, int isf32, unsigned* res) {
    unsigned nf = 0;
    for (size_t i = (size_t)blockIdx.x * 256 + threadIdx.x; i < n; i += (size_t)gridDim.x * 256) { const float a = isf32 ? ((const float*)p)[i] : bf2f(((const bf16_t*)p)[i]); if (!(fabsf(a) < 1e30f)) ++nf; }
    if (nf) atomicAdd(res, nf);
}
__global__ void n_scale_bits(float* out, size_t n, const unsigned* res, int nres) {
    int code = 0; for (int k = 0; k < nres; ++k) if (res[k]) code |= 1 << k;
    const float f = 1.f + 0.05f * code;
    for (size_t i = (size_t)blockIdx.x * 256 + threadIdx.x; i < n; i += (size_t)gridDim.x * 256) out[i] *= f;
}
__global__ void __launch_bounds__(256) n_mod(const float* c, const float* w_ada, const float* b_ada, float* mod) {
    __shared__ float ca[2][DM];
    for (int i = threadIdx.x; i < 2 * DM; i += 256) ca[i / DM][i % DM] = siluf_(c[i]);
    __syncthreads();
    const int j = blockIdx.x * 256 + threadIdx.x;
    float a0 = b_ada[j], a1 = a0;
    for (int k = 0; k < DM; ++k) { const float w = w_ada[(size_t)k * 12288 + j]; a0 += ca[0][k] * w; a1 += ca[1][k] * w; }
    mod[j] = a0; mod[12288 + j] = a1;
}
__global__ void __launch_bounds__(256) n_cs(const int* pos, float2* cs) {
    const int idx = blockIdx.x * 256 + threadIdx.x; const int m = idx >> 5, i = idx & 31;
    const float inv = 1.0f / powf(10000.0f, (float)(2 * i) / 64.0f);
    const float ang = (float)pos[m] * inv;
    float s, c; sincosf(ang, &s, &c); cs[idx] = make_float2(c, s);
}
__global__ void __launch_bounds__(256) n_normmod(const float* x, const float* g, const float* mod, int off_shift, int off_scale, bf16_t* h) {
    __shared__ float red[4];
    const int m = blockIdx.x, b = m / SEQ; const float* xr = x + (size_t)m * DM;
    float v[8], s = 0.f;
#pragma unroll
    for (int i = 0; i < 8; ++i) { v[i] = xr[threadIdx.x + i * 256]; s += v[i] * v[i]; }
    const float rstd = rsqrtf(block_sum256(s, red) / DM + EPSN);
#pragma unroll
    for (int i = 0; i < 8; ++i) { const int k = threadIdx.x + i * 256;
        h[(size_t)m * DM + k] = f2bf(v[i] * rstd * g[k] * (1.f + mod[b * 12288 + off_scale + k]) + mod[b * 12288 + off_shift + k]); }
}
template <class Epi>
__global__ void __launch_bounds__(256) n_gemm(const bf16_t* A, int lda, const float* W, int ldw, const float* ks, int M0, int M1, int N, int K, Epi epi) {
    __shared__ float As[16][68]; __shared__ float Ws[16][68];
    const int tx = threadIdx.x & 15, ty = threadIdx.x >> 4;
    const int m0 = M0 + blockIdx.y * 64, n0 = blockIdx.x * 64;
    float acc[4][4];
#pragma unroll
    for (int i = 0; i < 4; ++i)
#pragma unroll
        for (int j = 0; j < 4; ++j) acc[i][j] = 0.f;
    for (int k0 = 0; k0 < K; k0 += 16) {
#pragma unroll
        for (int i = 0; i < 4; ++i) { const int e = threadIdx.x + i * 256, r = e >> 4, kk = e & 15, m = m0 + r;
            float a = (m < M1) ? bf2f(A[(size_t)m * lda + k0 + kk]) : 0.f; if (ks) a *= ks[k0 + kk]; As[kk][r] = a; }
#pragma unroll
        for (int i = 0; i < 4; ++i) { const int e = threadIdx.x + i * 256, kk = e >> 6, cc = e & 63, n = n0 + cc;
            Ws[kk][cc] = (n < N) ? W[(size_t)(k0 + kk) * ldw + n] : 0.f; }
        __syncthreads();
#pragma unroll
        for (int kk = 0; kk < 16; ++kk) {
            float a[4], b[4];
#pragma unroll
            for (int i = 0; i < 4; ++i) { a[i] = As[kk][ty * 4 + i]; b[i] = Ws[kk][tx * 4 + i]; }
#pragma unroll
            for (int i = 0; i < 4; ++i)
#pragma unroll
                for (int j = 0; j < 4; ++j) acc[i][j] += a[i] * b[j];
        }
        __syncthreads();
    }
#pragma unroll
    for (int i = 0; i < 4; ++i)
#pragma unroll
        for (int j = 0; j < 4; ++j) { const int m = m0 + ty * 4 + i, n = n0 + tx * 4 + j; if (m < M1 && n < N) epi(m, n, acc[i][j]); }
}
struct EpiStore { bf16_t* C; int ldc; int row_off; __device__ void operator()(int m, int n, float v) const { C[(size_t)(m - row_off) * ldc + n] = f2bf(v); } };
struct EpiQ { bf16_t* Q; const float* rstd; __device__ void operator()(int m, int n, float v) const { Q[(size_t)m * 1536 + n] = f2bf(v * rstd[m]); } };
struct EpiKV { bf16_t* Kf; bf16_t* V; const float* rstd; __device__ void operator()(int m, int n, float v) const {
    const int h = n >> 8, w = n & 255; v *= rstd[MTOK + m];
    if (w < 128) Kf[(size_t)m * 1536 + h * 192 + w] = f2bf(v); else V[(size_t)m * 1024 + h * 128 + (w - 128)] = f2bf(v); } };
struct EpiGate { bf16_t* C; const bf16_t* z; int goff; const bf16_t* add; __device__ void operator()(int m, int n, float v) const {
    float r = v * sigmoidf_(bf2f(z[(size_t)m * LDZ + goff + n])); if (add) r += bf2f(add[(size_t)m * DM + n]); C[(size_t)m * DM + n] = f2bf(r); } };

__global__ void __launch_bounds__(256) n_latrstd(const bf16_t* z, float* rstd) {
    const int m = blockIdx.x * 4 + (threadIdx.x >> 6), lane = threadIdx.x & 63; const bf16_t* zr = z + (size_t)m * LDZ;
    float s = 0.f, s2 = 0.f;
    for (int i = lane; i < 512; i += 64) { const float v = bf2f(zr[i]); s += v * v; }
    for (int i = lane; i < 256; i += 64) { const float v = bf2f(zr[512 + i]); s2 += v * v; }
#pragma unroll
    for (int o = 32; o > 0; o >>= 1) { s += __shfl_xor(s, o); s2 += __shfl_xor(s2, o); }
    if (lane == 0) { rstd[m] = rsqrtf(s / 512.f + EPSN); rstd[MTOK + m] = rsqrtf(s2 / 256.f + EPSN); }
}
__global__ void __launch_bounds__(256) n_rope_q(bf16_t* Q, const float2* cs) {
    const int m = blockIdx.x, h = threadIdx.x >> 5, i = threadIdx.x & 31; bf16_t* q = Q + (size_t)m * 1536 + h * 192;
    const float x1 = bf2f(q[128 + i]), x2 = bf2f(q[160 + i]); const float2 c = cs[m * 32 + i];
    float nope[4];
#pragma unroll
    for (int j = 0; j < 4; ++j) nope[j] = bf2f(q[i * 4 + j]);
    __syncthreads();
    q[128 + rope_pos(i)] = f2bf((x1 * c.x - x2 * c.y) * QK_C2); q[128 + rope_pos(32 + i)] = f2bf((x2 * c.x + x1 * c.y) * QK_C2);
#pragma unroll
    for (int j = 0; j < 4; ++j) q[i * 4 + j] = f2bf(nope[j] * QK_C2);
}
__global__ void __launch_bounds__(256) n_rope_k(const bf16_t* z, bf16_t* Kf, const float2* cs) {
    const int idx = blockIdx.x * 256 + threadIdx.x, m = idx >> 5, i = idx & 31; const bf16_t* zr = z + (size_t)m * LDZ + OFF_KROPE;
    const float x1 = bf2f(zr[i]), x2 = bf2f(zr[32 + i]); const float2 c = cs[m * 32 + i];
    const bf16_t o1 = f2bf(x1 * c.x - x2 * c.y), o2 = f2bf(x2 * c.x + x1 * c.y);
#pragma unroll
    for (int h = 0; h < 8; ++h) { Kf[(size_t)m * 1536 + h * 192 + 128 + rope_pos(i)] = o1; Kf[(size_t)m * 1536 + h * 192 + 128 + rope_pos(32 + i)] = o2; }
}
__global__ void __launch_bounds__(256) n_attn(const bf16_t* Q, const bf16_t* Kf, const bf16_t* V, bf16_t* O) {
    __shared__ float qs[192]; __shared__ float p[SEQ]; __shared__ float red[4]; __shared__ float op[2][128];
    const int t = blockIdx.x % SEQ, h = (blockIdx.x / SEQ) % 8, b = blockIdx.x / (SEQ * 8); const size_t m = (size_t)b * SEQ + t;
    if (threadIdx.x < 192) qs[threadIdx.x] = bf2f(Q[m * 1536 + h * 192 + threadIdx.x]);
    __syncthreads();
    float mx = -1e30f;
    for (int j = threadIdx.x; j <= t; j += 256) { const bf16_t* kr = Kf + ((size_t)b * SEQ + j) * 1536 + h * 192; float s = 0.f;
        for (int d = 0; d < 192; ++d) s += qs[d] * bf2f(kr[d]);
        p[j] = s; mx = fmaxf(mx, s); }
#pragma unroll
    for (int o = 32; o > 0; o >>= 1) mx = fmaxf(mx, __shfl_xor(mx, o));
    if ((threadIdx.x & 63) == 0) red[threadIdx.x >> 6] = mx;
    __syncthreads();
    mx = fmaxf(fmaxf(red[0], red[1]), fmaxf(red[2], red[3]));
    float l = 0.f;
    for (int j = threadIdx.x; j <= t; j += 256) { const float e = exp2f(p[j] - mx); p[j] = e; l += e; }
    l = block_sum256(l, red);
    const int e = threadIdx.x & 127, g = threadIdx.x >> 7; float acc = 0.f;
    for (int j = g; j <= t; j += 2) acc += p[j] * bf2f(V[((size_t)b * SEQ + j) * 1024 + h * 128 + e]);
    op[g][e] = acc; __syncthreads();
    if (threadIdx.x < 128) O[m * 1024 + h * 128 + threadIdx.x] = f2bf((op[0][threadIdx.x] + op[1][threadIdx.x]) / l);
}
__global__ void __launch_bounds__(256) n_gla(const bf16_t* z, const float* wg, const float* bg, bf16_t* og) {
    constexpr int TS = 8;
    __shared__ float al[TS][256], kk[TS][256], qq[TS][256], vv[TS][64], opart[TS][4][64];
    const int bh = blockIdx.x >> 3, eb = blockIdx.x & 7, b = bh >> 2, h = bh & 3; const int e = threadIdx.x & 63, dg = threadIdx.x >> 6;
    float S[64];
#pragma unroll
    for (int i = 0; i < 64; ++i) S[i] = 0.f;
    for (int t0 = 0; t0 < SEQ; t0 += TS) {
        __syncthreads();
        for (int idx = threadIdx.x; idx < TS * 256; idx += 256) { const int tt = idx >> 8, d = idx & 255; const bf16_t* zr = z + ((size_t)b * SEQ + t0 + tt) * LDZ;
            float xg = bg[h * 256 + d];
#pragma unroll
            for (int r = 0; r < 16; ++r) xg += bf2f(zr[OFF_GLR + r]) * wg[r * 1024 + h * 256 + d];
            const float ls = fminf(xg, 0.f) - log1pf(__expf(-fabsf(xg)));
            al[tt][d] = __expf(ls * (1.f / 16.f));
            kk[tt][d] = bf2f(zr[OFF_GK + h * 256 + d]); qq[tt][d] = bf2f(zr[OFF_GQ + h * 256 + d]) * 0.0625f; }
        for (int idx = threadIdx.x; idx < TS * 64; idx += 256) { const int tt = idx >> 6, ee = idx & 63;
            vv[tt][ee] = bf2f(z[((size_t)b * SEQ + t0 + tt) * LDZ + OFF_GV + h * 512 + eb * 64 + ee]); }
        __syncthreads();
        for (int tt = 0; tt < TS; ++tt) { const float ve = vv[tt][e]; float o = 0.f;
#pragma unroll
            for (int i = 0; i < 64; ++i) { S[i] = al[tt][dg * 64 + i] * S[i] + kk[tt][dg * 64 + i] * ve; o += qq[tt][dg * 64 + i] * S[i]; }
            opart[tt][dg][e] = o; }
        __syncthreads();
        for (int idx = threadIdx.x; idx < TS * 64; idx += 256) { const int tt = idx >> 6, ee = idx & 63;
            og[((size_t)b * SEQ + t0 + tt) * DM + h * 512 + eb * 64 + ee] = f2bf(opart[tt][0][ee] + opart[tt][1][ee] + opart[tt][2][ee] + opart[tt][3][ee]); }
    }
}
__global__ void __launch_bounds__(256) n_glanorm(bf16_t* og, const bf16_t* z, const float* g) {
    const int m = blockIdx.x, h = threadIdx.x >> 6, lane = threadIdx.x & 63; bf16_t* o = og + (size_t)m * DM + h * 512;
    float v[8], s = 0.f;
#pragma unroll
    for (int i = 0; i < 8; ++i) { v[i] = bf2f(o[lane + i * 64]); s += v[i] * v[i]; }
#pragma unroll
    for (int of = 32; of > 0; of >>= 1) s += __shfl_xor(s, of);
    const float rstd = rsqrtf(s / 512.f + EPSN);
#pragma unroll
    for (int i = 0; i < 8; ++i) { const int ee = lane + i * 64; const float nv = v[i] * rstd * g[ee];
        o[ee] = f2bf(nv * siluf_(bf2f(z[(size_t)m * LDZ + OFF_GOG + h * 512 + ee]))); }
}
__global__ void __launch_bounds__(256) n_resnorm(const float* xin, const bf16_t* y, const float* g1, const float* mod, int off_gate, float* xout, const float* g2, int off_shift, int off_scale, bf16_t* h2) {
    __shared__ float red[4];
    const int m = blockIdx.x, b = m / SEQ;
    float yv[8], s = 0.f;
#pragma unroll
    for (int i = 0; i < 8; ++i) { yv[i] = bf2f(y[(size_t)m * DM + threadIdx.x + i * 256]); s += yv[i] * yv[i]; }
    const float rstd = rsqrtf(block_sum256(s, red) / DM + EPSN);
    float xv[8], s2 = 0.f;
#pragma unroll
    for (int i = 0; i < 8; ++i) { const int k = threadIdx.x + i * 256; xv[i] = xin[(size_t)m * DM + k] + mod[b * 12288 + off_gate + k] * (yv[i] * rstd * g1[k]); s2 += xv[i] * xv[i];
        xout[(size_t)m * DM + k] = xv[i]; }
    if (h2) { const float r2 = rsqrtf(block_sum256(s2, red) / DM + EPSN);
#pragma unroll
        for (int i = 0; i < 8; ++i) { const int k = threadIdx.x + i * 256;
            h2[(size_t)m * DM + k] = f2bf(xv[i] * r2 * g2[k] * (1.f + mod[b * 12288 + off_scale + k]) + mod[b * 12288 + off_shift + k]); } }
}
__global__ void __launch_bounds__(256) n_convact(const bf16_t* ubuf, int r0, int q0, const float* cw, const float* cb, bf16_t* act) {
    const int m = q0 + blockIdx.y, t = m % SEQ, j = blockIdx.x * 256 + threadIdx.x;
    float ca = cb[j], cv = cb[DFF + j];
#pragma unroll
    for (int i = 0; i < 3; ++i) { const int tt = t - 2 + i; if (tt >= 0) { const bf16_t* ur = ubuf + (size_t)(m - 2 + i - r0) * DFF2;
        ca += cw[i * DFF2 + j] * bf2f(ur[j]); cv += cw[i * DFF2 + DFF + j] * bf2f(ur[DFF + j]); } }
    act[(size_t)m * DFF + j] = f2bf(gelu_tanh(ca) * cv);
}

namespace pg8 {
#define PG8_LAS __attribute__((address_space(3)))
typedef short bf16x8 __attribute__((ext_vector_type(8)));
typedef float f32x4 __attribute__((ext_vector_type(4)));
typedef unsigned u32x4 __attribute__((ext_vector_type(4)));
constexpr int BM = 256, BK = 64, HALF = 128, HTB = HALF * BK * 2  , STAGE_BYTES = 8 * HTB, NXCD = 8, WGM = 8;

__host__ __device__ __forceinline__ int lds_byte(int r, int c) { const int st = (r >> 4) * 2 + (c >> 5), rr = r & 15, cc = c & 31, ob = rr * 64 + cc * 2; return st * 1024 + (ob ^ (((ob >> 9) & 1) << 5)); }
__host__ __device__ __forceinline__ void stage_rc(int b, int& R, int& C) { const int st = b / 1024, sb = b % 1024, swz = sb ^ (((sb >> 9) & 1) << 5); R = (st >> 1) * 16 + swz / 64; C = (st & 1) * 32 + (swz % 64) / 2; }
__host__ __device__ __forceinline__ int perm32(int rho) { const int n = rho >> 4, i = rho & 15; return 8 * (i >> 2) + 4 * n + (i & 3); }

struct Unit { int pm, pn; };
struct Gemm { const bf16_t* A; const bf16_t* Bt; int M, N, K, lda; };
__host__ __device__ __forceinline__ int arow(int R, bool perm) { return perm ? (128 * (R >> 6) + 8 * (R & 15) + ((R >> 4) & 3)) : R; }
typedef float f32x2c_t __attribute__((ext_vector_type(2))); typedef __bf16 bf16x2c_t __attribute__((ext_vector_type(2)));
__device__ __forceinline__ unsigned cvt_pk_bf16(float lo, float hi) { f32x2c_t v = {lo, hi}; bf16x2c_t b = __builtin_convertvector(v, bf16x2c_t); return __builtin_bit_cast(unsigned, b); }
typedef float f32x2 __attribute__((ext_vector_type(2)));
struct StaticOrder {
    int nM, nN, nwg, G, c;
    __host__ __device__ void init(int M, int N, int G_, int c_) { nM = M / BM; nN = N / BM; nwg = nM * nN; G = G_; c = c_; }
    __host__ __device__ bool next(int i, Unit& u) const {
        const long L = (long)i * G + c; if (L >= nwg) return false;
        int wgid = (int)L; { const int q = nwg / NXCD, r = nwg % NXCD, xcd = wgid % NXCD, off = wgid / NXCD; wgid = (xcd < r ? xcd * (q + 1) : r * (q + 1) + (xcd - r) * q) + off; }
        const int nig = WGM * nN, gid = wgid / nig, fm = gid * WGM, gsz = (nM - fm) < WGM ? (nM - fm) : WGM;
        u.pm = fm + ((wgid % nig) % gsz); u.pn = (wgid % nig) / gsz; return true;
    }
    __device__ __forceinline__ void a_ready(const Unit&) const {}
    __device__ __forceinline__ void done(const Unit&) const {}
};
template <class Epi, class Sched, bool ALIGN_EPI = false, bool SP2 = false>
__device__ __forceinline__ void gemm_phase(PG8_LAS unsigned char* lds, const Gemm g, const Sched& S, const Epi& E) {
    const int tid = fresh_tid(), wid = __builtin_amdgcn_readfirstlane(tid >> 6), lane = tid & 63, wr = wid >> 2, wc = wid & 3, fr = lane & 15, fq = lane >> 4;
    const int K = g.K, nt = K / BK;
    unsigned voffA[2], voffB[2];
#pragma unroll
    for (int i = 0; i < 2; ++i) { int R, C; stage_rc(tid * 16 + i * 8192, R, C); const int Rb = Epi::PERM ? ((R & ~31) + perm32(R & 31)) : R;
        voffA[i] = (unsigned)(arow(R, Epi::APERM) * g.lda + C) * 2u; voffB[i] = (unsigned)(Rb * K + C) * 2u; }
    const size_t kstep = (size_t)(BK * 2);
    const size_t hstepA = Epi::APERM ? (size_t)4 * g.lda * 2 : (size_t)HALF * g.lda * 2, hstepB = (size_t)HALF * K * 2;
    const size_t tstepA = (size_t)BM * g.lda * 2, tstepB = 2 * hstepB;
    const unsigned ldsw = (unsigned)wid * 1024u;
    const int aoff = lds_byte(wr * 64 + fr, fq * 8), boff = lds_byte(wc * 32 + fr, fq * 8);
#define PG8_SA(b, h) (((b) * 2 + (h)) * HTB)
#define PG8_SB(b, h) ((4 + (b) * 2 + (h)) * HTB)
#define PG8_STAGE(bufoff, gbase, voff) do { _Pragma("unroll") for (int _i = 0; _i < 2; ++_i) \
        __builtin_amdgcn_global_load_lds((const unsigned*)((const char*)(gbase) + (voff)[_i]), (PG8_LAS unsigned*)(lds + (bufoff) + ldsw + _i * 8192), 16, 0, 0); } while (0)
#define PG8_LDA(dst, b, h) do { _Pragma("unroll") for (int m = 0; m < 4; ++m) _Pragma("unroll") for (int k = 0; k < 2; ++k) dst[m][k] = *(const PG8_LAS bf16x8*)(lds + PG8_SA(b, h) + aoff + m * 2048 + k * 1024); } while (0)
#define PG8_LDB(dst, b, h) do { _Pragma("unroll") for (int n = 0; n < 2; ++n) _Pragma("unroll") for (int k = 0; k < 2; ++k) dst[n][k] = *(const PG8_LAS bf16x8*)(lds + PG8_SB(b, h) + boff + n * 2048 + k * 1024); } while (0)
#define PG8_MMA(ai, bj, At, Bt) do { __builtin_amdgcn_s_setprio(1); _Pragma("unroll") for (int m = 0; m < 4; ++m) _Pragma("unroll") for (int n = 0; n < 2; ++n) _Pragma("unroll") for (int k = 0; k < 2; ++k) \
        acc[ai][bj][m][n] = __builtin_amdgcn_mfma_f32_16x16x32_bf16(Bt[n][k], At[m][k], acc[ai][bj][m][n], 0, 0, 0); __builtin_amdgcn_s_setprio(0); } while (0)
#define PG8_WAIT_V(n) asm volatile("s_waitcnt vmcnt(" #n ")" ::: "memory")
#define PG8_WAIT_L(n) asm volatile("s_waitcnt lgkmcnt(" #n ")" ::: "memory")
#define PG8_BAR __builtin_amdgcn_s_barrier()
#define PG8_SCHED __builtin_amdgcn_sched_barrier(0)
    Unit cur, nxt; int ui = 0;
    if (!S.next(0, cur)) return;
    f32x4 acc[2][2][4][2];
#pragma unroll
    for (int a = 0; a < 2; ++a)
#pragma unroll
        for (int b = 0; b < 2; ++b)
#pragma unroll
            for (int m = 0; m < 4; ++m)
#pragma unroll
                for (int n = 0; n < 2; ++n) acc[a][b][m][n] = (f32x4){0.f, 0.f, 0.f, 0.f};
    bf16x8 At[4][2], B0[2][2], B1[2][2];
    const char* cA = (const char*)g.A + (size_t)cur.pm * tstepA; const char* cB = (const char*)g.Bt + (size_t)cur.pn * tstepB;
    S.a_ready(cur);
    if constexpr (SP2) {
        PG8_STAGE(PG8_SB(0, 0), cB, voffB); PG8_STAGE(PG8_SB(0, 1), cB + hstepB, voffB); PG8_STAGE(PG8_SA(0, 0), cA, voffA); PG8_STAGE(PG8_SA(0, 1), cA + hstepA, voffA);
        if (wr == 1) PG8_BAR;
        PG8_WAIT_V(2); PG8_BAR;
        PG8_STAGE(PG8_SB(1, 0), cB + kstep, voffB); PG8_STAGE(PG8_SA(1, 0), cA + kstep, voffA); PG8_STAGE(PG8_SB(1, 1), cB + hstepB + kstep, voffB);
        PG8_WAIT_V(6); PG8_BAR;
    } else {
        PG8_STAGE(PG8_SB(0, 0), cB, voffB); PG8_STAGE(PG8_SA(0, 0), cA, voffA); PG8_STAGE(PG8_SB(0, 1), cB + hstepB, voffB); PG8_STAGE(PG8_SA(0, 1), cA + hstepA, voffA);
        if (wr == 1) PG8_BAR;
        PG8_WAIT_V(4); PG8_BAR;
        PG8_STAGE(PG8_SB(1, 0), cB + kstep, voffB); PG8_STAGE(PG8_SA(1, 0), cA + kstep, voffA); PG8_STAGE(PG8_SB(1, 1), cB + hstepB + kstep, voffB);
        PG8_WAIT_V(6); PG8_BAR;
    }
    for (;;) {
        const bool has_next = S.next(ui + 1, nxt);
        const char* nA = has_next ? (const char*)g.A + (size_t)nxt.pm * tstepA : cA; const char* nB = has_next ? (const char*)g.Bt + (size_t)nxt.pn * tstepB : cB;
        for (int t = 0; t < nt; t += 2) {
            const bool last = (t == nt - 2);
            const char* a1 = cA + (size_t)(t + 1) * kstep;
            const char* a2 = last ? nA : cA + (size_t)(t + 2) * kstep; const char* b2 = last ? nB : cB + (size_t)(t + 2) * kstep;
            const char* a3 = a2 + kstep; const char* b3 = b2 + kstep;
            if (last && has_next) S.a_ready(nxt);
            if constexpr (SP2) {
            PG8_LDB(B0, 0, 0); PG8_LDB(B1, 0, 1); PG8_SCHED; PG8_LDA(At, 0, 0); PG8_STAGE(PG8_SA(1, 1), a1 + hstepA, voffA);
            PG8_WAIT_V(8); PG8_WAIT_L(0); PG8_BAR; PG8_MMA(0, 0, At, B0); PG8_MMA(0, 1, At, B1); PG8_BAR; PG8_SCHED;
            PG8_LDA(At, 0, 1); PG8_STAGE(PG8_SB(0, 0), b2, voffB); PG8_STAGE(PG8_SB(0, 1), b2 + hstepB, voffB); PG8_STAGE(PG8_SA(0, 0), a2, voffA);
            PG8_WAIT_V(8); PG8_WAIT_L(0); PG8_BAR; PG8_MMA(1, 0, At, B0); PG8_MMA(1, 1, At, B1); PG8_BAR; PG8_SCHED;
            PG8_LDB(B0, 1, 0); PG8_LDB(B1, 1, 1); PG8_SCHED; PG8_LDA(At, 1, 0); PG8_STAGE(PG8_SA(0, 1), a2 + hstepA, voffA);
            PG8_WAIT_V(8); PG8_WAIT_L(0); PG8_BAR; PG8_MMA(0, 0, At, B0); PG8_MMA(0, 1, At, B1); PG8_BAR; PG8_SCHED;
            PG8_LDA(At, 1, 1); PG8_STAGE(PG8_SB(1, 0), b3, voffB); PG8_STAGE(PG8_SB(1, 1), b3 + hstepB, voffB); PG8_STAGE(PG8_SA(1, 0), a3, voffA);
            PG8_WAIT_V(8); PG8_WAIT_L(0); PG8_BAR; PG8_MMA(1, 0, At, B0); PG8_MMA(1, 1, At, B1); PG8_BAR; PG8_SCHED;
            } else {
            PG8_LDB(B0, 0, 0); PG8_SCHED; PG8_LDA(At, 0, 0); PG8_STAGE(PG8_SA(1, 1), a1 + hstepA, voffA);
            PG8_WAIT_L(8); PG8_BAR; PG8_WAIT_L(0); PG8_MMA(0, 0, At, B0); PG8_BAR; PG8_SCHED;
            PG8_LDB(B1, 0, 1); PG8_STAGE(PG8_SB(0, 0), b2, voffB);
            PG8_BAR; PG8_WAIT_L(0); PG8_MMA(0, 1, At, B1); PG8_BAR;
            PG8_LDA(At, 0, 1); PG8_STAGE(PG8_SA(0, 0), a2, voffA);
            PG8_BAR; PG8_WAIT_L(0); PG8_MMA(1, 0, At, B0); PG8_BAR; PG8_SCHED;
            PG8_STAGE(PG8_SB(0, 1), b2 + hstepB, voffB);
            PG8_WAIT_V(6); PG8_BAR; PG8_MMA(1, 1, At, B1); PG8_BAR;
            PG8_LDB(B0, 1, 0); PG8_SCHED; PG8_LDA(At, 1, 0); PG8_STAGE(PG8_SA(0, 1), a2 + hstepA, voffA);
            PG8_WAIT_L(8); PG8_BAR; PG8_WAIT_L(0); PG8_MMA(0, 0, At, B0); PG8_BAR; PG8_SCHED;
            PG8_LDB(B1, 1, 1); PG8_STAGE(PG8_SB(1, 0), b3, voffB);
            PG8_BAR; PG8_WAIT_L(0); PG8_MMA(0, 1, At, B1); PG8_BAR;
            PG8_LDA(At, 1, 1); PG8_STAGE(PG8_SA(1, 0), a3, voffA);
            PG8_BAR; PG8_WAIT_L(0); PG8_MMA(1, 0, At, B0); PG8_BAR; PG8_SCHED;
            PG8_STAGE(PG8_SB(1, 1), b3 + hstepB, voffB);
            PG8_WAIT_V(6); PG8_BAR; PG8_MMA(1, 1, At, B1); PG8_BAR;
            }
        }
        if constexpr (ALIGN_EPI) { if (wr == 0) PG8_BAR; }
        if constexpr (!Epi::AFTER_DRAIN) { E(acc, cur, wr, wc, fr, fq); S.done(cur); }
        if (!has_next) break;
#pragma unroll
        for (int a = 0; a < 2; ++a)
#pragma unroll
            for (int b = 0; b < 2; ++b)
#pragma unroll
                for (int m = 0; m < 4; ++m)
#pragma unroll
                    for (int n = 0; n < 2; ++n) acc[a][b][m][n] = (f32x4){0.f, 0.f, 0.f, 0.f};
        cur = nxt; cA = nA; cB = nB; ++ui;
        if constexpr (ALIGN_EPI) { if (wr == 1) PG8_BAR; }
    }
    PG8_WAIT_V(0);
    if constexpr (!ALIGN_EPI) { if (wr == 0) PG8_BAR; }
    PG8_BAR;
    if constexpr (Epi::AFTER_DRAIN) { E.fused(acc, cur, wr, wc, fr, fq, lds, wid, lane); S.done(cur); }
#undef PG8_SA
#undef PG8_SB
#undef PG8_STAGE
#undef PG8_LDA
#undef PG8_LDB
#undef PG8_MMA
#undef PG8_WAIT_V
#undef PG8_WAIT_L
#undef PG8_BAR
#undef PG8_SCHED
}
}

#define GAS __attribute__((address_space(1)))
#define LAS __attribute__((address_space(3)))
typedef unsigned v4u __attribute__((ext_vector_type(4)));
typedef float f32x4 __attribute__((ext_vector_type(4)));
typedef GAS unsigned gu32;
#define RLX_AGENT __ATOMIC_RELAXED, __HIP_MEMORY_SCOPE_AGENT
#define LDS_WAIT() asm volatile("s_waitcnt lgkmcnt(0)" ::: "memory")
#define VM_WAIT() asm volatile("s_waitcnt vmcnt(0)" ::: "memory")
constexpr int NWAVES = 8;
constexpr int RING_BYTES = 131072, LDS_BYTES = 163840, LDSCTL_OFF = LDS_BYTES - 1024, MISC_OFF = LDSCTL_OFF + 320;
constexpr int CW_BAR = 4096, CW_ADA = 16384  ;
__device__ __forceinline__ unsigned pk2(float lo, float hi) { return (unsigned)f2bf(lo) | ((unsigned)f2bf(hi) << 16); }

#define XB_TMO      128
#define XB_XCNT(j)  (256  + 64 * (j))
#define XB_XSUB(j)  (1280 + 64 * (j))
#define XB_XGEN(j)  (2304 + 64 * (j))
#define XB_TOP      3328
#define XB_TOPGEN   3392
#define XCD_BAR_WORDS 3456
#define XB_SPIN_CAP (1u << 18)

__device__ __forceinline__ unsigned xb_ld(unsigned* p)              { return __hip_atomic_load(p, __ATOMIC_RELAXED, __HIP_MEMORY_SCOPE_AGENT); }
__device__ __forceinline__ unsigned xb_add(unsigned* p, unsigned v) { return __hip_atomic_fetch_add(p, v, __ATOMIC_RELAXED, __HIP_MEMORY_SCOPE_AGENT); }
__device__ __forceinline__ unsigned xb_xcc_id() { return (unsigned)__builtin_amdgcn_s_getreg((3 << 11) | 20) & 0xFu; }
#define XB_SPIN(cond, bar) do { unsigned _sp = 0; while (cond) { __builtin_amdgcn_s_sleep(1); \
    if ((++_sp & 255u) == 0u) { if (xb_ld(&(bar)[XB_TMO])) break; if (_sp > XB_SPIN_CAP) { atomicAdd(&(bar)[XB_TMO], 1u); break; } } } } while (0)

struct XcdBarrier {
    unsigned* bar; unsigned x;
    volatile LAS unsigned* st;
};

__device__ __forceinline__ XcdBarrier xcd_barrier_post(unsigned* bar, volatile LAS unsigned* st) {
    XcdBarrier b; b.bar = bar; b.x = xb_xcc_id(); b.st = st;
    if (threadIdx.x == 0) (void)xb_add(&bar[XB_XCNT(b.x)], 1u);
    return b;
}
__device__ __forceinline__ void xcd_barrier_complete(unsigned* bar, unsigned x, unsigned& nloc, unsigned& nx) {
    const unsigned G = gridDim.x * gridDim.y * gridDim.z;
    unsigned sum, cnt, mine, sp = 0u;
    for (;;) {
        sum = 0u; cnt = 0u; mine = 0u;
#pragma unroll
        for (unsigned j = 0; j < 16; ++j) { const unsigned c = xb_ld(&bar[XB_XCNT(j)]); sum += c; cnt += (c > 0u) ? 1u : 0u; mine = (j == x) ? c : mine; }
        if (sum == G) break;
        __builtin_amdgcn_s_sleep(1);
        if ((++sp & 255u) == 0u) { if (xb_ld(&bar[XB_TMO])) break; if (sp > XB_SPIN_CAP) { atomicAdd(&bar[XB_TMO], 1u); break; } }
    }
    nloc = mine > 0u ? mine : 1u; nx = cnt > 0u ? cnt : 1u;
}

__device__ __forceinline__ void xcd_barrier(const XcdBarrier& b) {
    asm volatile("s_waitcnt vmcnt(0)" ::: "memory");
    __syncthreads();
    if (threadIdx.x == 0) {
        unsigned* bar = b.bar;
        __builtin_amdgcn_s_waitcnt(0);
        unsigned nloc = b.st[0], nx = b.st[1];
        if (nloc == 0u) { xcd_barrier_complete(bar, b.x, nloc, nx); b.st[0] = nloc; b.st[1] = nx; }
        const unsigned old = xb_add(&bar[XB_XSUB(b.x)], 1u);
        const unsigned gen = old / nloc;
        if (old + 1u == (gen + 1u) * nloc) {
            __builtin_amdgcn_fence(__ATOMIC_RELEASE, "agent");
            asm volatile("s_waitcnt vmcnt(0)" ::: "memory");
            const unsigned og = xb_add(&bar[XB_TOP], 1u);
            const unsigned tg = og / nx;
            if (og + 1u == (tg + 1u) * nx) xb_add(&bar[XB_TOPGEN], 1u);
            else XB_SPIN(xb_ld(&bar[XB_TOPGEN]) == tg, bar);
            __builtin_amdgcn_fence(__ATOMIC_ACQUIRE, "agent");
            xb_add(&bar[XB_XGEN(b.x)], 1u);
            asm volatile("s_waitcnt vmcnt(0)" ::: "memory");
        } else {
            XB_SPIN(xb_ld(&bar[XB_XGEN(b.x)]) == gen, bar);
            __builtin_amdgcn_fence(__ATOMIC_ACQUIRE, "agent");
            asm volatile("s_waitcnt vmcnt(0)" ::: "memory");
        }
    }
    __syncthreads();
}


__device__ __forceinline__ float wave_sum(float v) {
#pragma unroll
    for (int o = 1; o < 64; o <<= 1) v += __shfl_xor(v, o);
    return v;
}

struct Args { const void* in[24]; float* out; unsigned char* ws; int ph_lo, ph_hi; };

__device__ __forceinline__ void p0_ada(const float* c, const float* w_ada, float* part, int gw, int NGW, int lane) {
    for (int it = gw; it < 48 * 32; it += NGW) {
        const int cg = it % 48, ks = it / 48, k0 = ks * 64;
        const float c0 = siluf_(c[k0 + lane]), c1 = siluf_(c[DM + k0 + lane]);
        f32x4 a0 = {0.f, 0.f, 0.f, 0.f}, a1 = {0.f, 0.f, 0.f, 0.f};
        const f32x4* wp = (const f32x4*)(w_ada + (size_t)k0 * 12288 + cg * 256) + lane;
#pragma unroll 16
        for (int kk = 0; kk < 64; ++kk) { const f32x4 w = wp[(size_t)kk * 3072]; const float s0 = __shfl(c0, kk), s1 = __shfl(c1, kk); a0 += s0 * w; a1 += s1 * w; }
        f32x4* pp = (f32x4*)(part + (size_t)ks * 2 * 12288 + cg * 256) + lane;
        pp[0] = a0; pp[3072] = a1;
    }
}
__device__ __forceinline__ void p1_modfinal(const float* b_ada, const float* part, float* mod, int gw, int NGW, int lane) {
    for (int it = gw; it < 96; it += NGW) { const int cg = it >> 1, b = it & 1;
        f32x4 s = *((const f32x4*)(b_ada + cg * 256) + lane);
#pragma unroll 8
        for (int j = 0; j < 32; ++j) s += *((const f32x4*)(part + ((size_t)j * 2 + b) * 12288 + cg * 256) + lane);
        *((f32x4*)(mod + b * 12288 + cg * 256) + lane) = s; }
}
__device__ __forceinline__ void p0_cs(const int* pos, float2* cs, int gw, int NGW, int lane) {
    for (int it = gw; it < MTOK * 32 / 64; it += NGW) { const int idx = it * 64 + lane, m = idx >> 5, i = idx & 31;
        const float inv = 1.0f / powf(10000.0f, (float)(2 * i) / 64.0f); const float ang = (float)pos[m] * inv;
        float s, c; sincosf(ang, &s, &c); cs[idx] = make_float2(c, s); }
}
template <class SrcCol>
__device__ __forceinline__ void tr_item(const float* W, int K, int Nsrc, bf16_t* WT, LAS float* scr, int kb, int nb, int lane, SrcCol sc, const float* kgain, float scale) {
    const int k0 = 64 * kb, n0 = 64 * nb; const int c4 = (lane & 15) * 4; const int ncol = sc(n0 + c4);
#pragma unroll 8
    for (int i = 0; i < 16; ++i) { const int kk = 4 * i + (lane >> 4); f32x4 v = {0.f, 0.f, 0.f, 0.f};
        if (ncol >= 0) v = *(const f32x4*)(W + (size_t)(k0 + kk) * Nsrc + ncol);
        float s = scale; if (kgain) s *= kgain[k0 + kk];
        LAS float* d = scr + kk * 65 + c4; d[0] = v[0] * s; d[1] = v[1] * s; d[2] = v[2] * s; d[3] = v[3] * s; }
    LDS_WAIT(); asm volatile("" ::: "memory");
    const int c = lane & 7;
#pragma unroll
    for (int j = 0; j < 8; ++j) { const int n = (lane >> 3) + 8 * j; const LAS float* s = scr + (8 * c) * 65 + n;
        v4u o; o.x = pk2(s[0 * 65], s[1 * 65]); o.y = pk2(s[2 * 65], s[3 * 65]); o.z = pk2(s[4 * 65], s[5 * 65]); o.w = pk2(s[6 * 65], s[7 * 65]);
        *(v4u*)(WT + (size_t)(n0 + n) * K + k0 + 8 * c) = o; }
    LDS_WAIT(); asm volatile("" ::: "memory");
}
struct ScNat { int N; __device__ int operator()(int n) const { return n < N ? n : -1; } };
struct ScQ { __device__ int operator()(int n) const { const int h = n / 192, w = n % 192; if (w < 128) return n; const int p = w - 128, g = p >> 3, e = p & 7; return h * 192 + 128 + (e < 4 ? 4 * g + e : 32 + 4 * g + (e - 4)); } };
struct ScUp { __device__ int operator()(int n) const { const int pn = n >> 8, r = n & 255; return r < 128 ? 128 * pn + r : DFF + 128 * pn + (r - 128); } };
template <class SrcCol>
__device__ __forceinline__ void tr_matrix(const float* W, int K, int Nsrc, int Ndst, bf16_t* WT, LAS float* scr, int& cursor, int gw, int NGW, int lane, SrcCol sc, const float* kgain, float scale) {
    const int nblk = Ndst / 64, nitems = (K / 64) * nblk;
    int it = gw - cursor % NGW; if (it < 0) it += NGW;
    for (; it < nitems; it += NGW) tr_item(W, K, Nsrc, WT, scr, it / nblk, it % nblk, lane, sc, kgain, scale);
    cursor += nitems;
}

namespace pg8 {
struct EpiZ {
    static constexpr bool PERM = true, AFTER_DRAIN = false, APERM = false;
    bf16_t* Z; float* statq; float* statkv;
    __device__ __forceinline__ void operator()(const f32x4 (&acc)[2][2][4][2], const Unit& u, int wr, int wc, int fr, int fq) const {
        const int row0 = u.pm * BM + wr * 64 + fr, col0 = u.pn * BM + wc * 32 + 8 * fq;
#pragma unroll
        for (int ai = 0; ai < 2; ++ai)
#pragma unroll
            for (int m = 0; m < 4; ++m) { const int row = row0 + ai * HALF + m * 16; bf16_t* rowp = Z + (size_t)row * LDZ + col0; float ss = 0.f;
#pragma unroll
                for (int bj = 0; bj < 2; ++bj) { const f32x4 v0 = acc[ai][bj][m][0], v1 = acc[ai][bj][m][1];
                    u32x4 w; w.x = cvt_pk_bf16(v0[0], v0[1]); w.y = cvt_pk_bf16(v0[2], v0[3]); w.z = cvt_pk_bf16(v1[0], v1[1]); w.w = cvt_pk_bf16(v1[2], v1[3]);
                    *(u32x4*)(rowp + bj * HALF) = w;
                    ss += (v0[0] * v0[0] + v0[1] * v0[1]) + (v0[2] * v0[2] + v0[3] * v0[3]) + (v1[0] * v1[0] + v1[1] * v1[1]) + (v1[2] * v1[2] + v1[3] * v1[3]); }
                if (u.pn < 3) { ss += __shfl_xor(ss, 16); ss += __shfl_xor(ss, 32);
                    if (fq == 0) { if (u.pn < 2) statq[row * 8 + u.pn * 4 + wc] = ss; else statkv[row * 4 + wc] = ss; } } }
    }
};
}


namespace pg8 {
__device__ __forceinline__ u32x4 pack8(const f32x4 v0, const f32x4 v1) { u32x4 w; w.x = cvt_pk_bf16(v0[0], v0[1]); w.y = cvt_pk_bf16(v0[2], v0[3]); w.z = cvt_pk_bf16(v1[0], v1[1]); w.w = cvt_pk_bf16(v1[2], v1[3]); return w; }
__device__ __forceinline__ void unpack8(const u32x4 w, f32x4& a, f32x4& b) {
    a[0] = __uint_as_float(w.x << 16); a[1] = __uint_as_float(w.x & 0xffff0000u); a[2] = __uint_as_float(w.y << 16); a[3] = __uint_as_float(w.y & 0xffff0000u);
    b[0] = __uint_as_float(w.z << 16); b[1] = __uint_as_float(w.z & 0xffff0000u); b[2] = __uint_as_float(w.w << 16); b[3] = __uint_as_float(w.w & 0xffff0000u); }
struct EpiStoreB {
    static constexpr bool PERM = true, AFTER_DRAIN = false, APERM = false;
    bf16_t* C; int ldc;
    __device__ __forceinline__ void operator()(const f32x4 (&acc)[2][2][4][2], const Unit& u, int wr, int wc, int fr, int fq) const {
        const int row0 = u.pm * BM + wr * 64 + fr, col0 = u.pn * BM + wc * 32 + 8 * fq;
#pragma unroll
        for (int ai = 0; ai < 2; ++ai)
#pragma unroll
            for (int m = 0; m < 4; ++m) { bf16_t* rowp = C + (size_t)(row0 + ai * HALF + m * 16) * ldc + col0;
#pragma unroll
                for (int bj = 0; bj < 2; ++bj) *(u32x4*)(rowp + bj * HALF) = pack8(acc[ai][bj][m][0], acc[ai][bj][m][1]); }
    }
};
struct EpiQo {
    static constexpr bool PERM = true, AFTER_DRAIN = false, APERM = false;
    bf16_t* Q; const float* statq; const float2* cs;
    __device__ __forceinline__ void operator()(const f32x4 (&acc)[2][2][4][2], const Unit& u, int wr, int wc, int fr, int fq) const {
        const int row0 = u.pm * BM + wr * 64 + fr, col0 = u.pn * BM + wc * 32 + 8 * fq;
#pragma unroll
        for (int ai = 0; ai < 2; ++ai)
#pragma unroll
            for (int m = 0; m < 4; ++m) { const int row = row0 + ai * HALF + m * 16; bf16_t* rowp = Q + (size_t)row * 1536 + col0;
                const f32x4 s0 = *(const f32x4*)(statq + row * 8), s1 = *(const f32x4*)(statq + row * 8 + 4);
                const float rstd = rsqrtf(((s0[0] + s0[1]) + (s0[2] + s0[3]) + (s1[0] + s1[1]) + (s1[2] + s1[3])) * (1.f / 512.f) + EPSN);
#pragma unroll
                for (int bj = 0; bj < 2; ++bj) { f32x4 v0 = acc[ai][bj][m][0] * rstd, v1 = acc[ai][bj][m][1] * rstd;
                    const int hw = (u.pn * BM + bj * HALF + wc * 32) % 192;
                    if (hw >= 128) { const int g = ((hw - 128) >> 3) + fq; const float2* c = cs + row * 32 + 4 * g;
#pragma unroll
                        for (int j = 0; j < 4; ++j) { const float2 cc = c[j]; const float x1 = v0[j], x2 = v1[j]; v0[j] = x1 * cc.x - x2 * cc.y; v1[j] = x2 * cc.x + x1 * cc.y; } }
                    *(u32x4*)(rowp + bj * HALF) = pack8(v0, v1); } }
    }
};
struct EpiKVo {
    static constexpr bool PERM = true, AFTER_DRAIN = false, APERM = false;
    bf16_t* Kf; bf16_t* V; const float* statkv;
    __device__ __forceinline__ void operator()(const f32x4 (&acc)[2][2][4][2], const Unit& u, int wr, int wc, int fr, int fq) const {
        const int row0 = u.pm * BM + wr * 64 + fr, c0 = wc * 32 + 8 * fq;
#pragma unroll
        for (int ai = 0; ai < 2; ++ai)
#pragma unroll
            for (int m = 0; m < 4; ++m) { const int row = row0 + ai * HALF + m * 16;
                const f32x4 s0 = *(const f32x4*)(statkv + row * 4);
                const float rstd = rsqrtf(((s0[0] + s0[1]) + (s0[2] + s0[3])) * (1.f / 256.f) + EPSN);
                *(u32x4*)(Kf + (size_t)row * 1536 + u.pn * 192 + c0) = pack8(acc[ai][0][m][0] * rstd, acc[ai][0][m][1] * rstd);
                *(u32x4*)(V + (size_t)row * 1024 + u.pn * 128 + c0) = pack8(acc[ai][1][m][0] * rstd, acc[ai][1][m][1] * rstd); }
    }
};
struct EpiGateo {
    static constexpr bool PERM = true, AFTER_DRAIN = false, APERM = false;
    bf16_t* C; const bf16_t* z; int goff; const bf16_t* add;
    __device__ __forceinline__ void operator()(const f32x4 (&acc)[2][2][4][2], const Unit& u, int wr, int wc, int fr, int fq) const {
        const int row0 = u.pm * BM + wr * 64 + fr, col0 = u.pn * BM + wc * 32 + 8 * fq;
#pragma unroll
        for (int ai = 0; ai < 2; ++ai)
#pragma unroll
            for (int m = 0; m < 4; ++m) { const int row = row0 + ai * HALF + m * 16;
#pragma unroll
                for (int bj = 0; bj < 2; ++bj) { const int col = col0 + bj * HALF;
                    f32x4 g0, g1; unpack8(*(const u32x4*)(z + (size_t)row * LDZ + goff + col), g0, g1);
                    f32x4 v0 = acc[ai][bj][m][0], v1 = acc[ai][bj][m][1];
#pragma unroll
                    for (int j = 0; j < 4; ++j) { v0[j] *= sigmoidf_(g0[j]); v1[j] *= sigmoidf_(g1[j]); }
                    if (add) { f32x4 a0, a1; unpack8(*(const u32x4*)(add + (size_t)row * DM + col), a0, a1); v0 += a0; v1 += a1; }
                    *(u32x4*)(C + (size_t)row * DM + col) = pack8(v0, v1); } }
    }
};
}

__device__ __forceinline__ void ph_kpe(const bf16_t* z, bf16_t* Kf, const float2* cs, int gw, int NGW, int lane) {
    for (int m2 = gw; m2 < MTOK / 2; m2 += NGW) { const int m = m2 * 2 + (lane >> 5), i = lane & 31; const bf16_t* zr = z + (size_t)m * LDZ + OFF_KROPE;
        const float x1 = bf2f(zr[i]), x2 = bf2f(zr[32 + i]); const float2 c = cs[m * 32 + i];
        const bf16_t o1 = f2bf(x1 * c.x - x2 * c.y), o2 = f2bf(x2 * c.x + x1 * c.y); const int p1 = rope_pos(i), p2 = rope_pos(32 + i);
#pragma unroll
        for (int h = 0; h < 8; ++h) { Kf[(size_t)m * 1536 + h * 192 + 128 + p1] = o1; Kf[(size_t)m * 1536 + h * 192 + 128 + p2] = o2; } }
}
__device__ __forceinline__ void ph_glanorm(bf16_t* og, const bf16_t* z, const float* g, int gw, int NGW, int lane) {
    const f32x4 ga = *((const f32x4*)g + lane * 2), gb = *((const f32x4*)g + lane * 2 + 1);
    for (int it = gw; it < MTOK * 4; it += NGW) { const int m = it >> 2, h = it & 3; bf16_t* o = og + (size_t)m * DM + h * 512 + lane * 8;
        f32x4 a, b, za, zb; pg8::unpack8(*(const pg8::u32x4*)o, a, b); pg8::unpack8(*(const pg8::u32x4*)(z + (size_t)m * LDZ + OFF_GOG + h * 512 + lane * 8), za, zb);
        float s = (a[0] * a[0] + a[1] * a[1]) + (a[2] * a[2] + a[3] * a[3]) + (b[0] * b[0] + b[1] * b[1]) + (b[2] * b[2] + b[3] * b[3]);
        const float rstd = rsqrtf(wave_sum(s) * (1.f / 512.f) + EPSN);
#pragma unroll
        for (int j = 0; j < 4; ++j) { a[j] = a[j] * rstd * ga[j] * siluf_(za[j]); b[j] = b[j] * rstd * gb[j] * siluf_(zb[j]); }
        *(pg8::u32x4*)o = pg8::pack8(a, b); }
}
template <bool H2>
__device__ __forceinline__ void ph_resnorm(const float* xin, const bf16_t* y, const float* g1, const float* mod, int off_gate, float* xout, const float* g2, int off_shift, int off_scale, bf16_t* h2, int gw, int NGW, int lane) {
    for (int m = gw; m < MTOK; m += NGW) { const float* mb = mod + (m / SEQ) * 12288;
        f32x4 ya[4], yb[4]; float s = 0.f;
#pragma unroll
        for (int j = 0; j < 4; ++j) { pg8::unpack8(*(const pg8::u32x4*)(y + (size_t)m * DM + 8 * (lane + 64 * j)), ya[j], yb[j]);
            s += (ya[j][0] * ya[j][0] + ya[j][1] * ya[j][1]) + (ya[j][2] * ya[j][2] + ya[j][3] * ya[j][3]) + (yb[j][0] * yb[j][0] + yb[j][1] * yb[j][1]) + (yb[j][2] * yb[j][2] + yb[j][3] * yb[j][3]); }
        const float rstd = rsqrtf(wave_sum(s) * (1.f / DM) + EPSN); float s2 = 0.f;
#pragma unroll
        for (int j = 0; j < 4; ++j) { const int e = 8 * (lane + 64 * j);
            const f32x4 xa = *(const f32x4*)(xin + (size_t)m * DM + e), xb = *(const f32x4*)(xin + (size_t)m * DM + e + 4);
            ya[j] = xa + *(const f32x4*)(mb + off_gate + e) * (ya[j] * rstd * *(const f32x4*)(g1 + e));
            yb[j] = xb + *(const f32x4*)(mb + off_gate + e + 4) * (yb[j] * rstd * *(const f32x4*)(g1 + e + 4));
            *(f32x4*)(xout + (size_t)m * DM + e) = ya[j]; *(f32x4*)(xout + (size_t)m * DM + e + 4) = yb[j];
            s2 += (ya[j][0] * ya[j][0] + ya[j][1] * ya[j][1]) + (ya[j][2] * ya[j][2] + ya[j][3] * ya[j][3]) + (yb[j][0] * yb[j][0] + yb[j][1] * yb[j][1]) + (yb[j][2] * yb[j][2] + yb[j][3] * yb[j][3]); }
        if (H2) { const float r2 = rsqrtf(wave_sum(s2) * (1.f / DM) + EPSN);
#pragma unroll
            for (int j = 0; j < 4; ++j) { const int e = 8 * (lane + 64 * j);
                const f32x4 ha = ya[j] * r2 * *(const f32x4*)(g2 + e) * (1.f + *(const f32x4*)(mb + off_scale + e)) + *(const f32x4*)(mb + off_shift + e);
                const f32x4 hb = yb[j] * r2 * *(const f32x4*)(g2 + e + 4) * (1.f + *(const f32x4*)(mb + off_scale + e + 4)) + *(const f32x4*)(mb + off_shift + e + 4);
                *(pg8::u32x4*)(h2 + (size_t)m * DM + e) = pg8::pack8(ha, hb); } } }
}
__device__ __forceinline__ void ph_convact(const bf16_t* u, const float* cw, const float* cb, bf16_t* act, int gw, int NGW, int lane) {
    for (int it = gw; it < 256 * 11; it += NGW) { const int r0 = (it / 11) * 32, j = (it % 11) * 512 + 8 * lane;
        f32x4 wa[3][2], wv[3][2];
#pragma unroll
        for (int k = 0; k < 3; ++k) { wa[k][0] = *(const f32x4*)(cw + k * DFF2 + j); wa[k][1] = *(const f32x4*)(cw + k * DFF2 + j + 4); wv[k][0] = *(const f32x4*)(cw + k * DFF2 + DFF + j); wv[k][1] = *(const f32x4*)(cw + k * DFF2 + DFF + j + 4); }
        const f32x4 ba0 = *(const f32x4*)(cb + j), ba1 = *(const f32x4*)(cb + j + 4), bv0 = *(const f32x4*)(cb + DFF + j), bv1 = *(const f32x4*)(cb + DFF + j + 4);
        f32x4 a2[2], a1[2], v2[2], v1[2];
        if (r0 % SEQ == 0) { a2[0] = a2[1] = a1[0] = a1[1] = v2[0] = v2[1] = v1[0] = v1[1] = (f32x4){0.f, 0.f, 0.f, 0.f}; }
        else { pg8::unpack8(*(const pg8::u32x4*)(u + (size_t)(r0 - 2) * DFF2 + j), a2[0], a2[1]); pg8::unpack8(*(const pg8::u32x4*)(u + (size_t)(r0 - 1) * DFF2 + j), a1[0], a1[1]);
               pg8::unpack8(*(const pg8::u32x4*)(u + (size_t)(r0 - 2) * DFF2 + DFF + j), v2[0], v2[1]); pg8::unpack8(*(const pg8::u32x4*)(u + (size_t)(r0 - 1) * DFF2 + DFF + j), v1[0], v1[1]); }
#pragma unroll 4
        for (int r = 0; r < 32; ++r) { const size_t m = (size_t)r0 + r; f32x4 a0[2], v0[2];
            pg8::unpack8(*(const pg8::u32x4*)(u + m * DFF2 + j), a0[0], a0[1]); pg8::unpack8(*(const pg8::u32x4*)(u + m * DFF2 + DFF + j), v0[0], v0[1]);
            f32x4 ca0 = ba0 + wa[0][0] * a2[0] + wa[1][0] * a1[0] + wa[2][0] * a0[0], ca1 = ba1 + wa[0][1] * a2[1] + wa[1][1] * a1[1] + wa[2][1] * a0[1];
            const f32x4 cv0 = bv0 + wv[0][0] * v2[0] + wv[1][0] * v1[0] + wv[2][0] * v0[0], cv1 = bv1 + wv[0][1] * v2[1] + wv[1][1] * v1[1] + wv[2][1] * v0[1];
#pragma unroll
            for (int q = 0; q < 4; ++q) { ca0[q] = gelu_tanh(ca0[q]) * cv0[q]; ca1[q] = gelu_tanh(ca1[q]) * cv1[q]; }
            *(pg8::u32x4*)(act + m * DFF + j) = pg8::pack8(ca0, ca1);
            a2[0] = a1[0]; a2[1] = a1[1]; a1[0] = a0[0]; a1[1] = a0[1]; v2[0] = v1[0]; v2[1] = v1[1]; v1[0] = v0[0]; v1[1] = v0[1]; } }
}
namespace pg8 {
struct EpiU {
    static constexpr bool PERM = true, AFTER_DRAIN = false, APERM = false;
    bf16_t* U;
    __device__ __forceinline__ void operator()(const f32x4 (&acc)[2][2][4][2], const Unit& u, int wr, int wc, int fr, int fq) const {
        const int row0 = u.pm * BM + wr * 64 + fr, c0 = u.pn * 128 + wc * 32 + 8 * fq;
#pragma unroll
        for (int ai = 0; ai < 2; ++ai)
#pragma unroll
            for (int m = 0; m < 4; ++m) { bf16_t* rowp = U + (size_t)(row0 + ai * HALF + m * 16) * DFF2 + c0;
                *(u32x4*)(rowp) = pack8(acc[ai][0][m][0], acc[ai][0][m][1]); *(u32x4*)(rowp + DFF) = pack8(acc[ai][1][m][0], acc[ai][1][m][1]); }
    }
};
}

namespace pg8 {
__device__ __forceinline__ float dpp_shr1(float v) { return __builtin_bit_cast(float, __builtin_amdgcn_update_dpp(0, __builtin_bit_cast(int, v), 0x111, 0xf, 0xf, true)); }
__device__ __forceinline__ float gelu_fast(float a) { const float u2 = a * (1.5957691216057308f + 0.07135481627f * a * a); return a * __builtin_amdgcn_rcpf(1.f + __builtin_amdgcn_exp2f(-1.4426950408889634f * u2)); }
struct EpiConv {
    static constexpr bool PERM = true, AFTER_DRAIN = false, APERM = true;
    bf16_t* act; const float* cw; const float* cb; bf16_t* hlast; float* hfirst; PG8_LAS float* xch;
    __device__ __forceinline__ void operator()(f32x4 (&acc)[2][2][4][2], const Unit& u, int wr, int wc, int fr, int fq) const {
        const int tok0 = u.pm * BM + 128 * wr + 8 * fr, chb = u.pn * 128 + wc * 32 + 8 * fq, colb = u.pn * BM + wc * 32 + 8 * fq;
        PG8_LAS float* xp = xch + (wc * 4 + fq) * 32;
        if (wr == 0 && fr == 15) {
#pragma unroll
            for (int n = 0; n < 2; ++n)
#pragma unroll
                for (int e = 0; e < 4; ++e) { xp[n * 4 + e] = acc[1][0][2][n][e]; xp[8 + n * 4 + e] = acc[1][0][3][n][e]; xp[16 + n * 4 + e] = acc[1][1][2][n][e]; xp[24 + n * 4 + e] = acc[1][1][3][n][e]; } }
        asm volatile("s_waitcnt lgkmcnt(0)" ::: "memory"); __builtin_amdgcn_s_barrier(); asm volatile("" ::: "memory");
        if (wr == 1 && fr == 15) {
#pragma unroll
            for (int s = 0; s < 2; ++s) { bf16_t* hp = hlast + ((size_t)u.pm * 2 + s) * DFF2 + colb;
                *(u32x4*)(hp) = pack8(acc[1][0][2 + s][0], acc[1][0][2 + s][1]); *(u32x4*)(hp + HALF) = pack8(acc[1][1][2 + s][0], acc[1][1][2 + s][1]); } }
        unsigned keep[8][2];
#pragma unroll
        for (int n = 0; n < 2; ++n) { const int ch = chb + 4 * n;
            const f32x4 wa0 = *(const f32x4*)(cw + ch), wa1 = *(const f32x4*)(cw + DFF2 + ch), wa2 = *(const f32x4*)(cw + 2 * DFF2 + ch), ba = *(const f32x4*)(cb + ch);
            const f32x4 wv0 = *(const f32x4*)(cw + DFF + ch), wv1 = *(const f32x4*)(cw + DFF2 + DFF + ch), wv2 = *(const f32x4*)(cw + 2 * DFF2 + DFF + ch), bv = *(const f32x4*)(cb + DFF + ch);
            f32x4 pa6, pa7, pv6, pv7;
#pragma unroll
            for (int e = 0; e < 4; ++e) { pa6[e] = dpp_shr1(acc[1][0][2][n][e]); pa7[e] = dpp_shr1(acc[1][0][3][n][e]); pv6[e] = dpp_shr1(acc[1][1][2][n][e]); pv7[e] = dpp_shr1(acc[1][1][3][n][e]); }
            if (wr == 1 && fr == 0) {
#pragma unroll
                for (int e = 0; e < 4; ++e) { pa6[e] = xp[n * 4 + e]; pa7[e] = xp[8 + n * 4 + e]; pv6[e] = xp[16 + n * 4 + e]; pv7[e] = xp[24 + n * 4 + e]; } }
            f32x4 a2 = pa6, a1 = pa7, v2 = pv6, v1 = pv7;
#pragma unroll
            for (int s = 0; s < 8; ++s) { const f32x4 a0 = acc[s >> 2][0][s & 3][n], v0 = acc[s >> 2][1][s & 3][n];
                f32x4 ca = ba + wa0 * a2 + wa1 * a1 + wa2 * a0; const f32x4 cv = bv + wv0 * v2 + wv1 * v1 + wv2 * v0;
                if (s < 2 && wr == 0 && fr == 0) { float* hp = hfirst + ((size_t)u.pm * 2 + s) * DFF2 + colb + 4 * n; *(f32x4*)hp = ca; *(f32x4*)(hp + HALF) = cv; }
#pragma unroll
                for (int e = 0; e < 4; ++e) ca[e] = gelu_fast(ca[e]) * cv[e];
                const unsigned lo = cvt_pk_bf16(ca[0], ca[1]), hi = cvt_pk_bf16(ca[2], ca[3]);
                if (n == 0) { keep[s][0] = lo; keep[s][1] = hi; }
                else { u32x4 w; w.x = keep[s][0]; w.y = keep[s][1]; w.z = lo; w.w = hi; *(u32x4*)(act + (size_t)(tok0 + s) * DFF + chb) = w; }
                a2 = a1; a1 = a0; v2 = v1; v1 = v0; } }
    }
};
}
__device__ __forceinline__ void ph_convfix(const bf16_t* hlast, const float* hfirst, const float* cw, bf16_t* act, int gw, int NGW, int lane) {
    for (int it = gw; it < 32 * 2 * 22; it += NGW) { const int pm = it / 44, s = (it / 22) & 1, seg = it % 22; if (pm % 16 == 0) continue;
        const int ch = seg * 256 + 4 * lane, pn = ch >> 7, col = pn * 256 + (ch & 127);
        f32x4 ca = *(const f32x4*)(hfirst + ((size_t)pm * 2 + s) * DFF2 + col), cv = *(const f32x4*)(hfirst + ((size_t)pm * 2 + s) * DFF2 + col + 128);
        const bf16_t* h0 = hlast + ((size_t)(pm - 1) * 2) * DFF2 + col; const bf16_t* h1 = h0 + DFF2;
        const uint2 a0r = *(const uint2*)h0, a1r = *(const uint2*)h1, v0r = *(const uint2*)(h0 + 128), v1r = *(const uint2*)(h1 + 128);
        f32x4 a0, a1, v0, v1;
        a0[0] = __uint_as_float(a0r.x << 16); a0[1] = __uint_as_float(a0r.x & 0xffff0000u); a0[2] = __uint_as_float(a0r.y << 16); a0[3] = __uint_as_float(a0r.y & 0xffff0000u);
        a1[0] = __uint_as_float(a1r.x << 16); a1[1] = __uint_as_float(a1r.x & 0xffff0000u); a1[2] = __uint_as_float(a1r.y << 16); a1[3] = __uint_as_float(a1r.y & 0xffff0000u);
        v0[0] = __uint_as_float(v0r.x << 16); v0[1] = __uint_as_float(v0r.x & 0xffff0000u); v0[2] = __uint_as_float(v0r.y << 16); v0[3] = __uint_as_float(v0r.y & 0xffff0000u);
        v1[0] = __uint_as_float(v1r.x << 16); v1[1] = __uint_as_float(v1r.x & 0xffff0000u); v1[2] = __uint_as_float(v1r.y << 16); v1[3] = __uint_as_float(v1r.y & 0xffff0000u);
        const f32x4 wa0 = *(const f32x4*)(cw + ch), wa1 = *(const f32x4*)(cw + DFF2 + ch), wv0 = *(const f32x4*)(cw + DFF + ch), wv1 = *(const f32x4*)(cw + DFF2 + DFF + ch);
        if (s == 0) { ca += wa0 * a0 + wa1 * a1; cv += wv0 * v0 + wv1 * v1; } else { ca += wa0 * a1; cv += wv0 * v1; }
#pragma unroll
        for (int e = 0; e < 4; ++e) ca[e] = pg8::gelu_fast(ca[e]) * cv[e];
        uint2 w; w.x = pg8::cvt_pk_bf16(ca[0], ca[1]); w.y = pg8::cvt_pk_bf16(ca[2], ca[3]);
        *(uint2*)(act + ((size_t)pm * 256 + s) * DFF + ch) = w; }
}
namespace att {
typedef short bf16x8 __attribute__((ext_vector_type(8)));
typedef short s16x4 __attribute__((ext_vector_type(4)));
typedef float f32x16 __attribute__((ext_vector_type(16)));
typedef __attribute__((address_space(3))) const unsigned char* lcp;
constexpr int KROW = 400, VROW = 320, KBYTES = 64 * KROW, VBYTES = 64 * VROW, BUFB = KBYTES + VBYTES;
constexpr size_t WS_ATTP = 396 * MiB, WS_ATTML = 68 * MiB + 512 * 1024;
__device__ __forceinline__ int crow(int r, int hi) { return (r & 3) + 8 * (r >> 2) + 4 * hi; }
__device__ __forceinline__ s16x4 vtr(lcp p) { typedef short v4i16_t __attribute__((ext_vector_type(4))); return __builtin_bit_cast(s16x4, __builtin_amdgcn_ds_read_tr16_b64_v4i16((__attribute__((address_space(3))) v4i16_t*)p)); }
__device__ __forceinline__ float hswap_max(float x) { auto rr = __builtin_amdgcn_permlane32_swap(__float_as_uint(x), __float_as_uint(x), false, false); return fmaxf(__uint_as_float(rr[0]), __uint_as_float(rr[1])); }
__device__ __forceinline__ float hswap_add(float x) { auto rr = __builtin_amdgcn_permlane32_swap(__float_as_uint(x), __float_as_uint(x), false, false); return __uint_as_float(rr[0]) + __uint_as_float(rr[1]); }
__device__ __forceinline__ bf16x8 packp(const f32x16& p, int b) { pg8::u32x4 w; w.x = pg8::cvt_pk_bf16(p[b], p[b + 1]); w.y = pg8::cvt_pk_bf16(p[b + 2], p[b + 3]); w.z = pg8::cvt_pk_bf16(p[b + 4], p[b + 5]); w.w = pg8::cvt_pk_bf16(p[b + 6], p[b + 7]); return __builtin_bit_cast(bf16x8, w); }

__device__ __forceinline__ void segment(LAS unsigned char* L, const bf16_t* Q, const bf16_t* Kf, const bf16_t* V, int b, int h, int qblk, int t0, int t1, bf16_t* outp, int ostride, float2* ml, int wave, int lane_) {
    const int tid = fresh_tid(), lane = tid & 63, r32 = lane & 31, hh = lane >> 5;
    const size_t rowbase = (size_t)b * SEQ; const int R0 = qblk * 256, qrow = R0 + 32 * wave + r32;
    bf16x8 qf[12];
    { const bf16_t* qp = Q + (rowbase + qrow) * 1536 + h * 192 + 8 * hh;
#pragma unroll
      for (int d0 = 0; d0 < 12; ++d0) qf[d0] = *(const bf16x8*)(qp + 16 * d0); }
    f32x16 O[4];
#pragma unroll
    for (int d0 = 0; d0 < 4; ++d0)
#pragma unroll
        for (int r = 0; r < 16; ++r) O[d0][r] = 0.f;
    float m = -1e30f, l = 0.f;
    const int srow = tid >> 3, sch = tid & 7;
    const int kgo = srow * 1536 + sch * 8, klo = srow * KROW + sch * 16, vgo = srow * 1024 + sch * 8, vlo = KBYTES + srow * VROW + sch * 16;
    const bf16_t* Kh = Kf + rowbase * 1536 + h * 192; const bf16_t* Vh = V + rowbase * 1024 + h * 128;
    pg8::u32x4 sk[3], sv[2];
#define ATT_LOAD(t) do { _Pragma("unroll") for (int i = 0; i < 3; ++i) sk[i] = *(const pg8::u32x4*)(Kh + (size_t)(t) * 64 * 1536 + kgo + 64 * i); \
                         _Pragma("unroll") for (int i = 0; i < 2; ++i) sv[i] = *(const pg8::u32x4*)(Vh + (size_t)(t) * 64 * 1024 + vgo + 64 * i); } while (0)
#define ATT_WRITE(buf) do { _Pragma("unroll") for (int i = 0; i < 3; ++i) *(LAS pg8::u32x4*)(L + (buf) * BUFB + klo + 128 * i) = sk[i]; \
                            _Pragma("unroll") for (int i = 0; i < 2; ++i) *(LAS pg8::u32x4*)(L + (buf) * BUFB + vlo + 128 * i) = sv[i]; } while (0)
    ATT_LOAD(t0); ATT_WRITE(0); __syncthreads();
    int cur = 0;
    for (int t = t0; t < t1; ++t) {
        const bool more = (t + 1 < t1);
        if (more) ATT_LOAD(t + 1);
        if (64 * t <= R0 + 32 * wave + 31) {
            lcp Kb = (lcp)(L + cur * BUFB); lcp Vb = Kb + KBYTES;
            f32x16 p0, p1;
#pragma unroll
            for (int r = 0; r < 16; ++r) { p0[r] = 0.f; p1[r] = 0.f; }
            lcp ka = Kb + r32 * KROW + hh * 16;
#pragma unroll
            for (int d0 = 0; d0 < 12; ++d0) { const bf16x8 k0 = *(const __attribute__((address_space(3))) bf16x8*)(ka + d0 * 32), k1 = *(const __attribute__((address_space(3))) bf16x8*)(ka + 32 * KROW + d0 * 32);
                p0 = __builtin_amdgcn_mfma_f32_32x32x16_bf16(k0, qf[d0], p0, 0, 0, 0); p1 = __builtin_amdgcn_mfma_f32_32x32x16_bf16(k1, qf[d0], p1, 0, 0, 0); }
            if (64 * t + 63 > R0 + 32 * wave) {
                const float NEG = -__builtin_inff();
#pragma unroll
                for (int r = 0; r < 16; ++r) { const int key = 64 * t + crow(r, hh); if (key > qrow) p0[r] = NEG; if (key + 32 > qrow) p1[r] = NEG; }
            }
            float mx = fmaxf(p0[0], p1[0]);
#pragma unroll
            for (int r = 1; r < 16; ++r) mx = fmaxf(mx, fmaxf(p0[r], p1[r]));
            mx = hswap_max(mx);
            if (__any(mx > m)) { const float mn = fmaxf(m, mx), alpha = __builtin_amdgcn_exp2f(m - mn); m = mn; l *= alpha;
#pragma unroll
                for (int d0 = 0; d0 < 4; ++d0)
#pragma unroll
                    for (int r = 0; r < 16; ++r) O[d0][r] *= alpha; }
            float ps = 0.f;
#pragma unroll
            for (int r = 0; r < 16; ++r) { p0[r] = __builtin_amdgcn_exp2f(p0[r] - m); p1[r] = __builtin_amdgcn_exp2f(p1[r] - m); ps += p0[r] + p1[r]; }
            l += ps;
            bf16x8 pf[4]; pf[0] = packp(p0, 0); pf[1] = packp(p0, 8); pf[2] = packp(p1, 0); pf[3] = packp(p1, 8);
            lcp va = Vb + (4 * hh + ((lane & 15) >> 2)) * VROW + (16 * ((lane >> 4) & 1) + 4 * (lane & 3)) * 2;
#pragma unroll
            for (int d0 = 0; d0 < 4; ++d0)
#pragma unroll
                for (int ks = 0; ks < 4; ++ks) { const s16x4 lo = vtr(va + (16 * ks) * VROW + 64 * d0), hi = vtr(va + (16 * ks + 8) * VROW + 64 * d0);
                    const bf16x8 vf = {lo[0], lo[1], lo[2], lo[3], hi[0], hi[1], hi[2], hi[3]};
                    O[d0] = __builtin_amdgcn_mfma_f32_32x32x16_bf16(vf, pf[ks], O[d0], 0, 0, 0); }
        }
        if (more) ATT_WRITE(cur ^ 1);
        __syncthreads();
        cur ^= 1;
    }
#undef ATT_LOAD
#undef ATT_WRITE
    const float lt = hswap_add(l), inv = lt > 0.f ? 1.f / lt : 0.f;
    bf16_t* op = outp + (size_t)(32 * wave + r32) * ostride + 4 * hh;
#pragma unroll
    for (int d0 = 0; d0 < 4; ++d0)
#pragma unroll
        for (int g = 0; g < 4; ++g) { uint2 w; w.x = pg8::cvt_pk_bf16(O[d0][4 * g] * inv, O[d0][4 * g + 1] * inv); w.y = pg8::cvt_pk_bf16(O[d0][4 * g + 2] * inv, O[d0][4 * g + 3] * inv);
            *(uint2*)(op + 32 * d0 + 8 * g) = w; }
    if (ml && hh == 0) ml[32 * wave + r32] = make_float2(m, lt);
}
__device__ __forceinline__ int att_B(int j) { return (j * 544) / 14; }
__device__ __forceinline__ int att_off(int u) { return 64 * u - 2 * u * (u - 1); }
__device__ __forceinline__ void phase(LAS unsigned char* L, const bf16_t* Q, const bf16_t* Kf, const bf16_t* V, bf16_t* om, unsigned char* ws, int bh, int j, int wave, int lane) {
    bf16_t* PO = (bf16_t*)(ws + WS_ATTP); float2* PML = (float2*)(ws + WS_ATTML);
    const int b = bh >> 3, h = bh & 7, lo = att_B(j), hi = att_B(j + 1);
    int pos = lo, u = 0;
    while (att_off(u + 1) <= pos) ++u;
    while (pos < hi) { const int off = att_off(u), n = 4 * (16 - u), t0 = pos - off, t1 = (hi - off < n) ? hi - off : n, qb = 15 - u;
        if (t0 == 0 && t1 == n) segment(L, Q, Kf, V, b, h, qb, 0, n, om + ((size_t)b * SEQ + 256 * qb) * 1024 + h * 128, 1024, nullptr, wave, lane);
        else { const int slot = bh * 26 + (t0 > 0 ? 2 * j - 1 : 2 * j);
            segment(L, Q, Kf, V, b, h, qb, t0, t1, PO + (size_t)slot * 256 * 128, 128, PML + slot * 256, wave, lane); }
        pos = off + t1; ++u; }
}
__device__ __forceinline__ void combine(bf16_t* om, unsigned char* ws, int gw, int NGW, int lane) {
    const bf16_t* PO = (const bf16_t*)(ws + WS_ATTP); const float2* PML = (const float2*)(ws + WS_ATTML);
    for (int it = gw; it < 256 * 256; it += NGW) { const int un = it >> 8, row = it & 255, bh = un >> 4, u = un & 15, b = bh >> 3, h = bh & 7;
        const int off = att_off(u), n = 4 * (16 - u); int jf = 0, jl = 0;
        for (int jj = 1; jj < 14; ++jj) { if (att_B(jj) <= off) jf = jj; if (att_B(jj) < off + n) jl = jj; }
        if (jf == jl) continue;
        float mm = -3e38f; float2 ml[3]; int slot[3];
#pragma unroll
        for (int p = 0; p < 3; ++p) { const int jj = jf + p; slot[p] = bh * 26 + (p == 0 ? 2 * jj : 2 * jj - 1); ml[p] = (jj <= jl) ? PML[slot[p] * 256 + row] : make_float2(-3e38f, 0.f); mm = fmaxf(mm, ml[p].x); }
        float o0 = 0.f, o1 = 0.f, wsum = 0.f;
#pragma unroll
        for (int p = 0; p < 3; ++p) if (jf + p <= jl) { const float w = ml[p].y * __builtin_amdgcn_exp2f(ml[p].x - mm); const unsigned uu = *(const unsigned*)(PO + ((size_t)slot[p] * 256 + row) * 128 + 2 * lane);
            o0 += w * __uint_as_float(uu << 16); o1 += w * __uint_as_float(uu & 0xffff0000u); wsum += w; }
        const float inv = 1.f / wsum;
        *(unsigned*)(om + ((size_t)b * SEQ + 256 * (15 - u) + row) * 1024 + h * 128 + 2 * lane) = pg8::cvt_pk_bf16(o0 * inv, o1 * inv); }
}
}
namespace gla {
typedef short bf16x8 __attribute__((ext_vector_type(8)));
typedef float f32x16 __attribute__((ext_vector_type(16)));
typedef __attribute__((address_space(3))) const unsigned char* lcp;
constexpr size_t WS_QBP = 32 * MiB, WS_KLT = 48 * MiB, WS_AMAT = 64 * MiB, WS_EBL = 68 * MiB, WS_VT = 252 * MiB;
constexpr int PROW = 528;
constexpr int L_GL = 0, L_TOT = 4096, L_BLAST = 5120, L_QB = 8192, L_KB = L_QB + 64 * PROW, L_VS = L_KB + 64 * PROW;
__device__ __forceinline__ int crow(int r, int hi) { return (r & 3) + 8 * (r >> 2) + 4 * hi; }
__device__ __forceinline__ unsigned pk(float lo, float hi) { return pg8::cvt_pk_bf16(lo, hi); }
__device__ __forceinline__ bf16x8 packs(const f32x16& p, int b) { pg8::u32x4 w; w.x = pk(p[b], p[b + 1]); w.y = pk(p[b + 2], p[b + 3]); w.z = pk(p[b + 4], p[b + 5]); w.w = pk(p[b + 6], p[b + 7]); return __builtin_bit_cast(bf16x8, w); }

__device__ __forceinline__ void prep_item(LAS unsigned char* L, const bf16_t* z, const float* wg, const float* bg, unsigned char* ws, int bh, int c, int wave, int lane_) {
    const int tid = fresh_tid(), lane = tid & 63, b = bh >> 2, h = bh & 3; const size_t rb = (size_t)b * SEQ + 64 * c; const int ic = bh * 64 + c;
    bf16_t* qbp = (bf16_t*)(ws + WS_QBP); bf16_t* klT = (bf16_t*)(ws + WS_KLT); bf16_t* Amat = (bf16_t*)(ws + WS_AMAT); float* ebl = (float*)(ws + WS_EBL); bf16_t* vT = (bf16_t*)(ws + WS_VT);
    LAS float* GL = (LAS float*)(L + L_GL); LAS float* TOT = (LAS float*)(L + L_TOT); LAS float* BLAST = (LAS float*)(L + L_BLAST);
    for (int i = 0; i < 2; ++i) { const int idx = tid + 512 * i, tok = idx >> 4, r = idx & 15; GL[idx] = bf2f(z[(rb + tok) * LDZ + OFF_GLR + r]); }
    __syncthreads();
    const int d = tid & 255, half = tid >> 8;
    float wgc[16];
#pragma unroll
    for (int r = 0; r < 16; ++r) wgc[r] = wg[r * 1024 + h * 256 + d];
    const float bias = bg[h * 256 + d];
    float bl[32]; float run = 0.f;
#pragma unroll
    for (int i = 0; i < 32; ++i) { const int tok = 32 * half + i; float xg = bias;
#pragma unroll
        for (int r = 0; r < 16; ++r) xg += GL[tok * 16 + r] * wgc[r];
        const float ls = fminf(xg, 0.f) - __logf(1.f + __expf(-fabsf(xg)));
        run += ls * (1.f / 16.f); bl[i] = run; }
    if (half == 0) TOT[d] = run;
    __syncthreads();
    if (half == 1) { const float t0 = TOT[d];
#pragma unroll
        for (int i = 0; i < 32; ++i) bl[i] += t0;
        BLAST[d] = bl[31]; }
    __syncthreads();
    const float blast = BLAST[d];
    if (half == 0) ebl[ic * 256 + d] = __expf(blast);
#pragma unroll
    for (int g = 0; g < 4; ++g) { float klv[8];
#pragma unroll
        for (int j = 0; j < 8; ++j) { const int i = 8 * g + j, tok = 32 * half + i; const bf16_t* zr = z + (rb + tok) * LDZ;
            const float qv = bf2f(zr[OFF_GQ + h * 256 + d]), kv = bf2f(zr[OFF_GK + h * 256 + d]);
            *(LAS bf16_t*)(L + L_QB + tok * PROW + d * 2) = f2bf(qv * 0.0625f * __expf(bl[i]));
            *(LAS bf16_t*)(L + L_KB + tok * PROW + d * 2) = f2bf(kv * __expf(-bl[i]));
            klv[j] = kv * __expf(blast - bl[i]); }
        pg8::u32x4 w; w.x = pk(klv[0], klv[1]); w.y = pk(klv[2], klv[3]); w.z = pk(klv[4], klv[5]); w.w = pk(klv[6], klv[7]);
        *(pg8::u32x4*)(klT + ((size_t)ic * 256 + d) * 64 + 32 * half + 8 * g) = w; }
    __syncthreads();
#pragma unroll
    for (int i = 0; i < 4; ++i) { const int q = tid + 512 * i, tok = q >> 5, ch = q & 31, t = ch >> 2, gq = ch & 3;
        typedef unsigned u32x2_t __attribute__((ext_vector_type(2)));
        const u32x2_t lo = *(const LAS u32x2_t*)(L + L_QB + tok * PROW + (32 * t + 4 * gq) * 2), hi = *(const LAS u32x2_t*)(L + L_QB + tok * PROW + (32 * t + 16 + 4 * gq) * 2);
        pg8::u32x4 w; w.x = lo.x; w.y = lo.y; w.z = hi.x; w.w = hi.y;
        *(pg8::u32x4*)(qbp + (rb + tok) * 1024 + h * 256 + 32 * t + 8 * gq) = w; }
    if (wave < 4) { const int ti = wave >> 1, tj = wave & 1, r32 = lane & 31, hh = lane >> 5; f32x16 C;
#pragma unroll
        for (int r = 0; r < 16; ++r) C[r] = 0.f;
        if (tj <= ti) { lcp ka = (lcp)(L + L_KB + (32 * tj + r32) * PROW + hh * 16); lcp qa = (lcp)(L + L_QB + (32 * ti + r32) * PROW + hh * 16);
#pragma unroll
            for (int s = 0; s < 16; ++s) { const bf16x8 kf = *(const __attribute__((address_space(3))) bf16x8*)(ka + s * 32), qf = *(const __attribute__((address_space(3))) bf16x8*)(qa + s * 32);
                C = __builtin_amdgcn_mfma_f32_32x32x16_bf16(kf, qf, C, 0, 0, 0); } }
        const int irow = 32 * ti + r32;
#pragma unroll
        for (int g = 0; g < 4; ++g) { float v[4];
#pragma unroll
            for (int q = 0; q < 4; ++q) { const int j = 32 * tj + crow(4 * g + q, hh); v[q] = (j <= irow) ? C[4 * g + q] : 0.f; }
            uint2 w; w.x = pk(v[0], v[1]); w.y = pk(v[2], v[3]);
            *(uint2*)(Amat + ((size_t)ic * 64 + irow) * 64 + 32 * tj + 8 * g + 4 * hh) = w; } }
    for (int e0 = 0; e0 < 512; e0 += 256) {
#pragma unroll
        for (int i = 0; i < 4; ++i) { const int q = tid + 512 * i, tok = q >> 5, ch = q & 31;
            *(LAS pg8::u32x4*)(L + L_VS + tok * PROW + ch * 16) = *(const pg8::u32x4*)(z + (rb + tok) * LDZ + OFF_GV + h * 512 + e0 + ch * 8); }
        __syncthreads();
#pragma unroll
        for (int g = 0; g < 4; ++g) { unsigned short t8[8];
#pragma unroll
            for (int j = 0; j < 8; ++j) t8[j] = *(const LAS bf16_t*)(L + L_VS + (32 * half + 8 * g + j) * PROW + d * 2);
            pg8::u32x4 w; w.x = t8[0] | ((unsigned)t8[1] << 16); w.y = t8[2] | ((unsigned)t8[3] << 16); w.z = t8[4] | ((unsigned)t8[5] << 16); w.w = t8[6] | ((unsigned)t8[7] << 16);
            *(pg8::u32x4*)(vT + ((size_t)ic * 512 + e0 + d) * 64 + 32 * half + 8 * g) = w; }
        __syncthreads();
    }
}
__device__ __forceinline__ void prep_phase(LAS unsigned char* L, const bf16_t* z, const float* wg, const float* bg, unsigned char* ws, int vcu, int G, int wave, int lane) {
    for (int it = vcu; it < 512; it += G) prep_item(L, z, wg, bg, ws, it >> 6, it & 63, wave, lane);
}
typedef float f32x4a __attribute__((ext_vector_type(4)));
constexpr int SC_NP = 71, SC_BUF = SC_NP * 1024;
__device__ __forceinline__ void scan_phase(LAS unsigned char* L, unsigned char* ws, bf16_t* og, int bh, int sub, int wave, int lane_) {
    const int lane = fresh_tid() & 63;
    const bf16_t* qbp = (const bf16_t*)(ws + WS_QBP); const bf16_t* klT = (const bf16_t*)(ws + WS_KLT); const bf16_t* Amat = (const bf16_t*)(ws + WS_AMAT); const float* ebl = (const float*)(ws + WS_EBL); const bf16_t* vT = (const bf16_t*)(ws + WS_VT);
    const int slice = sub * 8 + wave, b = bh >> 2, h = bh & 3, l15 = lane & 15, g4 = lane >> 4;
    const char* srcQ = (const char*)(qbp + ((size_t)b * SEQ + l15) * 1024 + h * 256 + 8 * g4);
    const char* srcA = (const char*)(Amat + ((size_t)bh * 64 * 64 + l15) * 64 + 8 * g4);
    const char* srcK = (const char*)(klT + ((size_t)bh * 64 * 256 + l15) * 64 + 8 * g4);
    const char* srcE = (const char*)(ebl + (size_t)bh * 64 * 256 + lane * 4);
#define SC_DMA(c, buf) do { _Pragma("unroll") for (int k = 0; k < 9; ++k) { const int p = wave + 8 * k; if (p < SC_NP) { const char* src; \
        if (p < 32) src = srcQ + (size_t)(c) * 131072 + (p >> 3) * 32768 + (p & 7) * 64; \
        else if (p < 34) src = srcA + (size_t)(c) * 8192 + (p - 32) * 2048; \
        else if (p < 38) src = srcA + (size_t)(c) * 8192 + (2 + ((p - 34) >> 1)) * 2048 + ((p - 34) & 1) * 64; \
        else if (p < 70) src = srcK + (size_t)(c) * 32768 + ((p - 38) >> 1) * 2048 + ((p - 38) & 1) * 64; \
        else src = srcE + (size_t)(c) * 1024; \
        __builtin_amdgcn_global_load_lds((const unsigned*)src, (LAS unsigned*)(L + (buf) * SC_BUF + p * 1024), 16, 0, 0); } } } while (0)
    f32x4a S[16];
#pragma unroll
    for (int dt = 0; dt < 16; ++dt) S[dt] = (f32x4a){0.f, 0.f, 0.f, 0.f};
    const bf16_t* vbase = vT + ((size_t)bh * 64 * 512 + 16 * slice + l15) * 64 + 8 * g4;
    bf16x8 vf[2];
    SC_DMA(0, 0);
    vf[0] = *(const bf16x8*)(vbase); vf[1] = *(const bf16x8*)(vbase + 32);
    __syncthreads();
    for (int c = 0; c < 64; ++c) { const int buf = c & 1;
        bf16x8 vn[2];
        if (c + 1 < 64) { SC_DMA(c + 1, buf ^ 1); vn[0] = *(const bf16x8*)(vbase + (size_t)(c + 1) * 512 * 64); vn[1] = *(const bf16x8*)(vbase + (size_t)(c + 1) * 512 * 64 + 32); }
        lcp F = (lcp)(L + buf * SC_BUF + lane * 16);
#define SC_FRAG(p) (*(const __attribute__((address_space(3))) bf16x8*)(F + (p) * 1024))
        f32x4a OT[4];
#pragma unroll
        for (int tt = 0; tt < 4; ++tt) OT[tt] = (f32x4a){0.f, 0.f, 0.f, 0.f};
#define SC_SB() __builtin_amdgcn_sched_barrier(0)
#define SC_RDQ(dst, t) do { _Pragma("unroll") for (int tt = 0; tt < 4; ++tt) dst[tt] = SC_FRAG(tt * 8 + (t)); } while (0)
#define SC_SF(t) ({ pg8::u32x4 w_; w_.x = pk(S[2 * (t)][0], S[2 * (t)][1]); w_.y = pk(S[2 * (t)][2], S[2 * (t)][3]); w_.z = pk(S[2 * (t) + 1][0], S[2 * (t) + 1][1]); w_.w = pk(S[2 * (t) + 1][2], S[2 * (t) + 1][3]); __builtin_bit_cast(bf16x8, w_); })
#define SC_MMQ(src, t) do { const bf16x8 sf_ = SC_SF(t); _Pragma("unroll") for (int tt = 0; tt < 4; ++tt) OT[tt] = __builtin_amdgcn_mfma_f32_16x16x32_bf16(sf_, src[tt], OT[tt], 0, 0, 0); } while (0)
        { bf16x8 qa[4], qb_[4], fa[6];
          SC_RDQ(qa, 0); SC_SB();
#pragma unroll
          for (int t = 0; t < 8; t += 2) { SC_RDQ(qb_, t + 1); SC_SB(); SC_MMQ(qa, t); SC_SB();
              if (t + 2 < 8) { SC_RDQ(qa, t + 2); } else {
#pragma unroll
                  for (int k = 0; k < 6; ++k) fa[k] = SC_FRAG(32 + k); }
              SC_SB(); SC_MMQ(qb_, t + 1); SC_SB(); }
          OT[0] = __builtin_amdgcn_mfma_f32_16x16x32_bf16(vf[0], fa[0], OT[0], 0, 0, 0);
          OT[1] = __builtin_amdgcn_mfma_f32_16x16x32_bf16(vf[0], fa[1], OT[1], 0, 0, 0);
          OT[2] = __builtin_amdgcn_mfma_f32_16x16x32_bf16(vf[0], fa[2], OT[2], 0, 0, 0); OT[2] = __builtin_amdgcn_mfma_f32_16x16x32_bf16(vf[1], fa[3], OT[2], 0, 0, 0);
          OT[3] = __builtin_amdgcn_mfma_f32_16x16x32_bf16(vf[0], fa[4], OT[3], 0, 0, 0); OT[3] = __builtin_amdgcn_mfma_f32_16x16x32_bf16(vf[1], fa[5], OT[3], 0, 0, 0); }
        const __attribute__((address_space(3))) float* E = (const __attribute__((address_space(3))) float*)(L + buf * SC_BUF + 70 * 1024);
#define SC_RDK(kd, ed, q) do { _Pragma("unroll") for (int i_ = 0; i_ < 4; ++i_) { kd[2 * i_] = SC_FRAG(38 + ((q) * 4 + i_) * 2); kd[2 * i_ + 1] = SC_FRAG(39 + ((q) * 4 + i_) * 2); \
            ed[i_] = *(const __attribute__((address_space(3))) f32x4a*)(E + 16 * ((q) * 4 + i_) + 4 * g4); } } while (0)
#define SC_UPD(kd, ed, q) do { _Pragma("unroll") for (int i_ = 0; i_ < 4; ++i_) { const int dt_ = (q) * 4 + i_; S[dt_] = S[dt_] * ed[i_]; \
            S[dt_] = __builtin_amdgcn_mfma_f32_16x16x32_bf16(kd[2 * i_], vf[0], S[dt_], 0, 0, 0); S[dt_] = __builtin_amdgcn_mfma_f32_16x16x32_bf16(kd[2 * i_ + 1], vf[1], S[dt_], 0, 0, 0); } } while (0)
        { bf16x8 ka[8], kb_[8]; f32x4a ea[4], eb_[4];
          SC_RDK(ka, ea, 0); SC_SB();
#pragma unroll
          for (int tt = 0; tt < 4; ++tt) { uint2 w; w.x = pk(OT[tt][0], OT[tt][1]); w.y = pk(OT[tt][2], OT[tt][3]);
              *(uint2*)(og + ((size_t)b * SEQ + 64 * c + 16 * tt + l15) * DM + h * 512 + 16 * slice + 4 * g4) = w; }
          SC_RDK(kb_, eb_, 1); SC_SB(); SC_UPD(ka, ea, 0); SC_SB();
          SC_RDK(ka, ea, 2); SC_SB(); SC_UPD(kb_, eb_, 1); SC_SB();
          SC_RDK(kb_, eb_, 3); SC_SB(); SC_UPD(ka, ea, 2); SC_SB();
          SC_UPD(kb_, eb_, 3); }
#undef SC_SB
#undef SC_RDQ
#undef SC_SF
#undef SC_MMQ
#undef SC_RDK
#undef SC_UPD
#undef SC_FRAG
        vf[0] = vn[0]; vf[1] = vn[1];
        __syncthreads();
    }
#undef SC_DMA
}
}
#ifndef REP5_ROLE
#define REP5_ROLE 0
#endif
#ifndef REPEAT_MASK
#define REPEAT_MASK 0u
#endif
#ifndef DBG_SCAN
#define DBG_SCAN 0
#endif
#if DBG_SCAN
#define DBG_SCAN_OUT ((bf16_t*)(ws + WS_Q))
#else
#define DBG_SCAN_OUT og
#endif
constexpr size_t WS_HLAST = 1 * MiB + 512 * 1024, WS_HFIRST = 4 * MiB;
constexpr size_t WS_WUP = WS_WIN, WS_WDN = 396 * MiB, WS_U = WS_Z;
__global__ void __launch_bounds__(NWAVES * 64, 2) mk_fwd(Args args) {
    extern __shared__ __attribute__((aligned(16))) unsigned char lds[];
    LAS unsigned char* L = (LAS unsigned char*)lds;
    volatile LAS unsigned* MISC = (volatile LAS unsigned*)(L + MISC_OFF);
    const int tid = threadIdx.x, wave = __builtin_amdgcn_readfirstlane(tid >> 6);
#define FL (fresh_tid() & 63)
    const int G = gridDim.x, bx = blockIdx.x; const int vcu = (G % 8 == 0) ? (bx % 8) * (G / 8) + bx / 8 : bx;
    const int gw = vcu * NWAVES + wave, NGW = G * NWAVES;
    unsigned char* ws = args.ws;
    gu32* ctl = (gu32*)(ws + WS_CTL);
    for (int u = tid; u < (LDS_BYTES - LDSCTL_OFF) / 4; u += NWAVES * 64) ((LAS unsigned*)(L + LDSCTL_OFF))[u] = 0u;
    __syncthreads();
    XcdBarrier bar = xcd_barrier_post((unsigned*)(ctl + CW_BAR), MISC + 8);
    const int lo = args.ph_lo, hi = args.ph_hi;
#define IN(k) (lo <= (k) && (k) < hi)
#define SEAM(k) do { if (IN(k) && IN((k) + 1)) xcd_barrier(bar); } while (0)
    const float* x = (const float*)args.in[0]; float* out = args.out;
    float* mod = (float*)(ws + WS_MOD); float2* cs = (float2*)(ws + WS_CS);
    float* statq = (float*)(ws + WS_RSTD); float* statkv = statq + MTOK * 8;
    bf16_t* hbuf = (bf16_t*)(ws + WS_H); bf16_t* z = (bf16_t*)(ws + WS_Z);
    bf16_t* Win_t = (bf16_t*)(ws + WS_WIN); bf16_t* Wq_t = (bf16_t*)(ws + WS_WQ); bf16_t* Wkv_t = (bf16_t*)(ws + WS_WKV);
    bf16_t* Wa_t = (bf16_t*)(ws + WS_WA); bf16_t* Wb_t = (bf16_t*)(ws + WS_WB); bf16_t* Wmix_t = (bf16_t*)(ws + WS_WMIX);
    bf16_t* Wup_t = (bf16_t*)(ws + WS_WUP); bf16_t* Wdn_t = (bf16_t*)(ws + WS_WDN);
    bf16_t* Q = (bf16_t*)(ws + WS_Q); bf16_t* Kf = (bf16_t*)(ws + WS_K); bf16_t* V = (bf16_t*)(ws + WS_V);
    bf16_t* om = (bf16_t*)(ws + WS_OM); bf16_t* og = (bf16_t*)(ws + WS_OG); bf16_t* t1 = (bf16_t*)(ws + WS_T1); bf16_t* merged = (bf16_t*)(ws + WS_MERGED);
    bf16_t* y = (bf16_t*)(ws + WS_Y); bf16_t* h2 = (bf16_t*)(ws + WS_H); bf16_t* act = (bf16_t*)(ws + WS_ACT_N); bf16_t* ubuf = (bf16_t*)(ws + WS_U); bf16_t* f = (bf16_t*)(ws + WS_F);

    for (int rep_ = 0; rep_ < 1 + (int)((REPEAT_MASK >> 0) & 1u); ++rep_) if (IN(0)) { const int lane = FL;
        p0_ada((const float*)args.in[1], (const float*)args.in[3], (float*)(ws + WS_PART), gw, NGW, FL);
        p0_cs((const int*)args.in[2], cs, gw, NGW, FL);
        LAS float* scr = (LAS float*)(L + wave * 16640);
        int cursor = 0;
        tr_matrix((const float*)args.in[6], DM, DIN, LDZ, Win_t, scr, cursor, gw, NGW, lane, ScNat{DIN}, nullptr, 1.f);
        tr_matrix((const float*)args.in[8], 512, 1536, 1536, Wq_t, scr, cursor, gw, NGW, lane, ScQ{}, (const float*)args.in[7], QK_C2);
        tr_matrix((const float*)args.in[10], 256, 2048, 2048, Wkv_t, scr, cursor, gw, NGW, lane, ScNat{2048}, (const float*)args.in[9], 1.f);
        tr_matrix((const float*)args.in[14], 1024, DM, DM, Wa_t, scr, cursor, gw, NGW, lane, ScNat{DM}, nullptr, 1.f);
        tr_matrix((const float*)args.in[15], DM, DM, DM, Wb_t, scr, cursor, gw, NGW, lane, ScNat{DM}, nullptr, 1.f);
        tr_matrix((const float*)args.in[16], DM, DM, DM, Wmix_t, scr, cursor, gw, NGW, lane, ScNat{DM}, nullptr, 1.f);
    }
    SEAM(0);
    for (int rep_ = 0; rep_ < 1 + (int)((REPEAT_MASK >> 1) & 1u); ++rep_) if (IN(1)) {
        const float* g = (const float*)args.in[5]; const int lane = FL;
        p1_modfinal((const float*)args.in[4], (const float*)(ws + WS_PART), mod, gw, NGW, lane);
        xcd_barrier(bar);
        for (int m = gw; m < MTOK; m += NGW) { const int b = m / SEQ; const f32x4* xr = (const f32x4*)(x + (size_t)m * DM) + lane;
            f32x4 v[8]; float s = 0.f;
#pragma unroll
            for (int j = 0; j < 8; ++j) { v[j] = xr[64 * j]; s += (v[j].x * v[j].x + v[j].y * v[j].y) + (v[j].z * v[j].z + v[j].w * v[j].w); }
            const float rstd = rsqrtf(wave_sum(s) * (1.f / DM) + EPSN);
            const f32x4* gp = (const f32x4*)g + lane; const f32x4* shp = (const f32x4*)(mod + b * 12288) + lane; const f32x4* scp = (const f32x4*)(mod + b * 12288 + 2048) + lane;
            unsigned long long* o8 = (unsigned long long*)(hbuf + (size_t)m * DM) + lane;
#pragma unroll
            for (int j = 0; j < 8; ++j) { const f32x4 r = v[j] * rstd * gp[64 * j] * (1.f + scp[64 * j]) + shp[64 * j];
                o8[64 * j] = (unsigned long long)pk2(r.x, r.y) | ((unsigned long long)pk2(r.z, r.w) << 32); } }
    }
    SEAM(1);
    for (int rep_ = 0; rep_ < 1 + (int)((REPEAT_MASK >> 2) & 1u); ++rep_) if (IN(2)) {
        pg8::Gemm g{hbuf, Win_t, MTOK, LDZ, DM, DM}; pg8::StaticOrder S; S.init(MTOK, LDZ, G, bx);
        pg8::EpiZ E{z, statq, statkv};
        pg8::gemm_phase<pg8::EpiZ, pg8::StaticOrder, true, true>(L, g, S, E);
    }
    SEAM(2);
    for (int rep_ = 0; rep_ < 1 + (int)((REPEAT_MASK >> 3) & 1u); ++rep_) if (IN(3)) {
        { pg8::Gemm g{z + OFF_QLAT, Wq_t, MTOK, 1536, 512, LDZ}; pg8::StaticOrder S; S.init(MTOK, 1536, G, bx);
          pg8::EpiQo E{Q, statq, cs}; pg8::gemm_phase<pg8::EpiQo, pg8::StaticOrder, true, true>(L, g, S, E); }
        { pg8::Gemm g{z + OFF_KVLAT, Wkv_t, MTOK, 2048, 256, LDZ}; pg8::StaticOrder S; S.init(MTOK, 2048, G, bx);
          pg8::EpiKVo E{Kf, V, statkv}; pg8::gemm_phase<pg8::EpiKVo, pg8::StaticOrder, true, true>(L, g, S, E); }
        ph_kpe(z, Kf, cs, gw, NGW, FL);
    }
    SEAM(3);
    for (int rep_ = 0; rep_ < 1 + (int)((REPEAT_MASK >> 4) & 1u); ++rep_) if (IN(4)) gla::prep_phase(L, z, (const float*)args.in[11], (const float*)args.in[12], ws, vcu, G, wave, FL);
    SEAM(4);
    for (int rep_ = 0; rep_ < 1 + (int)((REPEAT_MASK >> 5) & 1u); ++rep_) if (IN(5)) {
        const int xg = vcu >> 5, jj = vcu & 31;
        if (G != 256) {   }
        else if (jj < 4) { if (rep_ == 0 || REP5_ROLE != 2) gla::scan_phase(L, ws, DBG_SCAN_OUT, xg, jj, wave, FL); }
        else if (rep_ == 0 || REP5_ROLE != 1) att::phase(L, Q, Kf, V, om, ws, 2 * xg + (jj - 4) / 14, (jj - 4) % 14, wave, FL);
    }
    SEAM(5);
    SEAM(6);
    for (int rep_ = 0; rep_ < 1 + (int)((REPEAT_MASK >> 7) & 1u); ++rep_) if (IN(7)) { att::combine(om, ws, gw, NGW, FL); ph_glanorm(og, z, (const float*)args.in[13], gw, NGW, FL); }
    SEAM(7);
    for (int rep_ = 0; rep_ < 1 + (int)((REPEAT_MASK >> 8) & 1u); ++rep_) if (IN(8)) {
        { pg8::Gemm g{om, Wa_t, MTOK, DM, 1024, 1024}; pg8::StaticOrder S; S.init(MTOK, DM, G, bx);
          pg8::EpiGateo E{t1, z, OFF_GA, nullptr}; pg8::gemm_phase<pg8::EpiGateo, pg8::StaticOrder, true, true>(L, g, S, E); }
        { pg8::Gemm g{og, Wb_t, MTOK, DM, DM, DM}; pg8::StaticOrder S; S.init(MTOK, DM, G, bx);
          pg8::EpiGateo E{merged, z, OFF_GB, t1}; pg8::gemm_phase<pg8::EpiGateo, pg8::StaticOrder, true, true>(L, g, S, E); }
    }
    SEAM(8);
    for (int rep_ = 0; rep_ < 1 + (int)((REPEAT_MASK >> 9) & 1u); ++rep_) if (IN(9)) { pg8::Gemm g{merged, Wmix_t, MTOK, DM, DM, DM}; pg8::StaticOrder S; S.init(MTOK, DM, G, bx);
        pg8::EpiStoreB E{y, DM}; pg8::gemm_phase<pg8::EpiStoreB, pg8::StaticOrder, true, true>(L, g, S, E); }
    SEAM(9);
    for (int rep_ = 0; rep_ < 1 + (int)((REPEAT_MASK >> 10) & 1u); ++rep_) if (IN(10)) ph_resnorm<true>(x, y, (const float*)args.in[17], mod, 4096, out, (const float*)args.in[18], 6144, 8192, h2, gw, NGW, FL);
    SEAM(10);
    for (int rep_ = 0; rep_ < 1 + (int)((REPEAT_MASK >> 11) & 1u); ++rep_) if (IN(11)) { const int lane = FL; LAS float* scr = (LAS float*)(L + wave * 16640); int cursor = 0;
        tr_matrix((const float*)args.in[19], DM, DFF2, DFF2, Wup_t, scr, cursor, gw, NGW, lane, ScUp{}, nullptr, 1.f);
        tr_matrix((const float*)args.in[22], DFF, DM, DM, Wdn_t, scr, cursor, gw, NGW, lane, ScNat{DM}, nullptr, 1.f); }
    SEAM(11);
    for (int rep_ = 0; rep_ < 1 + (int)((REPEAT_MASK >> 12) & 1u); ++rep_) if (IN(12)) { pg8::Gemm g{h2, Wup_t, MTOK, DFF2, DM, DM}; pg8::StaticOrder S; S.init(MTOK, DFF2, G, bx);
        pg8::EpiConv E{act, (const float*)args.in[20], (const float*)args.in[21], (bf16_t*)(ws + WS_HLAST), (float*)(ws + WS_HFIRST), (LAS float*)(L + RING_BYTES)};
        pg8::gemm_phase<pg8::EpiConv, pg8::StaticOrder, true, true>(L, g, S, E); }
    SEAM(12);
    for (int rep_ = 0; rep_ < 1 + (int)((REPEAT_MASK >> 13) & 1u); ++rep_) if (IN(13)) ph_convfix((const bf16_t*)(ws + WS_HLAST), (const float*)(ws + WS_HFIRST), (const float*)args.in[20], act, gw, NGW, FL);
    SEAM(13);
    for (int rep_ = 0; rep_ < 1 + (int)((REPEAT_MASK >> 14) & 1u); ++rep_) if (IN(14)) { pg8::Gemm g{act, Wdn_t, MTOK, DM, DFF, DFF}; pg8::StaticOrder S; S.init(MTOK, DM, G, bx);
        pg8::EpiStoreB E{f, DM}; pg8::gemm_phase<pg8::EpiStoreB, pg8::StaticOrder, true, true>(L, g, S, E); }
    SEAM(14);
    for (int rep_ = 0; rep_ < 1 + (int)((REPEAT_MASK >> 15) & 1u); ++rep_) if (IN(15)) ph_resnorm<false>(out, f, (const float*)args.in[23], mod, 10240, out, nullptr, 0, 0, nullptr, gw, NGW, FL);
#undef IN
#undef SEAM
#undef FL
}

#ifndef OPT_MASK
#define OPT_MASK 0xFFFFu
#endif
static int mk_grid = 0;
static void launch_mk(void* const* d_in, float* out, void* ws, int lo, int hi, hipStream_t stream) {
    if (mk_grid == 0) {
        int dev = 0, cus = 0, per_cu = 0;
        (void)hipGetDevice(&dev); (void)hipDeviceGetAttribute(&cus, hipDeviceAttributeMultiprocessorCount, dev);
        (void)hipFuncSetAttribute((const void*)mk_fwd, hipFuncAttributeMaxDynamicSharedMemorySize, LDS_BYTES);
        (void)hipOccupancyMaxActiveBlocksPerMultiprocessor(&per_cu, (const void*)mk_fwd, NWAVES * 64, LDS_BYTES);
        if (per_cu < 1) { fprintf(stderr, "occupancy query says %d blocks/CU\n", per_cu); per_cu = 1; }
        if (per_cu > 1) per_cu = 1;
        mk_grid = cus * per_cu; (void)hipGetLastError();
    }
    (void)hipMemsetAsync((char*)ws + WS_CTL, 0, 1 * MiB, stream);
    Args a{}; for (int i = 0; i < 24; ++i) a.in[i] = d_in[i]; a.out = out; a.ws = (unsigned char*)ws; a.ph_lo = lo; a.ph_hi = hi;
    void* kargs[] = {&a};
    hipError_t e = hipLaunchCooperativeKernel((const void*)mk_fwd, dim3(mk_grid), dim3(NWAVES * 64), kargs, LDS_BYTES, stream);
    if (e != hipSuccess) fprintf(stderr, "cooperative launch failed: %s (grid %d)\n", hipGetErrorString(e), mk_grid);
}
extern "C" void kernel_launch(void* const* d_in, const int* in_sizes, int n_in, void* d_out, int out_size, void* d_ws, size_t ws_size, hipStream_t stream) {
    const float* x = (const float*)d_in[0]; const float* c = (const float*)d_in[1]; const int* pos = (const int*)d_in[2];
    const float* w_ada = (const float*)d_in[3]; const float* b_ada = (const float*)d_in[4]; const float* g_pre_mix = (const float*)d_in[5];
    const float* w_in = (const float*)d_in[6]; const float* g_q = (const float*)d_in[7]; const float* w_q_up = (const float*)d_in[8];
    const float* g_kv = (const float*)d_in[9]; const float* w_kv_up = (const float*)d_in[10]; const float* w_gate = (const float*)d_in[11];
    const float* b_gate = (const float*)d_in[12]; const float* g_gla = (const float*)d_in[13]; const float* w_a = (const float*)d_in[14];
    const float* w_b = (const float*)d_in[15]; const float* w_mix = (const float*)d_in[16]; const float* g_post_mix = (const float*)d_in[17];
    const float* g_pre_ffn = (const float*)d_in[18]; const float* w_up = (const float*)d_in[19]; const float* conv_w = (const float*)d_in[20];
    const float* conv_b = (const float*)d_in[21]; const float* w_dn = (const float*)d_in[22]; const float* g_post_ffn = (const float*)d_in[23];
    float* out = (float*)d_out; char* ws = (char*)d_ws;
    if (ws_size < 420 * MiB) { fprintf(stderr, "ws too small: %zu\n", ws_size); return; }
    float* mod = (float*)(ws + WS_MOD); float* rstd = (float*)(ws + WS_RSTD); float2* cs = (float2*)(ws + WS_CS);
    bf16_t* h = (bf16_t*)(ws + WS_H); bf16_t* z = (bf16_t*)(ws + WS_Z); bf16_t* Q = (bf16_t*)(ws + WS_Q); bf16_t* Kf = (bf16_t*)(ws + WS_K); bf16_t* V = (bf16_t*)(ws + WS_V);
    bf16_t* om = (bf16_t*)(ws + WS_OM); bf16_t* og = (bf16_t*)(ws + WS_OG); bf16_t* t1 = (bf16_t*)(ws + WS_T1); bf16_t* merged = (bf16_t*)(ws + WS_MERGED);
    bf16_t* y = (bf16_t*)(ws + WS_Y); bf16_t* h2 = (bf16_t*)(ws + WS_H); bf16_t* act = (bf16_t*)(ws + WS_ACT_N); bf16_t* uq = (bf16_t*)(ws + WS_UQ); bf16_t* f = (bf16_t*)(ws + WS_F);
    int pend_lo = -1, pend_hi = -1;
#define FLUSH() do { if (pend_lo >= 0) { launch_mk(d_in, out, d_ws, pend_lo, pend_hi, stream); pend_lo = -1; } } while (0)
#ifndef MK_SPLIT
#define MK_SPLIT 0
#endif
#define PHASE(p, ...) do { if ((OPT_MASK >> (p)) & 1u) { if (pend_lo >= 0 && (pend_hi != (p) || MK_SPLIT)) FLUSH(); if (pend_lo < 0) pend_lo = (p); pend_hi = (p) + 1; } else { FLUSH(); __VA_ARGS__ } } while (0)
    PHASE(0, { n_mod<<<12288 / 256, 256, 0, stream>>>(c, w_ada, b_ada, mod);
        n_cs<<<MTOK * 32 / 256, 256, 0, stream>>>(pos, cs); });
    PHASE(1, { n_normmod<<<MTOK, 256, 0, stream>>>(x, g_pre_mix, mod, 0, 2048, h); });
    PHASE(2, { n_gemm<EpiStore><<<dim3((DIN + 63) / 64, MTOK / 64), 256, 0, stream>>>(h, DM, w_in, DIN, nullptr, 0, MTOK, DIN, DM, EpiStore{z, LDZ, 0}); });
    PHASE(3, { n_latrstd<<<MTOK / 4, 256, 0, stream>>>(z, rstd);
        n_gemm<EpiQ><<<dim3(1536 / 64, MTOK / 64), 256, 0, stream>>>(z + OFF_QLAT, LDZ, w_q_up, 1536, g_q, 0, MTOK, 1536, 512, EpiQ{Q, rstd});
        n_rope_q<<<MTOK, 256, 0, stream>>>(Q, cs);
        n_gemm<EpiKV><<<dim3(2048 / 64, MTOK / 64), 256, 0, stream>>>(z + OFF_KVLAT, LDZ, w_kv_up, 2048, g_kv, 0, MTOK, 2048, 256, EpiKV{Kf, V, rstd});
        n_rope_k<<<MTOK * 32 / 256, 256, 0, stream>>>(z, Kf, cs); });
    PHASE(4, {  });
    PHASE(5, { n_attn<<<NB * 8 * SEQ, 256, 0, stream>>>(Q, Kf, V, om); });
    PHASE(6, { n_gla<<<64, 256, 0, stream>>>(z, w_gate, b_gate, og); });
#if DBG_SCAN
    FLUSH(); n_gla<<<64, 256, 0, stream>>>(z, w_gate, b_gate, og);
    (void)hipMemsetAsync(ws + WS_MOD + 256 * 1024, 0, 64, stream);
    { unsigned* res = (unsigned*)(ws + WS_MOD + 256 * 1024);
      n_countnf<<<1024, 256, 0, stream>>>(ws + 32 * MiB, (size_t)MTOK * 1024, 0, res + 0);
      n_countnf<<<1024, 256, 0, stream>>>(ws + 48 * MiB, (size_t)MTOK * 1024, 0, res + 1);
      n_countnf<<<1024, 256, 0, stream>>>(ws + 64 * MiB, (size_t)512 * 4096, 0, res + 2);
      n_countnf<<<1024, 256, 0, stream>>>(ws + 68 * MiB, (size_t)512 * 256, 1, res + 3);
      n_countnf<<<1024, 256, 0, stream>>>(ws + 252 * MiB, (size_t)MTOK * 2048, 0, res + 4); }
#endif
    PHASE(7, { n_glanorm<<<MTOK, 256, 0, stream>>>(og, z, g_gla); });
    PHASE(8, { n_gemm<EpiGate><<<dim3(DM / 64, MTOK / 64), 256, 0, stream>>>(om, 1024, w_a, DM, nullptr, 0, MTOK, DM, 1024, EpiGate{t1, z, OFF_GA, nullptr});
        n_gemm<EpiGate><<<dim3(DM / 64, MTOK / 64), 256, 0, stream>>>(og, DM, w_b, DM, nullptr, 0, MTOK, DM, DM, EpiGate{merged, z, OFF_GB, t1}); });
    PHASE(9, { n_gemm<EpiStore><<<dim3(DM / 64, MTOK / 64), 256, 0, stream>>>(merged, DM, w_mix, DM, nullptr, 0, MTOK, DM, DM, EpiStore{y, DM, 0}); });
    PHASE(10, { n_resnorm<<<MTOK, 256, 0, stream>>>(x, y, g_post_mix, mod, 4096, out, g_pre_ffn, 6144, 8192, h2); });
    PHASE(11, {  });
    PHASE(12, { for (int q = 0; q < 4; ++q) { const int q0 = q * 2048, r0 = (q0 % SEQ == 0) ? q0 : q0 - 2, r1 = q0 + 2048;
            n_gemm<EpiStore><<<dim3(DFF2 / 64, (r1 - r0 + 63) / 64), 256, 0, stream>>>(h2, DM, w_up, DFF2, nullptr, r0, r1, DFF2, DM, EpiStore{uq, DFF2, r0});
            n_convact<<<dim3(DFF / 256, 2048), 256, 0, stream>>>(uq, r0, q0, conv_w, conv_b, act); } });
    PHASE(13, {  });
    PHASE(14, { n_gemm<EpiStore><<<dim3(DM / 64, MTOK / 64), 256, 0, stream>>>(act, DFF, w_dn, DM, nullptr, 0, MTOK, DM, DFF, EpiStore{f, DM, 0}); });
    PHASE(15, { n_resnorm<<<MTOK, 256, 0, stream>>>(out, f, g_post_ffn, mod, 10240, out, nullptr, 0, 0, nullptr); });
    FLUSH();
#if DBG_SCAN
    n_scale_bits<<<1024, 256, 0, stream>>>(out, (size_t)MTOK * DM, (const unsigned*)(ws + WS_MOD + 256 * 1024), 5);
#endif
}
```

```cpp
#include <hip/hip_runtime.h>
#include <hip/hip_bf16.h>
#include <cstdint>
#include <cstdio>

typedef unsigned short bf16_t;
constexpr int NB = 2, SEQ = 4096, DM = 2048, MTOK = NB * SEQ;
constexpr int DIN = 11088, LDZ = 11264, ZA_LD = 6144, ZB_LD = 5120;
constexpr int OFF_QLAT = 0, OFF_KVLAT = 512, OFF_KROPE = 768, OFF_GQ = 832, OFF_GK = 1856, OFF_GV = 2880, OFF_GLR = 4928  , OFF_GOG = 0, OFF_GA = 2048, OFF_GB = 4096  ;
constexpr int DFF = 5632, DFF2 = 11264;
constexpr float EPSN = 1e-6f;
constexpr float QK_C2 = 0.07216878364870322f * 1.4426950408889634f;
constexpr size_t MiB = 1u << 20;
constexpr size_t WS_CTL = 0, WS_MOD = 1 * MiB, WS_RSTD = 1 * MiB + 512 * 1024, WS_CS = 2 * MiB, WS_PART = 4 * MiB;
constexpr size_t WS_WQ = 8 * MiB, WS_WKV = 10 * MiB, WS_WA = 12 * MiB, WS_WB = 16 * MiB, WS_WMIX = 24 * MiB;
constexpr size_t WS_WIN = 32 * MiB, WS_ZB = 76 * MiB, WS_ZA = 156 * MiB, WS_H = 252 * MiB, WS_Q = 284 * MiB, WS_K = 308 * MiB, WS_V = 332 * MiB, WS_OM = 348 * MiB, WS_OG = 76 * MiB  , WS_MISC = 396 * MiB;
constexpr size_t WS_MERGED = WS_WIN, WS_Y = 284 * MiB, WS_ACT_N = 284 * MiB  , WS_UQ = 196 * MiB  , WS_F = 196 * MiB, WS_T1 = WS_H;

__device__ __forceinline__ int fresh_tid() { int t = threadIdx.x; asm volatile("" : "+v"(t)); return t; }
__device__ __forceinline__ float bf2f(bf16_t v) { return __uint_as_float(((unsigned)v) << 16); }
__device__ __forceinline__ bf16_t f2bf(float f) { unsigned u = __float_as_uint(f); return (bf16_t)((u + 0x7fffu + ((u >> 16) & 1u)) >> 16); }
__device__ __forceinline__ float sigmoidf_(float x) { return 1.f / (1.f + __expf(-x)); }
__device__ __forceinline__ float siluf_(float x) { return x / (1.f + __expf(-x)); }
__device__ __forceinline__ float gelu_tanh(float a) { const float u = 0.7978845608028654f * (a + 0.044715f * a * a * a); return 0.5f * a * (1.f + tanhf(u)); }
__device__ __forceinline__ int rope_pos(int d) { return d < 32 ? (8 * (d >> 2) + (d & 3)) : (8 * ((d - 32) >> 2) + 4 + (d & 3)); }

__device__ __forceinline__ float block_sum256(float v, float* red) {
#pragma unroll
    for (int o = 32; o > 0; o >>= 1) v += __shfl_xor(v, o);
    __syncthreads();
    if ((threadIdx.x & 63) == 0) red[threadIdx.x >> 6] = v;
    __syncthreads();
    return red[0] + red[1] + red[2] + red[3];
}


__global__ void __launch_bounds__(256) n_cmp(const bf16_t* t, const bf16_t* r, size_t n, unsigned* res) {
    unsigned nf = 0; float md = 0.f, mr = 0.f;
    for (size_t i = (size_t)blockIdx.x * 256 + threadIdx.x; i < n; i += (size_t)gridDim.x * 256) { const float a = bf2f(t[i]), b = bf2f(r[i]);
        if (!(fabsf(a) < 1e30f)) { ++nf; } else md = fmaxf(md, fabsf(a - b)); mr = fmaxf(mr, fabsf(b)); }
    if (nf) atomicAdd(res, nf); atomicMax(res + 1, __float_as_uint(md)); atomicMax(res + 2, __float_as_uint(mr));
}
__global__ void n_scale(float* out, size_t n, const unsigned* res) {
    const float md = __uint_as_float(res[1]), mr = __uint_as_float(res[2]); const float rel = md / fmaxf(mr, 1e-20f);
    int code = rel < 1e-2f ? 0 : rel < 3e-2f ? 1 : rel < 0.1f ? 2 : rel < 0.3f ? 3 : rel < 1.f ? 4 : 5; if (res[0]) code = 6 + (res[0] > 1000u) + (res[0] > 1000000u);
    const float f = 1.f + 0.1f * code;
    for (size_t i = (size_t)blockIdx.x * 256 + threadIdx.x; i < n; i += (size_t)gridDim.x * 256) out[i] *= f;
}

__global__ void __launch_bounds__(256) n_countnf(const void* p, size_t n, int isf32, unsigned* res) {
    unsigned nf = 0;
    for (size_t i = (size_t)blockIdx.x * 256 + threadIdx.x; i < n; i += (size_t)gridDim.x * 256) { const float a = isf32 ? ((const float*)p)[i] : bf2f(((const bf16_t*)p)[i]); if (!(fabsf(a) < 1e30f)) ++nf; }
    if (nf) atomicAdd(res, nf);
}
__global__ void n_scale_bits(float* out, size_t n, const unsigned* res, int nres) {
    int code = 0; for (int k = 0; k < nres; ++k) if (res[k]) code |= 1 << k;
    const float f = 1.f + 0.05f * code;
    for (size_t i = (size_t)blockIdx.x * 256 + threadIdx.x; i < n; i += (size_t)gridDim.x * 256) out[i] *= f;
}
__global__ void __launch_bounds__(256) n_mod(const float* c, const float* w_ada, const float* b_ada, float* mod) {
    __shared__ float ca[2][DM];
    for (int i = threadIdx.x; i < 2 * DM; i += 256) ca[i / DM][i % DM] = siluf_(c[i]);
    __syncthreads();
    const int j = blockIdx.x * 256 + threadIdx.x;
    float a0 = b_ada[j], a1 = a0;
    for (int k = 0; k < DM; ++k) { const float w = w_ada[(size_t)k * 12288 + j]; a0 += ca[0][k] * w; a1 += ca[1][k] * w; }
    mod[j] = a0; mod[12288 + j] = a1;
}
__global__ void __launch_bounds__(256) n_cs(const int* pos, float2* cs) {
    const int idx = blockIdx.x * 256 + threadIdx.x; const int m = idx >> 5, i = idx & 31;
    const float inv = 1.0f / powf(10000.0f, (float)(2 * i) / 64.0f);
    const float ang = (float)pos[m] * inv;
    float s, c; sincosf(ang, &s, &c); cs[idx] = make_float2(c, s);
}
__global__ void __launch_bounds__(256) n_normmod(const float* x, const float* g, const float* mod, int off_shift, int off_scale, bf16_t* h) {
    __shared__ float red[4];
    const int m = blockIdx.x, b = m / SEQ; const float* xr = x + (size_t)m * DM;
    float v[8], s = 0.f;
#pragma unroll
    for (int i = 0; i < 8; ++i) { v[i] = xr[threadIdx.x + i * 256]; s += v[i] * v[i]; }
    const float rstd = rsqrtf(block_sum256(s, red) / DM + EPSN);
#pragma unroll
    for (int i = 0; i < 8; ++i) { const int k = threadIdx.x + i * 256;
        h[(size_t)m * DM + k] = f2bf(v[i] * rstd * g[k] * (1.f + mod[b * 12288 + off_scale + k]) + mod[b * 12288 + off_shift + k]); }
}
template <class Epi>
__global__ void __launch_bounds__(256) n_gemm(const bf16_t* A, int lda, const float* W, int ldw, const float* ks, int M0, int M1, int N, int K, Epi epi) {
    __shared__ float As[16][68]; __shared__ float Ws[16][68];
    const int tx = threadIdx.x & 15, ty = threadIdx.x >> 4;
    const int m0 = M0 + blockIdx.y * 64, n0 = blockIdx.x * 64;
    float acc[4][4];
#pragma unroll
    for (int i = 0; i < 4; ++i)
#pragma unroll
        for (int j = 0; j < 4; ++j) acc[i][j] = 0.f;
    for (int k0 = 0; k0 < K; k0 += 16) {
#pragma unroll
        for (int i = 0; i < 4; ++i) { const int e = threadIdx.x + i * 256, r = e >> 4, kk = e & 15, m = m0 + r;
            float a = (m < M1) ? bf2f(A[(size_t)m * lda + k0 + kk]) : 0.f; if (ks) a *= ks[k0 + kk]; As[kk][r] = a; }
#pragma unroll
        for (int i = 0; i < 4; ++i) { const int e = threadIdx.x + i * 256, kk = e >> 6, cc = e & 63, n = n0 + cc;
            Ws[kk][cc] = (n < N) ? W[(size_t)(k0 + kk) * ldw + n] : 0.f; }
        __syncthreads();
#pragma unroll
        for (int kk = 0; kk < 16; ++kk) {
            float a[4], b[4];
#pragma unroll
            for (int i = 0; i < 4; ++i) { a[i] = As[kk][ty * 4 + i]; b[i] = Ws[kk][tx * 4 + i]; }
#pragma unroll
            for (int i = 0; i < 4; ++i)
#pragma unroll
                for (int j = 0; j < 4; ++j) acc[i][j] += a[i] * b[j];
        }
        __syncthreads();
    }
#pragma unroll
    for (int i = 0; i < 4; ++i)
#pragma unroll
        for (int j = 0; j < 4; ++j) { const int m = m0 + ty * 4 + i, n = n0 + tx * 4 + j; if (m < M1 && n < N) epi(m, n, acc[i][j]); }
}
struct EpiStore { bf16_t* C; int ldc; int row_off; __device__ void operator()(int m, int n, float v) const { C[(size_t)(m - row_off) * ldc + n] = f2bf(v); } };
struct EpiQ { bf16_t* Q; const float* rstd; __device__ void operator()(int m, int n, float v) const { Q[(size_t)m * 1536 + n] = f2bf(v * rstd[m]); } };
struct EpiKV { bf16_t* Kf; bf16_t* V; const float* rstd; __device__ void operator()(int m, int n, float v) const {
    const int h = n >> 8, w = n & 255; v *= rstd[MTOK + m];
    if (w < 128) Kf[(size_t)m * 1536 + h * 192 + w] = f2bf(v); else V[(size_t)m * 1024 + h * 128 + (w - 128)] = f2bf(v); } };
struct EpiGate { bf16_t* C; const bf16_t* z; int goff; const bf16_t* add; __device__ void operator()(int m, int n, float v) const {
    float r = v * sigmoidf_(bf2f(z[(size_t)m * ZA_LD + goff + n])); if (add) r += bf2f(add[(size_t)m * DM + n]); C[(size_t)m * DM + n] = f2bf(r); } };

__global__ void __launch_bounds__(256) n_latrstd(const bf16_t* z, float* rstd) {
    const int m = blockIdx.x * 4 + (threadIdx.x >> 6), lane = threadIdx.x & 63; const bf16_t* zr = z + (size_t)m * ZB_LD;
    float s = 0.f, s2 = 0.f;
    for (int i = lane; i < 512; i += 64) { const float v = bf2f(zr[i]); s += v * v; }
    for (int i = lane; i < 256; i += 64) { const float v = bf2f(zr[512 + i]); s2 += v * v; }
#pragma unroll
    for (int o = 32; o > 0; o >>= 1) { s += __shfl_xor(s, o); s2 += __shfl_xor(s2, o); }
    if (lane == 0) { rstd[m] = rsqrtf(s / 512.f + EPSN); rstd[MTOK + m] = rsqrtf(s2 / 256.f + EPSN); }
}
__global__ void __launch_bounds__(256) n_rope_q(bf16_t* Q, const float2* cs) {
    const int m = blockIdx.x, h = threadIdx.x >> 5, i = threadIdx.x & 31; bf16_t* q = Q + (size_t)m * 1536 + h * 192;
    const float x1 = bf2f(q[128 + i]), x2 = bf2f(q[160 + i]); const float2 c = cs[m * 32 + i];
    float nope[4];
#pragma unroll
    for (int j = 0; j < 4; ++j) nope[j] = bf2f(q[i * 4 + j]);
    __syncthreads();
    q[128 + rope_pos(i)] = f2bf((x1 * c.x - x2 * c.y) * QK_C2); q[128 + rope_pos(32 + i)] = f2bf((x2 * c.x + x1 * c.y) * QK_C2);
#pragma unroll
    for (int j = 0; j < 4; ++j) q[i * 4 + j] = f2bf(nope[j] * QK_C2);
}
__global__ void __launch_bounds__(256) n_rope_k(const bf16_t* z, bf16_t* Kf, const float2* cs) {
    const int idx = blockIdx.x * 256 + threadIdx.x, m = idx >> 5, i = idx & 31; const bf16_t* zr = z + (size_t)m * ZB_LD + OFF_KROPE;
    const float x1 = bf2f(zr[i]), x2 = bf2f(zr[32 + i]); const float2 c = cs[m * 32 + i];
    const bf16_t o1 = f2bf(x1 * c.x - x2 * c.y), o2 = f2bf(x2 * c.x + x1 * c.y);
#pragma unroll
    for (int h = 0; h < 8; ++h) { Kf[(size_t)m * 1536 + h * 192 + 128 + rope_pos(i)] = o1; Kf[(size_t)m * 1536 + h * 192 + 128 + rope_pos(32 + i)] = o2; }
}
__global__ void __launch_bounds__(256) n_attn(const bf16_t* Q, const bf16_t* Kf, const bf16_t* V, bf16_t* O) {
    __shared__ float qs[192]; __shared__ float p[SEQ]; __shared__ float red[4]; __shared__ float op[2][128];
    const int t = blockIdx.x % SEQ, h = (blockIdx.x / SEQ) % 8, b = blockIdx.x / (SEQ * 8); const size_t m = (size_t)b * SEQ + t;
    if (threadIdx.x < 192) qs[threadIdx.x] = bf2f(Q[m * 1536 + h * 192 + threadIdx.x]);
    __syncthreads();
    float mx = -1e30f;
    for (int j = threadIdx.x; j <= t; j += 256) { const bf16_t* kr = Kf + ((size_t)b * SEQ + j) * 1536 + h * 192; float s = 0.f;
        for (int d = 0; d < 192; ++d) s += qs[d] * bf2f(kr[d]);
        p[j] = s; mx = fmaxf(mx, s); }
#pragma unroll
    for (int o = 32; o > 0; o >>= 1) mx = fmaxf(mx, __shfl_xor(mx, o));
    if ((threadIdx.x & 63) == 0) red[threadIdx.x >> 6] = mx;
    __syncthreads();
    mx = fmaxf(fmaxf(red[0], red[1]), fmaxf(red[2], red[3]));
    float l = 0.f;
    for (int j = threadIdx.x; j <= t; j += 256) { const float e = exp2f(p[j] - mx); p[j] = e; l += e; }
    l = block_sum256(l, red);
    const int e = threadIdx.x & 127, g = threadIdx.x >> 7; float acc = 0.f;
    for (int j = g; j <= t; j += 2) acc += p[j] * bf2f(V[((size_t)b * SEQ + j) * 1024 + h * 128 + e]);
    op[g][e] = acc; __syncthreads();
    if (threadIdx.x < 128) O[m * 1024 + h * 128 + threadIdx.x] = f2bf((op[0][threadIdx.x] + op[1][threadIdx.x]) / l);
}
__global__ void __launch_bounds__(256) n_gla(const bf16_t* z, const float* wg, const float* bg, bf16_t* og) {
    constexpr int TS = 8;
    __shared__ float al[TS][256], kk[TS][256], qq[TS][256], vv[TS][64], opart[TS][4][64];
    const int bh = blockIdx.x >> 3, eb = blockIdx.x & 7, b = bh >> 2, h = bh & 3; const int e = threadIdx.x & 63, dg = threadIdx.x >> 6;
    float S[64];
#pragma unroll
    for (int i = 0; i < 64; ++i) S[i] = 0.f;
    for (int t0 = 0; t0 < SEQ; t0 += TS) {
        __syncthreads();
        for (int idx = threadIdx.x; idx < TS * 256; idx += 256) { const int tt = idx >> 8, d = idx & 255; const bf16_t* zr = z + ((size_t)b * SEQ + t0 + tt) * ZB_LD;
            float xg = bg[h * 256 + d];
#pragma unroll
            for (int r = 0; r < 16; ++r) xg += bf2f(zr[OFF_GLR + r]) * wg[r * 1024 + h * 256 + d];
            const float ls = fminf(xg, 0.f) - log1pf(__expf(-fabsf(xg)));
            al[tt][d] = __expf(ls * (1.f / 16.f));
            kk[tt][d] = bf2f(zr[OFF_GK + h * 256 + d]); qq[tt][d] = bf2f(zr[OFF_GQ + h * 256 + d]) * 0.0625f; }
        for (int idx = threadIdx.x; idx < TS * 64; idx += 256) { const int tt = idx >> 6, ee = idx & 63;
            vv[tt][ee] = bf2f(z[((size_t)b * SEQ + t0 + tt) * ZB_LD + OFF_GV + h * 512 + eb * 64 + ee]); }
        __syncthreads();
        for (int tt = 0; tt < TS; ++tt) { const float ve = vv[tt][e]; float o = 0.f;
#pragma unroll
            for (int i = 0; i < 64; ++i) { S[i] = al[tt][dg * 64 + i] * S[i] + kk[tt][dg * 64 + i] * ve; o += qq[tt][dg * 64 + i] * S[i]; }
            opart[tt][dg][e] = o; }
        __syncthreads();
        for (int idx = threadIdx.x; idx < TS * 64; idx += 256) { const int tt = idx >> 6, ee = idx & 63;
            og[((size_t)b * SEQ + t0 + tt) * DM + h * 512 + eb * 64 + ee] = f2bf(opart[tt][0][ee] + opart[tt][1][ee] + opart[tt][2][ee] + opart[tt][3][ee]); }
    }
}
__global__ void __launch_bounds__(256) n_glanorm(bf16_t* og, const bf16_t* z, const float* g) {
    const int m = blockIdx.x, h = threadIdx.x >> 6, lane = threadIdx.x & 63; bf16_t* o = og + (size_t)m * DM + h * 512;
    float v[8], s = 0.f;
#pragma unroll
    for (int i = 0; i < 8; ++i) { v[i] = bf2f(o[lane + i * 64]); s += v[i] * v[i]; }
#pragma unroll
    for (int of = 32; of > 0; of >>= 1) s += __shfl_xor(s, of);
    const float rstd = rsqrtf(s / 512.f + EPSN);
#pragma unroll
    for (int i = 0; i < 8; ++i) { const int ee = lane + i * 64; const float nv = v[i] * rstd * g[ee];
        o[ee] = f2bf(nv * siluf_(bf2f(z[(size_t)m * ZA_LD + OFF_GOG + h * 512 + ee]))); }
}
__global__ void __launch_bounds__(256) n_resnorm(const float* xin, const bf16_t* y, const float* g1, const float* mod, int off_gate, float* xout, const float* g2, int off_shift, int off_scale, bf16_t* h2) {
    __shared__ float red[4];
    const int m = blockIdx.x, b = m / SEQ;
    float yv[8], s = 0.f;
#pragma unroll
    for (int i = 0; i < 8; ++i) { yv[i] = bf2f(y[(size_t)m * DM + threadIdx.x + i * 256]); s += yv[i] * yv[i]; }
    const float rstd = rsqrtf(block_sum256(s, red) / DM + EPSN);
    float xv[8], s2 = 0.f;
#pragma unroll
    for (int i = 0; i < 8; ++i) { const int k = threadIdx.x + i * 256; xv[i] = xin[(size_t)m * DM + k] + mod[b * 12288 + off_gate + k] * (yv[i] * rstd * g1[k]); s2 += xv[i] * xv[i];
        xout[(size_t)m * DM + k] = xv[i]; }
    if (h2) { const float r2 = rsqrtf(block_sum256(s2, red) / DM + EPSN);
#pragma unroll
        for (int i = 0; i < 8; ++i) { const int k = threadIdx.x + i * 256;
            h2[(size_t)m * DM + k] = f2bf(xv[i] * r2 * g2[k] * (1.f + mod[b * 12288 + off_scale + k]) + mod[b * 12288 + off_shift + k]); } }
}
__global__ void __launch_bounds__(256) n_convact(const bf16_t* ubuf, int r0, int q0, const float* cw, const float* cb, bf16_t* act) {
    const int m = q0 + blockIdx.y, t = m % SEQ, j = blockIdx.x * 256 + threadIdx.x;
    float ca = cb[j], cv = cb[DFF + j];
#pragma unroll
    for (int i = 0; i < 3; ++i) { const int tt = t - 2 + i; if (tt >= 0) { const bf16_t* ur = ubuf + (size_t)(m - 2 + i - r0) * DFF2;
        ca += cw[i * DFF2 + j] * bf2f(ur[j]); cv += cw[i * DFF2 + DFF + j] * bf2f(ur[DFF + j]); } }
    act[(size_t)m * DFF + j] = f2bf(gelu_tanh(ca) * cv);
}

namespace pg8 {
#define PG8_LAS __attribute__((address_space(3)))
typedef short bf16x8 __attribute__((ext_vector_type(8)));
typedef float f32x4 __attribute__((ext_vector_type(4)));
typedef unsigned u32x4 __attribute__((ext_vector_type(4)));
constexpr int BM = 256, BK = 64, HALF = 128, HTB = HALF * BK * 2  , STAGE_BYTES = 8 * HTB, NXCD = 8, WGM = 8;

__host__ __device__ __forceinline__ int lds_byte(int r, int c) { const int st = (r >> 4) * 2 + (c >> 5), rr = r & 15, cc = c & 31, ob = rr * 64 + cc * 2; return st * 1024 + (ob ^ (((ob >> 9) & 1) << 5)); }
__host__ __device__ __forceinline__ void stage_rc(int b, int& R, int& C) { const int st = b / 1024, sb = b % 1024, swz = sb ^ (((sb >> 9) & 1) << 5); R = (st >> 1) * 16 + swz / 64; C = (st & 1) * 32 + (swz % 64) / 2; }
__host__ __device__ __forceinline__ int perm32(int rho) { const int n = rho >> 4, i = rho & 15; return 8 * (i >> 2) + 4 * n + (i & 3); }

struct Unit { int pm, pn; };
struct Gemm { const bf16_t* A; const bf16_t* Bt; int M, N, K, lda; };
__host__ __device__ __forceinline__ int arow(int R, bool perm) { return perm ? (128 * (R >> 6) + 8 * (R & 15) + ((R >> 4) & 3)) : R; }
typedef float f32x2c_t __attribute__((ext_vector_type(2))); typedef __bf16 bf16x2c_t __attribute__((ext_vector_type(2)));
__device__ __forceinline__ unsigned cvt_pk_bf16(float lo, float hi) { f32x2c_t v = {lo, hi}; bf16x2c_t b = __builtin_convertvector(v, bf16x2c_t); return __builtin_bit_cast(unsigned, b); }
typedef float f32x2 __attribute__((ext_vector_type(2)));
struct StaticOrder {
    int nM, nN, nwg, G, c;
    __host__ __device__ __forceinline__ void init(int M, int N, int G_, int c_) { nM = M / BM; nN = N / BM; nwg = nM * nN; G = G_; c = c_; }
    __host__ __device__ __forceinline__ bool next(int i, Unit& u) const {
        const long L = (long)i * G + c; if (L >= nwg) return false;
        int wgid = (int)L; { const int q = nwg / NXCD, r = nwg % NXCD, xcd = wgid % NXCD, off = wgid / NXCD; wgid = (xcd < r ? xcd * (q + 1) : r * (q + 1) + (xcd - r) * q) + off; }
        const int nig = WGM * nN, gid = wgid / nig, fm = gid * WGM, gsz = (nM - fm) < WGM ? (nM - fm) : WGM;
        u.pm = fm + ((wgid % nig) % gsz); u.pn = (wgid % nig) / gsz; return true;
    }
    __device__ __forceinline__ void a_ready(const Unit&) const {}
    __device__ __forceinline__ void done(const Unit&) const {}
};
template <class Epi, class Sched, bool ALIGN_EPI = false, bool SP2 = false>
__device__ __forceinline__ void gemm_phase(PG8_LAS unsigned char* lds, const Gemm g, const Sched& S, const Epi& E) {
    const int tid = fresh_tid(), wid = __builtin_amdgcn_readfirstlane(tid >> 6), lane = tid & 63, wr = wid >> 2, wc = wid & 3, fr = lane & 15, fq = lane >> 4;
    const int K = g.K, nt = K / BK;
    unsigned voffA[2], voffB[2];
#pragma unroll
    for (int i = 0; i < 2; ++i) { int R, C; stage_rc(tid * 16 + i * 8192, R, C); const int Rb = Epi::PERM ? ((R & ~31) + perm32(R & 31)) : R;
        voffA[i] = (unsigned)(arow(R, Epi::APERM) * g.lda + C) * 2u; voffB[i] = (unsigned)(Rb * K + C) * 2u; }
    const size_t kstep = (size_t)(BK * 2);
    const size_t hstepA = Epi::APERM ? (size_t)4 * g.lda * 2 : (size_t)HALF * g.lda * 2, hstepB = (size_t)HALF * K * 2;
    const size_t tstepA = (size_t)BM * g.lda * 2, tstepB = 2 * hstepB;
    const unsigned ldsw = (unsigned)wid * 1024u;
    const int aoff = lds_byte(wr * 64 + fr, fq * 8), boff = lds_byte(wc * 32 + fr, fq * 8);
#define PG8_SA(b, h) (((b) * 2 + (h)) * HTB)
#define PG8_SB(b, h) ((4 + (b) * 2 + (h)) * HTB)
#define PG8_STAGE(bufoff, gbase, voff) do { _Pragma("unroll") for (int _i = 0; _i < 2; ++_i) \
        __builtin_amdgcn_global_load_lds((const unsigned*)((const char*)(gbase) + (voff)[_i]), (PG8_LAS unsigned*)(lds + (bufoff) + ldsw + _i * 8192), 16, 0, 0); } while (0)
#define PG8_LDA(dst, b, h) do { _Pragma("unroll") for (int m = 0; m < 4; ++m) _Pragma("unroll") for (int k = 0; k < 2; ++k) dst[m][k] = *(const PG8_LAS bf16x8*)(lds + PG8_SA(b, h) + aoff + m * 2048 + k * 1024); } while (0)
#define PG8_LDB(dst, b, h) do { _Pragma("unroll") for (int n = 0; n < 2; ++n) _Pragma("unroll") for (int k = 0; k < 2; ++k) dst[n][k] = *(const PG8_LAS bf16x8*)(lds + PG8_SB(b, h) + boff + n * 2048 + k * 1024); } while (0)
#define PG8_MMA(ai, bj, At, Bt) do { __builtin_amdgcn_s_setprio(1); _Pragma("unroll") for (int m = 0; m < 4; ++m) _Pragma("unroll") for (int n = 0; n < 2; ++n) _Pragma("unroll") for (int k = 0; k < 2; ++k) \
        acc[ai][bj][m][n] = __builtin_amdgcn_mfma_f32_16x16x32_bf16(Bt[n][k], At[m][k], acc[ai][bj][m][n], 0, 0, 0); __builtin_amdgcn_s_setprio(0); } while (0)
#define PG8_WAIT_V(n) asm volatile("s_waitcnt vmcnt(" #n ")" ::: "memory")
#define PG8_WAIT_L(n) asm volatile("s_waitcnt lgkmcnt(" #n ")" ::: "memory")
#define PG8_BAR __builtin_amdgcn_s_barrier()
#define PG8_SCHED __builtin_amdgcn_sched_barrier(0)
    Unit cur, nxt; int ui = 0;
    if (!S.next(0, cur)) return;
    f32x4 acc[2][2][4][2];
#pragma unroll
    for (int a = 0; a < 2; ++a)
#pragma unroll
        for (int b = 0; b < 2; ++b)
#pragma unroll
            for (int m = 0; m < 4; ++m)
#pragma unroll
                for (int n = 0; n < 2; ++n) acc[a][b][m][n] = (f32x4){0.f, 0.f, 0.f, 0.f};
    bf16x8 At[4][2], B0[2][2], B1[2][2];
    const char* cA = (const char*)g.A + (size_t)cur.pm * tstepA; const char* cB = (const char*)g.Bt + (size_t)cur.pn * tstepB;
    S.a_ready(cur);
    if constexpr (SP2) {
        PG8_STAGE(PG8_SB(0, 0), cB, voffB); PG8_STAGE(PG8_SB(0, 1), cB + hstepB, voffB); PG8_STAGE(PG8_SA(0, 0), cA, voffA); PG8_STAGE(PG8_SA(0, 1), cA + hstepA, voffA);
        if (wr == 1) PG8_BAR;
        PG8_WAIT_V(2); PG8_BAR;
        PG8_STAGE(PG8_SB(1, 0), cB + kstep, voffB); PG8_STAGE(PG8_SA(1, 0), cA + kstep, voffA); PG8_STAGE(PG8_SB(1, 1), cB + hstepB + kstep, voffB);
        PG8_WAIT_V(6); PG8_BAR;
    } else {
        PG8_STAGE(PG8_SB(0, 0), cB, voffB); PG8_STAGE(PG8_SA(0, 0), cA, voffA); PG8_STAGE(PG8_SB(0, 1), cB + hstepB, voffB); PG8_STAGE(PG8_SA(0, 1), cA + hstepA, voffA);
        if (wr == 1) PG8_BAR;
        PG8_WAIT_V(4); PG8_BAR;
        PG8_STAGE(PG8_SB(1, 0), cB + kstep, voffB); PG8_STAGE(PG8_SA(1, 0), cA + kstep, voffA); PG8_STAGE(PG8_SB(1, 1), cB + hstepB + kstep, voffB);
        PG8_WAIT_V(6); PG8_BAR;
    }
    for (;;) {
        const bool has_next = S.next(ui + 1, nxt);
        const char* nA = has_next ? (const char*)g.A + (size_t)nxt.pm * tstepA : cA; const char* nB = has_next ? (const char*)g.Bt + (size_t)nxt.pn * tstepB : cB;
        for (int t = 0; t < nt; t += 2) {
            const bool last = (t == nt - 2);
            const char* a1 = cA + (size_t)(t + 1) * kstep;
            const char* a2 = last ? nA : cA + (size_t)(t + 2) * kstep; const char* b2 = last ? nB : cB + (size_t)(t + 2) * kstep;
            const char* a3 = a2 + kstep; const char* b3 = b2 + kstep;
            if (last && has_next) S.a_ready(nxt);
            if constexpr (SP2) {
            PG8_LDB(B0, 0, 0); PG8_LDB(B1, 0, 1); PG8_SCHED; PG8_LDA(At, 0, 0); PG8_STAGE(PG8_SA(1, 1), a1 + hstepA, voffA);
            PG8_WAIT_V(8); PG8_WAIT_L(0); PG8_BAR; PG8_MMA(0, 0, At, B0); PG8_MMA(0, 1, At, B1); PG8_BAR; PG8_SCHED;
            PG8_LDA(At, 0, 1); PG8_STAGE(PG8_SB(0, 0), b2, voffB); PG8_STAGE(PG8_SB(0, 1), b2 + hstepB, voffB); PG8_STAGE(PG8_SA(0, 0), a2, voffA);
            PG8_WAIT_V(8); PG8_WAIT_L(0); PG8_BAR; PG8_MMA(1, 0, At, B0); PG8_MMA(1, 1, At, B1); PG8_BAR; PG8_SCHED;
            PG8_LDB(B0, 1, 0); PG8_LDB(B1, 1, 1); PG8_SCHED; PG8_LDA(At, 1, 0); PG8_STAGE(PG8_SA(0, 1), a2 + hstepA, voffA);
            PG8_WAIT_V(8); PG8_WAIT_L(0); PG8_BAR; PG8_MMA(0, 0, At, B0); PG8_MMA(0, 1, At, B1); PG8_BAR; PG8_SCHED;
            PG8_LDA(At, 1, 1); PG8_STAGE(PG8_SB(1, 0), b3, voffB); PG8_STAGE(PG8_SB(1, 1), b3 + hstepB, voffB); PG8_STAGE(PG8_SA(1, 0), a3, voffA);
            PG8_WAIT_V(8); PG8_WAIT_L(0); PG8_BAR; PG8_MMA(1, 0, At, B0); PG8_MMA(1, 1, At, B1); PG8_BAR; PG8_SCHED;
            } else {
            PG8_LDB(B0, 0, 0); PG8_SCHED; PG8_LDA(At, 0, 0); PG8_STAGE(PG8_SA(1, 1), a1 + hstepA, voffA);
            PG8_WAIT_L(8); PG8_BAR; PG8_WAIT_L(0); PG8_MMA(0, 0, At, B0); PG8_BAR; PG8_SCHED;
            PG8_LDB(B1, 0, 1); PG8_STAGE(PG8_SB(0, 0), b2, voffB);
            PG8_BAR; PG8_WAIT_L(0); PG8_MMA(0, 1, At, B1); PG8_BAR;
            PG8_LDA(At, 0, 1); PG8_STAGE(PG8_SA(0, 0), a2, voffA);
            PG8_BAR; PG8_WAIT_L(0); PG8_MMA(1, 0, At, B0); PG8_BAR; PG8_SCHED;
            PG8_STAGE(PG8_SB(0, 1), b2 + hstepB, voffB);
            PG8_WAIT_V(6); PG8_BAR; PG8_MMA(1, 1, At, B1); PG8_BAR;
            PG8_LDB(B0, 1, 0); PG8_SCHED; PG8_LDA(At, 1, 0); PG8_STAGE(PG8_SA(0, 1), a2 + hstepA, voffA);
            PG8_WAIT_L(8); PG8_BAR; PG8_WAIT_L(0); PG8_MMA(0, 0, At, B0); PG8_BAR; PG8_SCHED;
            PG8_LDB(B1, 1, 1); PG8_STAGE(PG8_SB(1, 0), b3, voffB);
            PG8_BAR; PG8_WAIT_L(0); PG8_MMA(0, 1, At, B1); PG8_BAR;
            PG8_LDA(At, 1, 1); PG8_STAGE(PG8_SA(1, 0), a3, voffA);
            PG8_BAR; PG8_WAIT_L(0); PG8_MMA(1, 0, At, B0); PG8_BAR; PG8_SCHED;
            PG8_STAGE(PG8_SB(1, 1), b3 + hstepB, voffB);
            PG8_WAIT_V(6); PG8_BAR; PG8_MMA(1, 1, At, B1); PG8_BAR;
            }
        }
        if constexpr (ALIGN_EPI) { if (wr == 0) PG8_BAR; }
        if constexpr (!Epi::AFTER_DRAIN) { E(acc, cur, wr, wc, fr, fq); S.done(cur); }
        if (!has_next) break;
#pragma unroll
        for (int a = 0; a < 2; ++a)
#pragma unroll
            for (int b = 0; b < 2; ++b)
#pragma unroll
                for (int m = 0; m < 4; ++m)
#pragma unroll
                    for (int n = 0; n < 2; ++n) acc[a][b][m][n] = (f32x4){0.f, 0.f, 0.f, 0.f};
        cur = nxt; cA = nA; cB = nB; ++ui;
        if constexpr (ALIGN_EPI) { if (wr == 1) PG8_BAR; }
    }
    PG8_WAIT_V(0);
    if constexpr (!ALIGN_EPI) { if (wr == 0) PG8_BAR; }
    PG8_BAR;
    if constexpr (Epi::AFTER_DRAIN) { E.fused(acc, cur, wr, wc, fr, fq, lds, wid, lane); S.done(cur); }
#undef PG8_SA
#undef PG8_SB
#undef PG8_STAGE
#undef PG8_LDA
#undef PG8_LDB
#undef PG8_MMA
#undef PG8_WAIT_V
#undef PG8_WAIT_L
#undef PG8_BAR
#undef PG8_SCHED
}
}

#define GAS __attribute__((address_space(1)))
#define LAS __attribute__((address_space(3)))
typedef unsigned v4u __attribute__((ext_vector_type(4)));
typedef float f32x4 __attribute__((ext_vector_type(4)));
typedef GAS unsigned gu32;
#define RLX_AGENT __ATOMIC_RELAXED, __HIP_MEMORY_SCOPE_AGENT
#define LDS_WAIT() asm volatile("s_waitcnt lgkmcnt(0)" ::: "memory")
#define VM_WAIT() asm volatile("s_waitcnt vmcnt(0)" ::: "memory")
constexpr int NWAVES = 8;
constexpr int RING_BYTES = 131072, LDS_BYTES = 163840, LDSCTL_OFF = LDS_BYTES - 1024, MISC_OFF = LDSCTL_OFF + 320;
constexpr int CW_BAR = 4096, CW_PROG = 20480  , CW_ADA = 16384  ;
__device__ __forceinline__ unsigned pk2(float lo, float hi) { return (unsigned)f2bf(lo) | ((unsigned)f2bf(hi) << 16); }

#define XB_TMO      128
#define XB_XCNT(j)  (256  + 64 * (j))
#define XB_XSUB(j)  (1280 + 64 * (j))
#define XB_XGEN(j)  (2304 + 64 * (j))
#define XB_TOP      3328
#define XB_TOPGEN   3392
#define XCD_BAR_WORDS 3456
#define XB_SPIN_CAP (1u << 18)

__device__ __forceinline__ unsigned xb_ld(unsigned* p)              { return __hip_atomic_load(p, __ATOMIC_RELAXED, __HIP_MEMORY_SCOPE_AGENT); }
__device__ __forceinline__ unsigned xb_add(unsigned* p, unsigned v) { return __hip_atomic_fetch_add(p, v, __ATOMIC_RELAXED, __HIP_MEMORY_SCOPE_AGENT); }
__device__ __forceinline__ unsigned xb_xcc_id() { return (unsigned)__builtin_amdgcn_s_getreg((3 << 11) | 20) & 0xFu; }
#define XB_SPIN(cond, bar) do { unsigned _sp = 0; while (cond) { __builtin_amdgcn_s_sleep(1); \
    if ((++_sp & 255u) == 0u) { if (xb_ld(&(bar)[XB_TMO])) break; if (_sp > XB_SPIN_CAP) { atomicAdd(&(bar)[XB_TMO], 1u); break; } } } } while (0)

struct XcdBarrier {
    unsigned* bar; unsigned x;
    volatile LAS unsigned* st;
};

__device__ __forceinline__ XcdBarrier xcd_barrier_post(unsigned* bar, volatile LAS unsigned* st) {
    XcdBarrier b; b.bar = bar; b.x = xb_xcc_id(); b.st = st;
    if (threadIdx.x == 0) (void)xb_add(&bar[XB_XCNT(b.x)], 1u);
    return b;
}
__device__ __forceinline__ void xcd_barrier_complete(unsigned* bar, unsigned x, unsigned& nloc, unsigned& nx) {
    const unsigned G = gridDim.x * gridDim.y * gridDim.z;
    unsigned sum, cnt, mine, sp = 0u;
    for (;;) {
        sum = 0u; cnt = 0u; mine = 0u;
#pragma unroll
        for (unsigned j = 0; j < 16; ++j) { const unsigned c = xb_ld(&bar[XB_XCNT(j)]); sum += c; cnt += (c > 0u) ? 1u : 0u; mine = (j == x) ? c : mine; }
        if (sum == G) break;
        __builtin_amdgcn_s_sleep(1);
        if ((++sp & 255u) == 0u) { if (xb_ld(&bar[XB_TMO])) break; if (sp > XB_SPIN_CAP) { atomicAdd(&bar[XB_TMO], 1u); break; } }
    }
    nloc = mine > 0u ? mine : 1u; nx = cnt > 0u ? cnt : 1u;
}

__device__ __forceinline__ void xcd_barrier(const XcdBarrier& b) {
    asm volatile("s_waitcnt vmcnt(0)" ::: "memory");
    __syncthreads();
    if (threadIdx.x == 0) {
        unsigned* bar = b.bar;
        __builtin_amdgcn_s_waitcnt(0);
        unsigned nloc = b.st[0], nx = b.st[1];
        if (nloc == 0u) { xcd_barrier_complete(bar, b.x, nloc, nx); b.st[0] = nloc; b.st[1] = nx; }
        const unsigned old = xb_add(&bar[XB_XSUB(b.x)], 1u);
        const unsigned gen = old / nloc;
        if (old + 1u == (gen + 1u) * nloc) {
            __builtin_amdgcn_fence(__ATOMIC_RELEASE, "agent");
            asm volatile("s_waitcnt vmcnt(0)" ::: "memory");
            const unsigned og = xb_add(&bar[XB_TOP], 1u);
            const unsigned tg = og / nx;
            if (og + 1u == (tg + 1u) * nx) xb_add(&bar[XB_TOPGEN], 1u);
            else XB_SPIN(xb_ld(&bar[XB_TOPGEN]) == tg, bar);
            __builtin_amdgcn_fence(__ATOMIC_ACQUIRE, "agent");
            xb_add(&bar[XB_XGEN(b.x)], 1u);
            asm volatile("s_waitcnt vmcnt(0)" ::: "memory");
        } else {
            XB_SPIN(xb_ld(&bar[XB_XGEN(b.x)]) == gen, bar);
            __builtin_amdgcn_fence(__ATOMIC_ACQUIRE, "agent");
            asm volatile("s_waitcnt vmcnt(0)" ::: "memory");
        }
    }
    __syncthreads();
}


__device__ __forceinline__ float wave_sum(float v) {
#pragma unroll
    for (int o = 1; o < 64; o <<= 1) v += __shfl_xor(v, o);
    return v;
}

struct Args { const void* in[24]; float* out; unsigned char* ws; int ph_lo, ph_hi; };

__device__ __forceinline__ void p0_ada(const float* c, const float* w_ada, const float* b_ada, float* mod, LAS float* lds, int cg, int wave, int lane) {
    if (cg >= 192) return;
    LAS float* ct = lds; LAS float* red = lds + 2 * DM;
    const int tid = wave * 64 + lane;
#pragma unroll
    for (int i = 0; i < 8; ++i) ct[tid + 512 * i] = siluf_(c[tid + 512 * i]);
    LDS_WAIT(); __syncthreads();
    const int r = lane >> 4, c4 = (lane & 15) * 4, k0 = wave * 256 + r;
    f32x4 a0[2] = {{0.f, 0.f, 0.f, 0.f}, {0.f, 0.f, 0.f, 0.f}}, a1[2] = {{0.f, 0.f, 0.f, 0.f}, {0.f, 0.f, 0.f, 0.f}};
    const float* wp = w_ada + (size_t)k0 * 12288 + cg * 64 + c4;
#pragma unroll 16
    for (int i = 0; i < 64; ++i) { const f32x4 w = __builtin_nontemporal_load((const f32x4*)(wp + (size_t)(4 * i) * 12288)); const float s0 = ct[k0 + 4 * i], s1 = ct[DM + k0 + 4 * i];
        a0[i & 1] += s0 * w; a1[i & 1] += s1 * w; }
    f32x4 s0 = a0[0] + a0[1], s1 = a1[0] + a1[1];
#pragma unroll
    for (int e = 0; e < 4; ++e) { s0[e] += __shfl_xor(s0[e], 16); s0[e] += __shfl_xor(s0[e], 32); s1[e] += __shfl_xor(s1[e], 16); s1[e] += __shfl_xor(s1[e], 32); }
    if (lane < 16) { *(LAS f32x4*)(red + (wave * 2 + 0) * 64 + c4) = s0; *(LAS f32x4*)(red + (wave * 2 + 1) * 64 + c4) = s1; }
    LDS_WAIT(); __syncthreads();
    if (tid < 128) { const int b = tid >> 6, l = tid & 63; float s = b_ada[cg * 64 + l];
#pragma unroll
        for (int w = 0; w < 8; ++w) s += red[(w * 2 + b) * 64 + l];
        mod[b * 12288 + cg * 64 + l] = s; }
    __syncthreads();
}
__device__ __forceinline__ void p0_cs(const int* pos, float2* cs, int gw, int NGW, int lane) {
    for (int it = gw; it < MTOK * 32 / 64; it += NGW) { const int idx = it * 64 + lane, m = idx >> 5, i = idx & 31;
        const float inv = 1.0f / powf(10000.0f, (float)(2 * i) / 64.0f); const float ang = (float)pos[m] * inv;
        float s, c; sincosf(ang, &s, &c); cs[idx] = make_float2(c, s); }
}
template <class SrcCol>
__device__ __forceinline__ void tr_load(f32x4 (&v)[16], const float* W, int Nsrc, int kb, int nb, int lane, SrcCol sc) {
    const int k0 = 64 * kb + 8 * (lane >> 3), n0 = 64 * nb + 4 * (lane & 7); const int nc0 = sc(n0), nc1 = sc(n0 + 32);
#pragma unroll
    for (int i = 0; i < 8; ++i) { v[2 * i] = (f32x4){0.f, 0.f, 0.f, 0.f}; v[2 * i + 1] = (f32x4){0.f, 0.f, 0.f, 0.f};
        if (nc0 >= 0) v[2 * i] = __builtin_nontemporal_load((const f32x4*)(W + (size_t)(k0 + i) * Nsrc + nc0));
        if (nc1 >= 0) v[2 * i + 1] = __builtin_nontemporal_load((const f32x4*)(W + (size_t)(k0 + i) * Nsrc + nc1)); }
}
__device__ __forceinline__ void tr_proc(const f32x4 (&v)[16], int K, bf16_t* WT, LAS float* scr, int kb, int nb, int lane, const float* kgain, float scale) {
    const int k0 = 64 * kb + 8 * (lane >> 3), n0 = 64 * nb + 4 * (lane & 7);
    float s[8];
#pragma unroll
    for (int i = 0; i < 8; ++i) s[i] = scale;
    if (kgain) { const f32x4 ga = *(const f32x4*)(kgain + k0), gb = *(const f32x4*)(kgain + k0 + 4);
#pragma unroll
        for (int i = 0; i < 4; ++i) { s[i] *= ga[i]; s[4 + i] *= gb[i]; } }
#pragma unroll
    for (int c = 0; c < 8; ++c) { const int h = c >> 2, e = c & 3;
        v4u o; o.x = pg8::cvt_pk_bf16(v[h][e] * s[0], v[2 + h][e] * s[1]); o.y = pg8::cvt_pk_bf16(v[4 + h][e] * s[2], v[6 + h][e] * s[3]); o.z = pg8::cvt_pk_bf16(v[8 + h][e] * s[4], v[10 + h][e] * s[5]); o.w = pg8::cvt_pk_bf16(v[12 + h][e] * s[6], v[14 + h][e] * s[7]);
        *(v4u*)(WT + (size_t)(n0 + 32 * h + e) * K + k0) = o; }
}
struct ScNat { int N; __device__ int operator()(int n) const { return n < N ? n : -1; } };
struct ScIn { __device__ int operator()(int n) const { return n < 6144 ? 4944 + n : (n < DIN ? n - 6144 : -1); } };
struct ScQ { __device__ int operator()(int n) const { const int h = n / 192, w = n % 192; if (w < 128) return n; const int p = w - 128, g = p >> 3, e = p & 7; return h * 192 + 128 + (e < 4 ? 4 * g + e : 32 + 4 * g + (e - 4)); } };
struct ScUp { __device__ int operator()(int n) const { const int pn = n >> 8, r = n & 255; return r < 128 ? 128 * pn + r : DFF + 128 * pn + (r - 128); } };
template <class SrcCol>
__device__ __forceinline__ void tr_matrix(const float* W, int K, int Nsrc, int Ndst, bf16_t* WT, LAS float* scr, int& cursor, int gw, int NGW, int lane, SrcCol sc, const float* kgain, float scale, int item_lo = 0, int item_hi = 0x7fffffff) {
    const int nblk = Ndst / 64, nall = (K / 64) * nblk, nitems = item_hi < nall ? item_hi : nall;
    int it = gw - cursor % NGW; if (it < 0) it += NGW; it += item_lo;
    f32x4 cur[16], nxt[16];
    if (it < nitems) tr_load(cur, W, Nsrc, it / nblk, it % nblk, lane, sc);
    for (; it < nitems; it += NGW) { const int itn = it + NGW;
        if (itn < nitems) tr_load(nxt, W, Nsrc, itn / nblk, itn % nblk, lane, sc);
        tr_proc(cur, K, WT, scr, it / nblk, it % nblk, lane, kgain, scale);
#pragma unroll
        for (int i = 0; i < 16; ++i) cur[i] = nxt[i]; }
    cursor += nitems - item_lo;
}

namespace pg8 {
struct EpiZ {
    static constexpr bool PERM = true, AFTER_DRAIN = false, APERM = false;
    bf16_t* ZA; bf16_t* ZB; float* statq; float* statkv;
    __device__ __forceinline__ void operator()(const f32x4 (&acc)[2][2][4][2], const Unit& u, int wr, int wc, int fr, int fq) const {
        const int row0 = u.pm * BM + wr * 64 + fr, col0 = u.pn * BM + wc * 32 + 8 * fq;
#pragma unroll
        for (int ai = 0; ai < 2; ++ai)
#pragma unroll
            for (int m = 0; m < 4; ++m) { const int row = row0 + ai * HALF + m * 16; bf16_t* rowp = (u.pn < 24) ? ZA + (size_t)row * ZA_LD + col0 : ZB + (size_t)row * ZB_LD + (col0 - 6144); float ss = 0.f;
#pragma unroll
                for (int bj = 0; bj < 2; ++bj) { const f32x4 v0 = acc[ai][bj][m][0], v1 = acc[ai][bj][m][1];
                    u32x4 w; w.x = cvt_pk_bf16(v0[0], v0[1]); w.y = cvt_pk_bf16(v0[2], v0[3]); w.z = cvt_pk_bf16(v1[0], v1[1]); w.w = cvt_pk_bf16(v1[2], v1[3]);
                    *(u32x4*)(rowp + bj * HALF) = w;
                    ss += (v0[0] * v0[0] + v0[1] * v0[1]) + (v0[2] * v0[2] + v0[3] * v0[3]) + (v1[0] * v1[0] + v1[1] * v1[1]) + (v1[2] * v1[2] + v1[3] * v1[3]); }
                if (u.pn >= 24 && u.pn < 27) { ss += __shfl_xor(ss, 16); ss += __shfl_xor(ss, 32);
                    if (fq == 0) { if (u.pn < 26) statq[row * 8 + (u.pn - 24) * 4 + wc] = ss; else statkv[row * 4 + wc] = ss; } } }
    }
};
}


namespace pg8 {
__device__ __forceinline__ u32x4 pack8(const f32x4 v0, const f32x4 v1) { u32x4 w; w.x = cvt_pk_bf16(v0[0], v0[1]); w.y = cvt_pk_bf16(v0[2], v0[3]); w.z = cvt_pk_bf16(v1[0], v1[1]); w.w = cvt_pk_bf16(v1[2], v1[3]); return w; }
__device__ __forceinline__ void unpack8(const u32x4 w, f32x4& a, f32x4& b) {
    a[0] = __uint_as_float(w.x << 16); a[1] = __uint_as_float(w.x & 0xffff0000u); a[2] = __uint_as_float(w.y << 16); a[3] = __uint_as_float(w.y & 0xffff0000u);
    b[0] = __uint_as_float(w.z << 16); b[1] = __uint_as_float(w.z & 0xffff0000u); b[2] = __uint_as_float(w.w << 16); b[3] = __uint_as_float(w.w & 0xffff0000u); }
struct EpiStoreB {
    static constexpr bool PERM = true, AFTER_DRAIN = false, APERM = false;
    bf16_t* C; int ldc;
    __device__ __forceinline__ void operator()(const f32x4 (&acc)[2][2][4][2], const Unit& u, int wr, int wc, int fr, int fq) const {
        const int row0 = u.pm * BM + wr * 64 + fr, col0 = u.pn * BM + wc * 32 + 8 * fq;
#pragma unroll
        for (int ai = 0; ai < 2; ++ai)
#pragma unroll
            for (int m = 0; m < 4; ++m) { bf16_t* rowp = C + (size_t)(row0 + ai * HALF + m * 16) * ldc + col0;
#pragma unroll
                for (int bj = 0; bj < 2; ++bj) *(u32x4*)(rowp + bj * HALF) = pack8(acc[ai][bj][m][0], acc[ai][bj][m][1]); }
    }
};
struct EpiQo {
    static constexpr bool PERM = true, AFTER_DRAIN = false, APERM = false;
    bf16_t* Q; const float* statq; const float2* cs;
    __device__ __forceinline__ void operator()(const f32x4 (&acc)[2][2][4][2], const Unit& u, int wr, int wc, int fr, int fq) const {
        const int row0 = u.pm * BM + wr * 64 + fr, col0 = u.pn * BM + wc * 32 + 8 * fq;
        const int hw0 = (u.pn * BM + wc * 32) % 192, hw1 = (u.pn * BM + HALF + wc * 32) % 192;
        const bool rp0 = hw0 >= 128, rp1 = hw1 >= 128;
#pragma unroll
        for (int aq = 0; aq < 4; ++aq) { const int ai = aq >> 1, mb = (aq & 1) * 2;
            f32x4 s0[4], s1[4]; f32x4 c0[4][2], c1[4][2];
#pragma unroll
            for (int m = mb; m < mb + 2; ++m) { const int row = row0 + ai * HALF + m * 16;
                s0[m] = *(const f32x4*)(statq + row * 8); s1[m] = *(const f32x4*)(statq + row * 8 + 4);
                if (rp0) { const f32x4* c = (const f32x4*)(cs + row * 32 + 4 * (((hw0 - 128) >> 3) + fq)); c0[m][0] = c[0]; c0[m][1] = c[1]; }
                if (rp1) { const f32x4* c = (const f32x4*)(cs + row * 32 + 4 * (((hw1 - 128) >> 3) + fq)); c1[m][0] = c[0]; c1[m][1] = c[1]; } }
#pragma unroll
            for (int m = mb; m < mb + 2; ++m) { const int row = row0 + ai * HALF + m * 16; bf16_t* rowp = Q + (size_t)row * 1536 + col0;
                const float rstd = rsqrtf(((s0[m][0] + s0[m][1]) + (s0[m][2] + s0[m][3]) + (s1[m][0] + s1[m][1]) + (s1[m][2] + s1[m][3])) * (1.f / 512.f) + EPSN);
#pragma unroll
                for (int bj = 0; bj < 2; ++bj) { f32x4 v0 = acc[ai][bj][m][0] * rstd, v1 = acc[ai][bj][m][1] * rstd;
                    if (bj == 0 ? rp0 : rp1) { const f32x4 ca = bj == 0 ? c0[m][0] : c1[m][0], cb = bj == 0 ? c0[m][1] : c1[m][1];
                        const float cx[4] = {ca[0], ca[2], cb[0], cb[2]}, sx[4] = {ca[1], ca[3], cb[1], cb[3]};
#pragma unroll
                        for (int j = 0; j < 4; ++j) { const float x1 = v0[j], x2 = v1[j]; v0[j] = x1 * cx[j] - x2 * sx[j]; v1[j] = x2 * cx[j] + x1 * sx[j]; } }
                    *(u32x4*)(rowp + bj * HALF) = pack8(v0, v1); } } }
    }
};
struct EpiKVo {
    static constexpr bool PERM = true, AFTER_DRAIN = false, APERM = false;
    bf16_t* Kf; bf16_t* V; const float* statkv;
    __device__ __forceinline__ void operator()(const f32x4 (&acc)[2][2][4][2], const Unit& u, int wr, int wc, int fr, int fq) const {
        const int row0 = u.pm * BM + wr * 64 + fr, c0 = wc * 32 + 8 * fq;
        f32x4 st[2][4];
#pragma unroll
        for (int ai = 0; ai < 2; ++ai)
#pragma unroll
            for (int m = 0; m < 4; ++m) st[ai][m] = *(const f32x4*)(statkv + (row0 + ai * HALF + m * 16) * 4);
#pragma unroll
        for (int ai = 0; ai < 2; ++ai)
#pragma unroll
            for (int m = 0; m < 4; ++m) { const int row = row0 + ai * HALF + m * 16; const f32x4 s0 = st[ai][m];
                const float rstd = rsqrtf(((s0[0] + s0[1]) + (s0[2] + s0[3])) * (1.f / 256.f) + EPSN);
                *(u32x4*)(Kf + (size_t)row * 1536 + u.pn * 192 + c0) = pack8(acc[ai][0][m][0] * rstd, acc[ai][0][m][1] * rstd);
                *(u32x4*)(V + (size_t)row * 1024 + u.pn * 128 + c0) = pack8(acc[ai][1][m][0] * rstd, acc[ai][1][m][1] * rstd); }
    }
};
struct EpiGateo {
    static constexpr bool PERM = true, AFTER_DRAIN = false, APERM = false;
    bf16_t* C; const bf16_t* z; int goff; const bf16_t* add;
    __device__ __forceinline__ void operator()(const f32x4 (&acc)[2][2][4][2], const Unit& u, int wr, int wc, int fr, int fq) const {
        const int row0 = u.pm * BM + wr * 64 + fr, col0 = u.pn * BM + wc * 32 + 8 * fq;
#pragma unroll
        for (int aq = 0; aq < 4; ++aq) { const int ai = aq >> 1, mb = (aq & 1) * 2;
            u32x4 gr[4][2], ar[4][2];
#pragma unroll
            for (int m = mb; m < mb + 2; ++m)
#pragma unroll
                for (int bj = 0; bj < 2; ++bj) { const int row = row0 + ai * HALF + m * 16, col = col0 + bj * HALF;
                    gr[m][bj] = *(const u32x4*)(z + (size_t)row * ZA_LD + goff + col); if (add) ar[m][bj] = *(const u32x4*)(add + (size_t)row * DM + col); }
#pragma unroll
            for (int m = mb; m < mb + 2; ++m) { const int row = row0 + ai * HALF + m * 16;
#pragma unroll
                for (int bj = 0; bj < 2; ++bj) { const int col = col0 + bj * HALF;
                    f32x4 g0, g1; unpack8(gr[m][bj], g0, g1);
                    f32x4 v0 = acc[ai][bj][m][0], v1 = acc[ai][bj][m][1];
#pragma unroll
                    for (int j = 0; j < 4; ++j) { v0[j] *= sigmoidf_(g0[j]); v1[j] *= sigmoidf_(g1[j]); }
                    if (add) { f32x4 a0, a1; unpack8(ar[m][bj], a0, a1); v0 += a0; v1 += a1; }
                    *(u32x4*)(C + (size_t)row * DM + col) = pack8(v0, v1); } } }
    }
};
}

__device__ __forceinline__ void ph_kpe(const bf16_t* z, bf16_t* Kf, const float2* cs, int gw, int NGW, int lane) {
    for (int m2 = gw; m2 < MTOK / 2; m2 += NGW) { const int m = m2 * 2 + (lane >> 5), i = lane & 31; const bf16_t* zr = z + (size_t)m * ZB_LD + OFF_KROPE;
        const float x1 = bf2f(zr[i]), x2 = bf2f(zr[32 + i]); const float2 c = cs[m * 32 + i];
        const bf16_t o1 = f2bf(x1 * c.x - x2 * c.y), o2 = f2bf(x2 * c.x + x1 * c.y); const int p1 = rope_pos(i), p2 = rope_pos(32 + i);
#pragma unroll
        for (int h = 0; h < 8; ++h) { Kf[(size_t)m * 1536 + h * 192 + 128 + p1] = o1; Kf[(size_t)m * 1536 + h * 192 + 128 + p2] = o2; } }
}
__device__ __forceinline__ void ph_glanorm(bf16_t* og, const bf16_t* z, const float* g, int gw, int NGW, int lane) {
    const f32x4 ga = *((const f32x4*)g + lane * 2), gb = *((const f32x4*)g + lane * 2 + 1);
    pg8::u32x4 o0, z0, o1, z1, o2, z2, o3, z3;
#define GN_LOAD(O, Z, it_) do { if ((it_) < MTOK * 4) { const int m_ = (it_) >> 2, h_ = (it_) & 3; O = *(const pg8::u32x4*)(og + (size_t)m_ * DM + h_ * 512 + lane * 8); Z = *(const pg8::u32x4*)(z + (size_t)m_ * ZA_LD + OFF_GOG + h_ * 512 + lane * 8); } } while (0)
    int it = gw; GN_LOAD(o0, z0, it); GN_LOAD(o1, z1, it + NGW); GN_LOAD(o2, z2, it + 2 * NGW);
    for (; it < MTOK * 4; it += NGW) { GN_LOAD(o3, z3, it + 3 * NGW);
        const int m = it >> 2, h = it & 3; bf16_t* o = og + (size_t)m * DM + h * 512 + lane * 8;
        f32x4 a, b, za, zb; pg8::unpack8(o0, a, b); pg8::unpack8(z0, za, zb);
        float s = (a[0] * a[0] + a[1] * a[1]) + (a[2] * a[2] + a[3] * a[3]) + (b[0] * b[0] + b[1] * b[1]) + (b[2] * b[2] + b[3] * b[3]);
        const float rstd = rsqrtf(wave_sum(s) * (1.f / 512.f) + EPSN);
#pragma unroll
        for (int j = 0; j < 4; ++j) { a[j] = a[j] * rstd * ga[j] * siluf_(za[j]); b[j] = b[j] * rstd * gb[j] * siluf_(zb[j]); }
        *(pg8::u32x4*)o = pg8::pack8(a, b);
        o0 = o1; z0 = z1; o1 = o2; z1 = z2; o2 = o3; z2 = z3; }
#undef GN_LOAD
}
template <bool H2, bool XB>
__device__ __forceinline__ void ph_resnorm(const float* xin, const bf16_t* y, const float* g1, const float* mod, int off_gate, float* xout, const float* g2, int off_shift, int off_scale, bf16_t* h2, int gw, int NGW, int lane, float oscale) {
    constexpr bool XIN16 = XB && !H2;
    pg8::u32x4 yr[4], yn[4]; f32x4 xr[8], xn[8];
#define RN_LOAD(Y, X, m_) do { _Pragma("unroll") for (int j = 0; j < 4; ++j) { const int e = 8 * (lane + 64 * j); Y[j] = *(const pg8::u32x4*)(y + (size_t)(m_) * DM + e); \
        if (XIN16) X[j] = __builtin_bit_cast(f32x4, *(const pg8::u32x4*)((const bf16_t*)xin + (size_t)(m_) * DM + e)); \
        else { X[2 * j] = __builtin_nontemporal_load((const f32x4*)(xin + (size_t)(m_) * DM + e)); X[2 * j + 1] = __builtin_nontemporal_load((const f32x4*)(xin + (size_t)(m_) * DM + e + 4)); } } } while (0)
    int m = gw; if (m < MTOK) RN_LOAD(yr, xr, m);
    for (; m < MTOK; m += NGW) { const int mn = m + NGW; if (mn < MTOK) RN_LOAD(yn, xn, mn);
        const float* mb = mod + (m / SEQ) * 12288;
        f32x4 ya[4], yb[4]; float s = 0.f;
#pragma unroll
        for (int j = 0; j < 4; ++j) { pg8::unpack8(yr[j], ya[j], yb[j]);
            s += (ya[j][0] * ya[j][0] + ya[j][1] * ya[j][1]) + (ya[j][2] * ya[j][2] + ya[j][3] * ya[j][3]) + (yb[j][0] * yb[j][0] + yb[j][1] * yb[j][1]) + (yb[j][2] * yb[j][2] + yb[j][3] * yb[j][3]); }
        const float rstd = rsqrtf(wave_sum(s) * (1.f / DM) + EPSN); float s2 = 0.f;
#pragma unroll
        for (int j = 0; j < 4; ++j) { const int e = 8 * (lane + 64 * j);
            f32x4 xa, xb; if (XIN16) pg8::unpack8(__builtin_bit_cast(pg8::u32x4, xr[j]), xa, xb); else { xa = xr[2 * j]; xb = xr[2 * j + 1]; }
            ya[j] = xa + *(const f32x4*)(mb + off_gate + e) * (ya[j] * rstd * *(const f32x4*)(g1 + e));
            yb[j] = xb + *(const f32x4*)(mb + off_gate + e + 4) * (yb[j] * rstd * *(const f32x4*)(g1 + e + 4));
            if (XB && H2) *(pg8::u32x4*)((bf16_t*)xout + (size_t)m * DM + e) = pg8::pack8(ya[j], yb[j]); else { *(f32x4*)(xout + (size_t)m * DM + e) = ya[j] * oscale; *(f32x4*)(xout + (size_t)m * DM + e + 4) = yb[j] * oscale; }
            s2 += (ya[j][0] * ya[j][0] + ya[j][1] * ya[j][1]) + (ya[j][2] * ya[j][2] + ya[j][3] * ya[j][3]) + (yb[j][0] * yb[j][0] + yb[j][1] * yb[j][1]) + (yb[j][2] * yb[j][2] + yb[j][3] * yb[j][3]); }
        if (H2) { const float r2 = rsqrtf(wave_sum(s2) * (1.f / DM) + EPSN);
#pragma unroll
            for (int j = 0; j < 4; ++j) { const int e = 8 * (lane + 64 * j);
                const f32x4 ha = ya[j] * r2 * *(const f32x4*)(g2 + e) * (1.f + *(const f32x4*)(mb + off_scale + e)) + *(const f32x4*)(mb + off_shift + e);
                const f32x4 hb = yb[j] * r2 * *(const f32x4*)(g2 + e + 4) * (1.f + *(const f32x4*)(mb + off_scale + e + 4)) + *(const f32x4*)(mb + off_shift + e + 4);
                *(pg8::u32x4*)(h2 + (size_t)m * DM + e) = pg8::pack8(ha, hb); } }
#pragma unroll
        for (int j = 0; j < 4; ++j) { yr[j] = yn[j]; xr[2 * j] = xn[2 * j]; xr[2 * j + 1] = xn[2 * j + 1]; } }
#undef RN_LOAD
}
__device__ __forceinline__ void ph_convact(const bf16_t* u, const float* cw, const float* cb, bf16_t* act, int gw, int NGW, int lane) {
    for (int it = gw; it < 256 * 11; it += NGW) { const int r0 = (it / 11) * 32, j = (it % 11) * 512 + 8 * lane;
        f32x4 wa[3][2], wv[3][2];
#pragma unroll
        for (int k = 0; k < 3; ++k) { wa[k][0] = *(const f32x4*)(cw + k * DFF2 + j); wa[k][1] = *(const f32x4*)(cw + k * DFF2 + j + 4); wv[k][0] = *(const f32x4*)(cw + k * DFF2 + DFF + j); wv[k][1] = *(const f32x4*)(cw + k * DFF2 + DFF + j + 4); }
        const f32x4 ba0 = *(const f32x4*)(cb + j), ba1 = *(const f32x4*)(cb + j + 4), bv0 = *(const f32x4*)(cb + DFF + j), bv1 = *(const f32x4*)(cb + DFF + j + 4);
        f32x4 a2[2], a1[2], v2[2], v1[2];
        if (r0 % SEQ == 0) { a2[0] = a2[1] = a1[0] = a1[1] = v2[0] = v2[1] = v1[0] = v1[1] = (f32x4){0.f, 0.f, 0.f, 0.f}; }
        else { pg8::unpack8(*(const pg8::u32x4*)(u + (size_t)(r0 - 2) * DFF2 + j), a2[0], a2[1]); pg8::unpack8(*(const pg8::u32x4*)(u + (size_t)(r0 - 1) * DFF2 + j), a1[0], a1[1]);
               pg8::unpack8(*(const pg8::u32x4*)(u + (size_t)(r0 - 2) * DFF2 + DFF + j), v2[0], v2[1]); pg8::unpack8(*(const pg8::u32x4*)(u + (size_t)(r0 - 1) * DFF2 + DFF + j), v1[0], v1[1]); }
#pragma unroll 4
        for (int r = 0; r < 32; ++r) { const size_t m = (size_t)r0 + r; f32x4 a0[2], v0[2];
            pg8::unpack8(*(const pg8::u32x4*)(u + m * DFF2 + j), a0[0], a0[1]); pg8::unpack8(*(const pg8::u32x4*)(u + m * DFF2 + DFF + j), v0[0], v0[1]);
            f32x4 ca0 = ba0 + wa[0][0] * a2[0] + wa[1][0] * a1[0] + wa[2][0] * a0[0], ca1 = ba1 + wa[0][1] * a2[1] + wa[1][1] * a1[1] + wa[2][1] * a0[1];
            const f32x4 cv0 = bv0 + wv[0][0] * v2[0] + wv[1][0] * v1[0] + wv[2][0] * v0[0], cv1 = bv1 + wv[0][1] * v2[1] + wv[1][1] * v1[1] + wv[2][1] * v0[1];
#pragma unroll
            for (int q = 0; q < 4; ++q) { ca0[q] = gelu_tanh(ca0[q]) * cv0[q]; ca1[q] = gelu_tanh(ca1[q]) * cv1[q]; }
            *(pg8::u32x4*)(act + m * DFF + j) = pg8::pack8(ca0, ca1);
            a2[0] = a1[0]; a2[1] = a1[1]; a1[0] = a0[0]; a1[1] = a0[1]; v2[0] = v1[0]; v2[1] = v1[1]; v1[0] = v0[0]; v1[1] = v0[1]; } }
}
namespace pg8 {
struct EpiU {
    static constexpr bool PERM = true, AFTER_DRAIN = false, APERM = false;
    bf16_t* U;
    __device__ __forceinline__ void operator()(const f32x4 (&acc)[2][2][4][2], const Unit& u, int wr, int wc, int fr, int fq) const {
        const int row0 = u.pm * BM + wr * 64 + fr, c0 = u.pn * 128 + wc * 32 + 8 * fq;
#pragma unroll
        for (int ai = 0; ai < 2; ++ai)
#pragma unroll
            for (int m = 0; m < 4; ++m) { bf16_t* rowp = U + (size_t)(row0 + ai * HALF + m * 16) * DFF2 + c0;
                *(u32x4*)(rowp) = pack8(acc[ai][0][m][0], acc[ai][0][m][1]); *(u32x4*)(rowp + DFF) = pack8(acc[ai][1][m][0], acc[ai][1][m][1]); }
    }
};
}

namespace pg8 {
__device__ __forceinline__ float dpp_shr1(float v) { return __builtin_bit_cast(float, __builtin_amdgcn_update_dpp(0, __builtin_bit_cast(int, v), 0x111, 0xf, 0xf, true)); }
__device__ __forceinline__ float gelu_fast(float a) { const float u2 = a * (1.5957691216057308f + 0.07135481627f * a * a); return a * __builtin_amdgcn_rcpf(1.f + __builtin_amdgcn_exp2f(-1.4426950408889634f * u2)); }
struct EpiConv {
    static constexpr bool PERM = true, AFTER_DRAIN = false, APERM = true;
    bf16_t* act; const float* cw; const float* cb; bf16_t* hlast; float* hfirst; PG8_LAS float* xch;
    __device__ __forceinline__ void operator()(f32x4 (&acc)[2][2][4][2], const Unit& u, int wr, int wc, int fr, int fq) const {
        const int tok0 = u.pm * BM + 128 * wr + 8 * fr, chb = u.pn * 128 + wc * 32 + 8 * fq, colb = u.pn * BM + wc * 32 + 8 * fq;
        f32x4 cwt[8];
#define EC_LOADW(ch_) do { cwt[0] = *(const f32x4*)(cw + (ch_)); cwt[1] = *(const f32x4*)(cw + DFF2 + (ch_)); cwt[2] = *(const f32x4*)(cw + 2 * DFF2 + (ch_)); cwt[3] = *(const f32x4*)(cb + (ch_)); \
        cwt[4] = *(const f32x4*)(cw + DFF + (ch_)); cwt[5] = *(const f32x4*)(cw + DFF2 + DFF + (ch_)); cwt[6] = *(const f32x4*)(cw + 2 * DFF2 + DFF + (ch_)); cwt[7] = *(const f32x4*)(cb + DFF + (ch_)); } while (0)
        EC_LOADW(chb);
        PG8_LAS float* xp = xch + (wc * 4 + fq) * 32;
        if (wr == 0 && fr == 15) {
#pragma unroll
            for (int n = 0; n < 2; ++n)
#pragma unroll
                for (int e = 0; e < 4; ++e) { xp[n * 4 + e] = acc[1][0][2][n][e]; xp[8 + n * 4 + e] = acc[1][0][3][n][e]; xp[16 + n * 4 + e] = acc[1][1][2][n][e]; xp[24 + n * 4 + e] = acc[1][1][3][n][e]; } }
        asm volatile("s_waitcnt lgkmcnt(0)" ::: "memory"); __builtin_amdgcn_s_barrier(); asm volatile("" ::: "memory");
        if (wr == 1 && fr == 15) {
#pragma unroll
            for (int s = 0; s < 2; ++s) { bf16_t* hp = hlast + ((size_t)u.pm * 2 + s) * DFF2 + colb;
                *(u32x4*)(hp) = pack8(acc[1][0][2 + s][0], acc[1][0][2 + s][1]); *(u32x4*)(hp + HALF) = pack8(acc[1][1][2 + s][0], acc[1][1][2 + s][1]); } }
        unsigned keep[8][2];
#pragma unroll
        for (int n = 0; n < 2; ++n) { if (n == 1) EC_LOADW(chb + 4);
            const f32x4 wa0 = cwt[0], wa1 = cwt[1], wa2 = cwt[2], ba = cwt[3], wv0 = cwt[4], wv1 = cwt[5], wv2 = cwt[6], bv = cwt[7];
            f32x4 pa6, pa7, pv6, pv7;
#pragma unroll
            for (int e = 0; e < 4; ++e) { pa6[e] = dpp_shr1(acc[1][0][2][n][e]); pa7[e] = dpp_shr1(acc[1][0][3][n][e]); pv6[e] = dpp_shr1(acc[1][1][2][n][e]); pv7[e] = dpp_shr1(acc[1][1][3][n][e]); }
            if (wr == 1 && fr == 0) {
#pragma unroll
                for (int e = 0; e < 4; ++e) { pa6[e] = xp[n * 4 + e]; pa7[e] = xp[8 + n * 4 + e]; pv6[e] = xp[16 + n * 4 + e]; pv7[e] = xp[24 + n * 4 + e]; } }
            f32x4 a2 = pa6, a1 = pa7, v2 = pv6, v1 = pv7;
#pragma unroll
            for (int s = 0; s < 8; ++s) { const f32x4 a0 = acc[s >> 2][0][s & 3][n], v0 = acc[s >> 2][1][s & 3][n];
                f32x4 ca = ba + wa0 * a2 + wa1 * a1 + wa2 * a0; const f32x4 cv = bv + wv0 * v2 + wv1 * v1 + wv2 * v0;
                if (s < 2 && wr == 0 && fr == 0) { float* hp = hfirst + ((size_t)u.pm * 2 + s) * DFF2 + colb + 4 * n; *(f32x4*)hp = ca; *(f32x4*)(hp + HALF) = cv; }
#pragma unroll
                for (int e = 0; e < 4; ++e) ca[e] = gelu_fast(ca[e]) * cv[e];
                const unsigned lo = cvt_pk_bf16(ca[0], ca[1]), hi = cvt_pk_bf16(ca[2], ca[3]);
                if (n == 0) { keep[s][0] = lo; keep[s][1] = hi; }
                else { u32x4 w; w.x = keep[s][0]; w.y = keep[s][1]; w.z = lo; w.w = hi; *(u32x4*)(act + (size_t)(tok0 + s) * DFF + chb) = w; }
                a2 = a1; a1 = a0; v2 = v1; v1 = v0; } }
#undef EC_LOADW
    }
};
}
namespace pg8 {
struct RowX { float* slots; unsigned* cnt; unsigned* bar; };
__device__ __forceinline__ void rowx_publish(const f32x4 (&acc)[2][2][4][2], const RowX& X, const Unit& u, int wr, int wc, int fr, int fq, PG8_LAS float* part, int tid) {
#pragma unroll
    for (int ai = 0; ai < 2; ++ai)
#pragma unroll
        for (int m = 0; m < 4; ++m) { float s = 0.f;
#pragma unroll
            for (int bj = 0; bj < 2; ++bj)
#pragma unroll
                for (int n = 0; n < 2; ++n) { const f32x4 v = acc[ai][bj][m][n]; s += (v[0] * v[0] + v[1] * v[1]) + (v[2] * v[2] + v[3] * v[3]); }
            part[(wc * 4 + fq) * 272 + wr * 64 + ai * HALF + m * 16 + fr] = s; }
    asm volatile("s_waitcnt lgkmcnt(0)" ::: "memory"); __syncthreads();
    if (tid < 256) { float t = 0.f;
#pragma unroll
        for (int s = 0; s < 16; ++s) t += part[s * 272 + tid];
        __hip_atomic_store(X.slots + ((size_t)u.pm * BM + tid) * 8 + u.pn, t, RLX_AGENT); }
    asm volatile("s_waitcnt vmcnt(0)" ::: "memory"); __syncthreads();
    if (tid == 0) (void)xb_add(X.cnt, 1u);
}
__device__ __forceinline__ void rowx_wait(const RowX& X, const Unit& u, PG8_LAS float* rs, int tid) {
    if (tid == 0) { XB_SPIN(xb_ld(X.cnt) < 8u, X.bar); }
    __syncthreads();
    if (tid < 256) { unsigned* sp = (unsigned*)(X.slots + ((size_t)u.pm * BM + tid) * 8); float t = 0.f;
#pragma unroll
        for (int j = 0; j < 8; ++j) t += __uint_as_float(xb_ld(sp + j));
        rs[tid] = rsqrtf(t * (1.f / DM) + EPSN); }
    asm volatile("s_waitcnt lgkmcnt(0)" ::: "memory"); __syncthreads();
}
struct EpiResOut {
    static constexpr bool PERM = true, AFTER_DRAIN = true, APERM = false;
    const bf16_t* x1b; const float* gate; const float* g; float* out; RowX X; float oscale;
    __device__ __forceinline__ void fused(f32x4 (&acc)[2][2][4][2], const Unit& u, int wr, int wc, int fr, int fq, PG8_LAS unsigned char* lds, int wid, int lane) const {
        const int tid = wid * 64 + lane; PG8_LAS float* part = (PG8_LAS float*)lds; PG8_LAS float* rs = part + 16 * 272;
        rowx_publish(acc, X, u, wr, wc, fr, fq, part, tid);
        const int lrow0 = wr * 64 + fr, row0 = u.pm * BM + lrow0, col0 = u.pn * BM + wc * 32 + 8 * fq; const float* gb = gate + (u.pm / 16) * 12288;
        f32x4 gg[2][2];
#pragma unroll
        for (int bj = 0; bj < 2; ++bj)
#pragma unroll
            for (int n = 0; n < 2; ++n) gg[bj][n] = *(const f32x4*)(gb + col0 + bj * HALF + 4 * n) * *(const f32x4*)(g + col0 + bj * HALF + 4 * n);
        u32x4 xr[2][2][2];
#define RO_LOAD(buf, aq_) do { _Pragma("unroll") for (int mm = 0; mm < 2; ++mm) _Pragma("unroll") for (int bj = 0; bj < 2; ++bj) \
            xr[buf][mm][bj] = *(const u32x4*)(x1b + (size_t)(row0 + ((aq_) >> 1) * HALF + (((aq_) & 1) * 2 + mm) * 16) * DM + col0 + bj * HALF); } while (0)
        RO_LOAD(0, 0);
        rowx_wait(X, u, rs, tid);
#pragma unroll
        for (int aq = 0; aq < 4; ++aq) { const int ai = aq >> 1, mb = (aq & 1) * 2;
            if (aq + 1 < 4) RO_LOAD((aq + 1) & 1, aq + 1);
            __builtin_amdgcn_sched_barrier(0);
#pragma unroll
            for (int mm = 0; mm < 2; ++mm) { const int m = mb + mm, row = row0 + ai * HALF + m * 16; const float r = rs[lrow0 + ai * HALF + m * 16];
#pragma unroll
                for (int bj = 0; bj < 2; ++bj) { f32x4 xa, xb; unpack8(xr[aq & 1][mm][bj], xa, xb); float* op = out + (size_t)row * DM + col0 + bj * HALF;
                    *(f32x4*)op = (xa + gg[bj][0] * (acc[ai][bj][m][0] * r)) * oscale; *(f32x4*)(op + 4) = (xb + gg[bj][1] * (acc[ai][bj][m][1] * r)) * oscale; } }
            __builtin_amdgcn_sched_barrier(0); }
#undef RO_LOAD
    }
};
struct EpiResMid {
    static constexpr bool PERM = true, AFTER_DRAIN = true, APERM = false;
    const float* x; const float* mod; const float* g1; const float* g2; bf16_t* x1b; bf16_t* h2; RowX X1, X2;
    __device__ __forceinline__ void fused(f32x4 (&acc)[2][2][4][2], const Unit& u, int wr, int wc, int fr, int fq, PG8_LAS unsigned char* lds, int wid, int lane) const {
        const int tid = wid * 64 + lane; PG8_LAS float* part = (PG8_LAS float*)lds; PG8_LAS float* rs = part + 16 * 272;
        rowx_publish(acc, X1, u, wr, wc, fr, fq, part, tid);
        const int lrow0 = wr * 64 + fr, row0 = u.pm * BM + lrow0, col0 = u.pn * BM + wc * 32 + 8 * fq; const float* mb_ = mod + (u.pm / 16) * 12288;
        { f32x4 gg[2][2];
#pragma unroll
          for (int bj = 0; bj < 2; ++bj)
#pragma unroll
              for (int n = 0; n < 2; ++n) gg[bj][n] = *(const f32x4*)(mb_ + 4096 + col0 + bj * HALF + 4 * n) * *(const f32x4*)(g1 + col0 + bj * HALF + 4 * n);
          f32x4 xr[2][2][2];
#define RM_LOAD(buf, aq_) do { _Pragma("unroll") for (int bj = 0; bj < 2; ++bj) { const float* xp = x + (size_t)(row0 + ((aq_) >> 2) * HALF + ((aq_) & 3) * 16) * DM + col0 + bj * HALF; \
              xr[buf][bj][0] = __builtin_nontemporal_load((const f32x4*)xp); xr[buf][bj][1] = __builtin_nontemporal_load((const f32x4*)xp + 1); } } while (0)
          RM_LOAD(0, 0);
          rowx_wait(X1, u, rs, tid);
#pragma unroll
          for (int aq = 0; aq < 8; ++aq) { const int ai = aq >> 2, m = aq & 3;
              if (aq + 1 < 8) RM_LOAD((aq + 1) & 1, aq + 1);
              __builtin_amdgcn_sched_barrier(0);
              const float r = rs[lrow0 + ai * HALF + m * 16];
#pragma unroll
              for (int bj = 0; bj < 2; ++bj)
#pragma unroll
                  for (int n = 0; n < 2; ++n) acc[ai][bj][m][n] = xr[aq & 1][bj][n] + gg[bj][n] * (acc[ai][bj][m][n] * r);
              __builtin_amdgcn_sched_barrier(0); } }
#undef RM_LOAD
        __syncthreads();
        rowx_publish(acc, X2, u, wr, wc, fr, fq, part, tid);
#pragma unroll
        for (int ai = 0; ai < 2; ++ai)
#pragma unroll
            for (int m = 0; m < 4; ++m)
#pragma unroll
                for (int bj = 0; bj < 2; ++bj) *(u32x4*)(x1b + (size_t)(row0 + ai * HALF + m * 16) * DM + col0 + bj * HALF) = pack8(acc[ai][bj][m][0], acc[ai][bj][m][1]);
        rowx_wait(X2, u, rs, tid);
#pragma unroll
        for (int bj = 0; bj < 2; ++bj) { f32x4 gs[2], sh[2];
#pragma unroll
            for (int n = 0; n < 2; ++n) { const int c = col0 + bj * HALF + 4 * n; gs[n] = *(const f32x4*)(g2 + c) * (1.f + *(const f32x4*)(mb_ + 8192 + c)); sh[n] = *(const f32x4*)(mb_ + 6144 + c); }
#pragma unroll
            for (int ai = 0; ai < 2; ++ai)
#pragma unroll
                for (int m = 0; m < 4; ++m) { const float r = rs[lrow0 + ai * HALF + m * 16];
                    *(u32x4*)(h2 + (size_t)(row0 + ai * HALF + m * 16) * DM + col0 + bj * HALF) = pack8(acc[ai][bj][m][0] * r * gs[0] + sh[0], acc[ai][bj][m][1] * r * gs[1] + sh[1]); } }
    }
};
}
__device__ __forceinline__ void ph_convfix(const bf16_t* hlast, const float* hfirst, const float* cw, bf16_t* act, int pm, int wave, int lane) {
    if (pm % 16 == 0) return;
    for (int it = wave; it < 2 * 22; it += 8) { const int s = it / 22, seg = it % 22;
        const int ch = seg * 256 + 4 * lane, pn = ch >> 7, col = pn * 256 + (ch & 127);
        f32x4 ca = *(const f32x4*)(hfirst + ((size_t)pm * 2 + s) * DFF2 + col), cv = *(const f32x4*)(hfirst + ((size_t)pm * 2 + s) * DFF2 + col + 128);
        const bf16_t* h0 = hlast + ((size_t)(pm - 1) * 2) * DFF2 + col; const bf16_t* h1 = h0 + DFF2;
        const uint2 a0r = *(const uint2*)h0, a1r = *(const uint2*)h1, v0r = *(const uint2*)(h0 + 128), v1r = *(const uint2*)(h1 + 128);
        f32x4 a0, a1, v0, v1;
        a0[0] = __uint_as_float(a0r.x << 16); a0[1] = __uint_as_float(a0r.x & 0xffff0000u); a0[2] = __uint_as_float(a0r.y << 16); a0[3] = __uint_as_float(a0r.y & 0xffff0000u);
        a1[0] = __uint_as_float(a1r.x << 16); a1[1] = __uint_as_float(a1r.x & 0xffff0000u); a1[2] = __uint_as_float(a1r.y << 16); a1[3] = __uint_as_float(a1r.y & 0xffff0000u);
        v0[0] = __uint_as_float(v0r.x << 16); v0[1] = __uint_as_float(v0r.x & 0xffff0000u); v0[2] = __uint_as_float(v0r.y << 16); v0[3] = __uint_as_float(v0r.y & 0xffff0000u);
        v1[0] = __uint_as_float(v1r.x << 16); v1[1] = __uint_as_float(v1r.x & 0xffff0000u); v1[2] = __uint_as_float(v1r.y << 16); v1[3] = __uint_as_float(v1r.y & 0xffff0000u);
        const f32x4 wa0 = *(const f32x4*)(cw + ch), wa1 = *(const f32x4*)(cw + DFF2 + ch), wv0 = *(const f32x4*)(cw + DFF + ch), wv1 = *(const f32x4*)(cw + DFF2 + DFF + ch);
        if (s == 0) { ca += wa0 * a0 + wa1 * a1; cv += wv0 * v0 + wv1 * v1; } else { ca += wa0 * a1; cv += wv0 * v1; }
#pragma unroll
        for (int e = 0; e < 4; ++e) ca[e] = pg8::gelu_fast(ca[e]) * cv[e];
        uint2 w; w.x = pg8::cvt_pk_bf16(ca[0], ca[1]); w.y = pg8::cvt_pk_bf16(ca[2], ca[3]);
        *(uint2*)(act + ((size_t)pm * 256 + s) * DFF + ch) = w; }
}
namespace att {
typedef short bf16x8 __attribute__((ext_vector_type(8)));
typedef short s16x4 __attribute__((ext_vector_type(4)));
typedef float f32x16 __attribute__((ext_vector_type(16)));
typedef __attribute__((address_space(3))) const unsigned char* lcp;
constexpr int KROW = 400, VROW = 320, KBYTES = 64 * KROW, VBYTES = 64 * VROW, BUFB = KBYTES + VBYTES;
constexpr size_t WS_ATTP = 108 * MiB, WS_ATTML = 68 * MiB + 512 * 1024;
__device__ __forceinline__ int crow(int r, int hi) { return (r & 3) + 8 * (r >> 2) + 4 * hi; }
__device__ __forceinline__ s16x4 vtr(lcp p) { typedef short v4i16_t __attribute__((ext_vector_type(4))); return __builtin_bit_cast(s16x4, __builtin_amdgcn_ds_read_tr16_b64_v4i16((__attribute__((address_space(3))) v4i16_t*)p)); }
__device__ __forceinline__ float hswap_max(float x) { auto rr = __builtin_amdgcn_permlane32_swap(__float_as_uint(x), __float_as_uint(x), false, false); return fmaxf(__uint_as_float(rr[0]), __uint_as_float(rr[1])); }
__device__ __forceinline__ float hswap_add(float x) { auto rr = __builtin_amdgcn_permlane32_swap(__float_as_uint(x), __float_as_uint(x), false, false); return __uint_as_float(rr[0]) + __uint_as_float(rr[1]); }
__device__ __forceinline__ bf16x8 packp(const f32x16& p, int b) { pg8::u32x4 w; w.x = pg8::cvt_pk_bf16(p[b], p[b + 1]); w.y = pg8::cvt_pk_bf16(p[b + 2], p[b + 3]); w.z = pg8::cvt_pk_bf16(p[b + 4], p[b + 5]); w.w = pg8::cvt_pk_bf16(p[b + 6], p[b + 7]); return __builtin_bit_cast(bf16x8, w); }

__device__ __forceinline__ void segment(LAS unsigned char* L, const bf16_t* Q, const bf16_t* Kf, const bf16_t* V, int b, int h, int qblk, int t0, int t1, bf16_t* outp, int ostride, float2* ml, int wave, int lane_) {
    const int tid = fresh_tid(), lane = tid & 63, r32 = lane & 31, hh = lane >> 5;
    const size_t rowbase = (size_t)b * SEQ; const int R0 = qblk * 256, qrow = R0 + 32 * wave + r32;
    bf16x8 qf[12];
    { const bf16_t* qp = Q + (rowbase + qrow) * 1536 + h * 192 + 8 * hh;
#pragma unroll
      for (int d0 = 0; d0 < 12; ++d0) qf[d0] = *(const bf16x8*)(qp + 16 * d0); }
    f32x16 O[4];
#pragma unroll
    for (int d0 = 0; d0 < 4; ++d0)
#pragma unroll
        for (int r = 0; r < 16; ++r) O[d0][r] = 0.f;
    float m = -1e30f, l = 0.f;
    const int srow = tid >> 3, sch = tid & 7;
    const int kgo = srow * 1536 + sch * 8, klo = srow * KROW + sch * 16, vgo = srow * 1024 + sch * 8, vlo = KBYTES + srow * VROW + sch * 16;
    const bf16_t* Kh = Kf + rowbase * 1536 + h * 192; const bf16_t* Vh = V + rowbase * 1024 + h * 128;
    pg8::u32x4 skA[3], svA[2], skB[3], svB[2];
#define ATT_LOAD(sk, sv, t) do { _Pragma("unroll") for (int i = 0; i < 3; ++i) sk[i] = *(const pg8::u32x4*)(Kh + (size_t)(t) * 64 * 1536 + kgo + 64 * i); \
                         _Pragma("unroll") for (int i = 0; i < 2; ++i) sv[i] = *(const pg8::u32x4*)(Vh + (size_t)(t) * 64 * 1024 + vgo + 64 * i); } while (0)
#define ATT_WRITE(sk, sv, buf) do { _Pragma("unroll") for (int i = 0; i < 3; ++i) *(LAS pg8::u32x4*)(L + (buf) * BUFB + klo + 128 * i) = sk[i]; \
                            _Pragma("unroll") for (int i = 0; i < 2; ++i) *(LAS pg8::u32x4*)(L + (buf) * BUFB + vlo + 128 * i) = sv[i]; } while (0)
    typedef __attribute__((address_space(3))) const bf16x8* lfp;
#define AT_SB() __builtin_amdgcn_sched_barrier(0)
#define AT_RDK(dst, d0) do { dst[0] = *(lfp)(ka + (d0) * 32); dst[1] = *(lfp)(ka + 32 * KROW + (d0) * 32); dst[2] = *(lfp)(ka + ((d0) + 1) * 32); dst[3] = *(lfp)(ka + 32 * KROW + ((d0) + 1) * 32); } while (0)
#define AT_MMK(src, d0) do { p0 = __builtin_amdgcn_mfma_f32_32x32x16_bf16(src[0], qf[d0], p0, 0, 0, 0); p1 = __builtin_amdgcn_mfma_f32_32x32x16_bf16(src[1], qf[d0], p1, 0, 0, 0); \
            p0 = __builtin_amdgcn_mfma_f32_32x32x16_bf16(src[2], qf[(d0) + 1], p0, 0, 0, 0); p1 = __builtin_amdgcn_mfma_f32_32x32x16_bf16(src[3], qf[(d0) + 1], p1, 0, 0, 0); } while (0)
#define AT_RDV(dst, d0) do { _Pragma("unroll") for (int ks = 0; ks < 4; ++ks) { const s16x4 lo_ = vtr(va + (16 * ks) * VROW + 64 * (d0)), hi_ = vtr(va + (16 * ks + 8) * VROW + 64 * (d0)); \
            dst[ks] = (bf16x8){lo_[0], lo_[1], lo_[2], lo_[3], hi_[0], hi_[1], hi_[2], hi_[3]}; } } while (0)
#define AT_MMV(src, d0) do { _Pragma("unroll") for (int ks = 0; ks < 4; ++ks) O[d0] = __builtin_amdgcn_mfma_f32_32x32x16_bf16(src[ks], pf[ks], O[d0], 0, 0, 0); } while (0)
#define AT_PV(slot) do { lcp va = (lcp)(L + (slot) * BUFB + KBYTES) + (4 * hh + ((lane & 15) >> 2)) * VROW + (16 * ((lane >> 4) & 1) + 4 * (lane & 3)) * 2; bf16x8 v0[4], v1[4]; \
            AT_RDV(v0, 0); AT_SB(); AT_RDV(v1, 1); AT_SB(); AT_MMV(v0, 0); AT_SB(); AT_RDV(v0, 2); AT_SB(); AT_MMV(v1, 1); AT_SB(); AT_RDV(v1, 3); AT_SB(); AT_MMV(v0, 2); AT_SB(); AT_MMV(v1, 3); AT_SB(); } while (0)
    const bool lag = wave >= 4; bool pend = false; int pslot = 0; bf16x8 pf[4];
    constexpr int AHEAD = 1;
    ATT_LOAD(skA, svA, t0); ATT_WRITE(skA, svA, 0);
    if (AHEAD == 2 && t0 + 1 < t1) ATT_LOAD(skB, svB, t0 + 1);
    __syncthreads();
    int cur = 0;
    auto step = [&](const int t, pg8::u32x4 (&lk)[3], pg8::u32x4 (&lv)[2], pg8::u32x4 (&wk)[3], pg8::u32x4 (&wv)[2]) __attribute__((always_inline)) {
        const bool more = (t + 1 < t1);
        if (t + AHEAD < t1) ATT_LOAD(lk, lv, t + AHEAD);
        if (lag && pend) { AT_PV(pslot); pend = false; }
        if (64 * t <= R0 + 32 * wave + 31) {
            lcp Kb = (lcp)(L + cur * BUFB);
            f32x16 p0, p1;
#pragma unroll
            for (int r = 0; r < 16; ++r) { p0[r] = 0.f; p1[r] = 0.f; }
            lcp ka = Kb + r32 * KROW + hh * 16;
            { bf16x8 fa[4], fb[4];
              AT_RDK(fa, 0); AT_SB();
              AT_RDK(fb, 2); AT_SB(); AT_MMK(fa, 0); AT_SB();
              AT_RDK(fa, 4); AT_SB(); AT_MMK(fb, 2); AT_SB();
              AT_RDK(fb, 6); AT_SB(); AT_MMK(fa, 4); AT_SB();
              AT_RDK(fa, 8); AT_SB(); AT_MMK(fb, 6); AT_SB();
              AT_RDK(fb, 10); AT_SB(); AT_MMK(fa, 8); AT_SB();
              AT_MMK(fb, 10); AT_SB(); }
            if (64 * t + 63 > R0 + 32 * wave) {
                const float NEG = -__builtin_inff();
#pragma unroll
                for (int r = 0; r < 16; ++r) { const int key = 64 * t + crow(r, hh); if (key > qrow) p0[r] = NEG; if (key + 32 > qrow) p1[r] = NEG; }
            }
            float mxa[4];
#pragma unroll
            for (int q = 0; q < 4; ++q) mxa[q] = fmaxf(p0[q], p1[q]);
#pragma unroll
            for (int r = 4; r < 16; ++r) mxa[r & 3] = fmaxf(mxa[r & 3], fmaxf(p0[r], p1[r]));
            float mx = fmaxf(fmaxf(mxa[0], mxa[1]), fmaxf(mxa[2], mxa[3]));
            mx = hswap_max(mx);
            if (__any(mx > m + 8.f)) { const float mn = fmaxf(m, mx), alpha = __builtin_amdgcn_exp2f(m - mn); m = mn; l *= alpha;
#pragma unroll
                for (int d0 = 0; d0 < 4; ++d0)
#pragma unroll
                    for (int r = 0; r < 16; ++r) O[d0][r] *= alpha; }
            float psa[4] = {0.f, 0.f, 0.f, 0.f};
#pragma unroll
            for (int r = 0; r < 16; ++r) { p0[r] = __builtin_amdgcn_exp2f(p0[r] - m); p1[r] = __builtin_amdgcn_exp2f(p1[r] - m); psa[r & 3] += p0[r] + p1[r]; }
            l += (psa[0] + psa[1]) + (psa[2] + psa[3]);
            pf[0] = packp(p0, 0); pf[1] = packp(p0, 8); pf[2] = packp(p1, 0); pf[3] = packp(p1, 8);
            AT_SB();
            if (lag) { pend = true; pslot = cur; } else AT_PV(cur);
        }
        const int nx = cur == 2 ? 0 : cur + 1;
        if (more) ATT_WRITE(wk, wv, nx);
        __syncthreads();
        cur = nx;
    };
    if (AHEAD == 2) { for (int t = t0; t < t1; t += 2) { step(t, skA, svA, skB, svB); if (t + 1 < t1) step(t + 1, skB, svB, skA, svA); } }
    else { for (int t = t0; t < t1; ++t) step(t, skA, svA, skA, svA); }
    if (lag && pend) AT_PV(pslot);
#undef AT_PV
#undef AT_SB
#undef AT_RDK
#undef AT_MMK
#undef AT_RDV
#undef AT_MMV
#undef ATT_LOAD
#undef ATT_WRITE
    const float lt = hswap_add(l), inv = lt > 0.f ? 1.f / lt : 0.f;
    bf16_t* op = outp + (size_t)(32 * wave + r32) * ostride + 4 * hh;
#pragma unroll
    for (int d0 = 0; d0 < 4; ++d0)
#pragma unroll
        for (int g = 0; g < 4; ++g) { uint2 w; w.x = pg8::cvt_pk_bf16(O[d0][4 * g] * inv, O[d0][4 * g + 1] * inv); w.y = pg8::cvt_pk_bf16(O[d0][4 * g + 2] * inv, O[d0][4 * g + 3] * inv);
            *(uint2*)(op + 32 * d0 + 8 * g) = w; }
    if (ml && hh == 0) ml[32 * wave + r32] = make_float2(m, lt);
}
constexpr int ATT_NCU = 13;
__device__ __forceinline__ int att_B(int j) {
    constexpr int T[14] = {0, 45, 88, 131, 176, 219, 262, 305, 348, 391, 432, 475, 515, 544};
    int r = T[13];
#pragma unroll
    for (int k = 12; k >= 0; --k) r = (j <= k) ? T[k] : r;
    return r; }
static_assert(ATT_NCU == 13, "att_B table is for 13 CUs per (b,h)");
__device__ __forceinline__ int att_off(int u) { return 64 * u - 2 * u * (u - 1); }
__device__ __forceinline__ void phase(LAS unsigned char* L, const bf16_t* Q, const bf16_t* Kf, const bf16_t* V, bf16_t* om, unsigned char* ws, int bh, int j, int wave, int lane) {
    bf16_t* PO = (bf16_t*)(ws + WS_ATTP); float2* PML = (float2*)(ws + WS_ATTML);
    const int b = bh >> 3, h = bh & 7, lo = att_B(j), hi = att_B(j + 1);
    int pos = lo, u = 0;
    while (att_off(u + 1) <= pos) ++u;
    while (pos < hi) { const int off = att_off(u), n = 4 * (16 - u), t0 = pos - off, t1 = (hi - off < n) ? hi - off : n, qb = 15 - u;
        if (t0 == 0 && t1 == n) segment(L, Q, Kf, V, b, h, qb, 0, n, om + ((size_t)b * SEQ + 256 * qb) * 1024 + h * 128, 1024, nullptr, wave, lane);
        else { const int slot = bh * (2 * ATT_NCU) + (t0 > 0 ? 2 * j - 1 : 2 * j);
            segment(L, Q, Kf, V, b, h, qb, t0, t1, PO + (size_t)slot * 256 * 128, 128, PML + slot * 256, wave, lane); }
        pos = off + t1; ++u; }
}
__device__ __forceinline__ void combine(bf16_t* om, unsigned char* ws, int gw, int NGW, int lane) {
    const bf16_t* PO = (const bf16_t*)(ws + WS_ATTP); const float2* PML = (const float2*)(ws + WS_ATTML);
    const int rsub = lane >> 4, c8 = (lane & 15) * 8;
#define CB_LOAD(NP, ML, POV, DST, it_) do { NP = 0; if ((it_) < 256 * 64) { const int un = (it_) >> 6, rg = (it_) & 63, bh = un >> 4, u = un & 15, b = bh >> 3, h = bh & 7; \
        const int off = att_off(u), n = 4 * (16 - u); int jf = 0, jl = 0; \
        _Pragma("unroll") for (int jj = 1; jj < ATT_NCU; ++jj) { if (att_B(jj) <= off) jf = jj; if (att_B(jj) < off + n) jl = jj; } \
        if (jf != jl) { const int row = rg * 4 + rsub; NP = jl - jf + 1; DST = om + ((size_t)b * SEQ + 256 * (15 - u) + row) * 1024 + h * 128 + c8; \
            _Pragma("unroll") for (int p = 0; p < 3; ++p) if (jf + p <= jl) { const int jj = jf + p, slot = bh * (2 * ATT_NCU) + (p == 0 ? 2 * jj : 2 * jj - 1); \
                ML[p] = PML[slot * 256 + row]; POV[p] = *(const pg8::u32x4*)(PO + ((size_t)slot * 256 + row) * 128 + c8); } } } } while (0)
    int npA, npB; float2 mlA[3], mlB[3]; pg8::u32x4 poA[3], poB[3]; bf16_t* dA; bf16_t* dB;
#define CB_PROC(NP, ML, POV, DST) do { if (NP) { float mm = ML[0].x; _Pragma("unroll") for (int p = 1; p < 3; ++p) if (p < NP) mm = fmaxf(mm, ML[p].x); \
        f32x4 o0 = {0.f, 0.f, 0.f, 0.f}, o1 = o0; float wsum = 0.f; \
        _Pragma("unroll") for (int p = 0; p < 3; ++p) if (p < NP) { const float w = ML[p].y * __builtin_amdgcn_exp2f(ML[p].x - mm); f32x4 a, c; pg8::unpack8(POV[p], a, c); o0 += w * a; o1 += w * c; wsum += w; } \
        const float inv = 1.f / wsum; *(pg8::u32x4*)(DST) = pg8::pack8(o0 * inv, o1 * inv); } } while (0)
    int it = gw;
    CB_LOAD(npA, mlA, poA, dA, it);
    for (; it < 256 * 64; it += 2 * NGW) {
        CB_LOAD(npB, mlB, poB, dB, it + NGW);
        CB_PROC(npA, mlA, poA, dA);
        CB_LOAD(npA, mlA, poA, dA, it + 2 * NGW);
        CB_PROC(npB, mlB, poB, dB);
    }
#undef CB_LOAD
#undef CB_PROC
}
}
namespace gla {
typedef short bf16x8 __attribute__((ext_vector_type(8)));
typedef float f32x16 __attribute__((ext_vector_type(16)));
typedef __attribute__((address_space(3))) const unsigned char* lcp;
constexpr size_t WS_IMG = 32 * MiB, WS_VT = 252 * MiB;
constexpr int IMG_STRIDE = 73728;
constexpr int PROW = 528;
constexpr int L_GL = 0, L_TOT = 4096, L_BLAST = 5120, L_QB = 8192, L_KB = L_QB + 64 * PROW, L_VS = L_KB + 64 * PROW;
__device__ __forceinline__ int crow(int r, int hi) { return (r & 3) + 8 * (r >> 2) + 4 * hi; }
__device__ __forceinline__ unsigned pk(float lo, float hi) { return pg8::cvt_pk_bf16(lo, hi); }
__device__ __forceinline__ bf16x8 packs(const f32x16& p, int b) { pg8::u32x4 w; w.x = pk(p[b], p[b + 1]); w.y = pk(p[b + 2], p[b + 3]); w.z = pk(p[b + 4], p[b + 5]); w.w = pk(p[b + 6], p[b + 7]); return __builtin_bit_cast(bf16x8, w); }

__device__ __forceinline__ void prep_item(LAS unsigned char* L, const bf16_t* z, const float* wg, const float* bg, unsigned char* ws, int bh, int c, int wave, int lane_) {
    const int tid = fresh_tid(), lane = tid & 63, b = bh >> 2, h = bh & 3; const size_t rb = (size_t)b * SEQ + 64 * c; const int ic = bh * 64 + c;
    unsigned char* img = ws + WS_IMG + (size_t)ic * IMG_STRIDE; bf16_t* vT = (bf16_t*)(ws + WS_VT);
    LAS float* GL = (LAS float*)(L + L_GL); LAS float* TOT = (LAS float*)(L + L_TOT); LAS float* BLAST = (LAS float*)(L + L_BLAST);
    pg8::u32x4 rq[4], rk[4], rv[4];
#pragma unroll
    for (int i = 0; i < 4; ++i) { const int q = tid + 512 * i, tok = q >> 5, ch = q & 31; rq[i] = *(const pg8::u32x4*)(z + (rb + tok) * ZB_LD + OFF_GQ + h * 256 + ch * 8); rk[i] = *(const pg8::u32x4*)(z + (rb + tok) * ZB_LD + OFF_GK + h * 256 + ch * 8);
        rv[i] = *(const pg8::u32x4*)(z + (rb + tok) * ZB_LD + OFF_GV + h * 512 + ch * 8); }
    for (int i = 0; i < 2; ++i) { const int idx = tid + 512 * i, tok = idx >> 4, r = idx & 15; GL[idx] = bf2f(z[(rb + tok) * ZB_LD + OFF_GLR + r]); }
    __syncthreads();
    const int d = tid & 255, half = tid >> 8;
    float wgc[16];
#pragma unroll
    for (int r = 0; r < 16; ++r) wgc[r] = wg[r * 1024 + h * 256 + d];
    const float bias = bg[h * 256 + d];
    float bl[32]; float run = 0.f;
#pragma unroll
    for (int i = 0; i < 32; ++i) { const int tok = 32 * half + i; float xg = bias;
#pragma unroll
        for (int r = 0; r < 16; ++r) xg += GL[tok * 16 + r] * wgc[r];
        const float ls = fminf(xg, 0.f) - __logf(1.f + __expf(-fabsf(xg)));
        run += ls * (1.f / 16.f); bl[i] = run; }
    if (half == 0) TOT[d] = run;
#pragma unroll
    for (int i = 0; i < 4; ++i) { const int q = tid + 512 * i, tok = q >> 5, ch = q & 31; *(LAS pg8::u32x4*)(L + L_QB + tok * PROW + ch * 16) = rq[i]; *(LAS pg8::u32x4*)(L + L_KB + tok * PROW + ch * 16) = rk[i]; *(LAS pg8::u32x4*)(L + L_VS + tok * PROW + ch * 16) = rv[i];
        rv[i] = *(const pg8::u32x4*)(z + (rb + tok) * ZB_LD + OFF_GV + h * 512 + 256 + ch * 8); }
    __syncthreads();
    if (half == 1) { const float t0 = TOT[d];
#pragma unroll
        for (int i = 0; i < 32; ++i) bl[i] += t0;
        BLAST[d] = bl[31]; }
    __syncthreads();
    const float blast = BLAST[d];
    if (half == 0) *(float*)(img + 70 * 1024 + d * 4) = __expf(blast);
#pragma unroll
    for (int g = 0; g < 4; ++g) { float klv[8];
#pragma unroll
        for (int j = 0; j < 8; ++j) { const int i = 8 * g + j, tok = 32 * half + i;
            const float qv = bf2f(*(const LAS bf16_t*)(L + L_QB + tok * PROW + d * 2)), kv = bf2f(*(const LAS bf16_t*)(L + L_KB + tok * PROW + d * 2));
            *(LAS bf16_t*)(L + L_QB + tok * PROW + d * 2) = f2bf(qv * 0.0625f * __expf(bl[i]));
            *(LAS bf16_t*)(L + L_KB + tok * PROW + d * 2) = f2bf(kv * __expf(-bl[i]));
            klv[j] = kv * __expf(blast - bl[i]); }
        pg8::u32x4 w; w.x = pk(klv[0], klv[1]); w.y = pk(klv[2], klv[3]); w.z = pk(klv[4], klv[5]); w.w = pk(klv[6], klv[7]);
        *(pg8::u32x4*)(img + (38 + (d >> 4) * 2 + half) * 1024 + (g * 16 + (d & 15)) * 16) = w; }
    __syncthreads();
#pragma unroll
    for (int i = 0; i < 4; ++i) { const int q = tid + 512 * i, tok = q >> 5, ch = q & 31, t = ch >> 2, gq = ch & 3;
        typedef unsigned u32x2_t __attribute__((ext_vector_type(2)));
        const u32x2_t lo = *(const LAS u32x2_t*)(L + L_QB + tok * PROW + (32 * t + 4 * gq) * 2), hi = *(const LAS u32x2_t*)(L + L_QB + tok * PROW + (32 * t + 16 + 4 * gq) * 2);
        pg8::u32x4 w; w.x = lo.x; w.y = lo.y; w.z = hi.x; w.w = hi.y;
        *(pg8::u32x4*)(img + ((tok >> 4) * 8 + t) * 1024 + (gq * 16 + (tok & 15)) * 16) = w; }
    if (wave < 4) { const int ti = wave >> 1, tj = wave & 1, r32 = lane & 31, hh = lane >> 5; f32x16 C;
#pragma unroll
        for (int r = 0; r < 16; ++r) C[r] = 0.f;
        if (tj <= ti) { lcp ka = (lcp)(L + L_KB + (32 * tj + r32) * PROW + hh * 16); lcp qa = (lcp)(L + L_QB + (32 * ti + r32) * PROW + hh * 16);
#pragma unroll
            for (int s = 0; s < 16; ++s) { const bf16x8 kf = *(const __attribute__((address_space(3))) bf16x8*)(ka + s * 32), qf = *(const __attribute__((address_space(3))) bf16x8*)(qa + s * 32);
                C = __builtin_amdgcn_mfma_f32_32x32x16_bf16(kf, qf, C, 0, 0, 0); } }
        const int irow = 32 * ti + r32;
#pragma unroll
        for (int g = 0; g < 4; ++g) { float v[4];
#pragma unroll
            for (int q = 0; q < 4; ++q) { const int j = 32 * tj + crow(4 * g + q, hh); v[q] = (j <= irow) ? C[4 * g + q] : 0.f; }
            uint2 w; w.x = pk(v[0], v[1]); w.y = pk(v[2], v[3]);
            const int tt = irow >> 4, P = tt < 2 ? 32 + tt : 34 + (tt - 2) * 2 + tj;
            if (tj <= ti) *(uint2*)(img + P * 1024 + (g * 16 + (irow & 15)) * 16 + hh * 8) = w; } }
    for (int e0 = 0; e0 < 512; e0 += 256) {
        if (e0) {
#pragma unroll
            for (int i = 0; i < 4; ++i) { const int q = tid + 512 * i, tok = q >> 5, ch = q & 31; *(LAS pg8::u32x4*)(L + L_VS + tok * PROW + ch * 16) = rv[i]; }
            __syncthreads(); }
#pragma unroll
        for (int g = 0; g < 4; ++g) { unsigned short t8[8];
#pragma unroll
            for (int j = 0; j < 8; ++j) t8[j] = *(const LAS bf16_t*)(L + L_VS + (32 * half + 8 * g + j) * PROW + d * 2);
            pg8::u32x4 w; w.x = t8[0] | ((unsigned)t8[1] << 16); w.y = t8[2] | ((unsigned)t8[3] << 16); w.z = t8[4] | ((unsigned)t8[5] << 16); w.w = t8[6] | ((unsigned)t8[7] << 16);
            *(pg8::u32x4*)(vT + ((size_t)ic * 512 + e0 + d) * 64 + 32 * half + 8 * g) = w; }
        __syncthreads();
    }
}
__device__ __forceinline__ void prep_phase(LAS unsigned char* L, const bf16_t* z, const float* wg, const float* bg, unsigned char* ws, int vcu, int G, int wave, int lane) {
    for (int it = vcu; it < 512; it += G) prep_item(L, z, wg, bg, ws, it >> 6, it & 63, wave, lane);
}
typedef float f32x4a __attribute__((ext_vector_type(4)));
constexpr int SC_NP = 71, SC_BUF = SC_NP * 1024;
template <int MODE>
__device__ __forceinline__ void scan_chunk(LAS unsigned char* L, f32x4a (&S)[16], const bf16x8 vf0, const bf16x8 vf1, const int c, bf16_t* ogp, const int lane, const int g4) {
        const int buf = c & 1;
        lcp F = (lcp)(L + buf * SC_BUF + lane * 16);
#define SC_FRAG(p) (*(const __attribute__((address_space(3))) bf16x8*)(F + (p) * 1024))
        f32x4a OT[4];
#pragma unroll
        for (int tt = 0; tt < 4; ++tt) OT[tt] = (f32x4a){0.f, 0.f, 0.f, 0.f};
#define SC_SB() __builtin_amdgcn_sched_barrier(0)
#define SC_RDQ(dst, t) do { _Pragma("unroll") for (int tt = 0; tt < 4; ++tt) dst[tt] = SC_FRAG(tt * 8 + (t)); } while (0)
#define SC_SF(t) ({ pg8::u32x4 w_; w_.x = pk(S[2 * (t)][0], S[2 * (t)][1]); w_.y = pk(S[2 * (t)][2], S[2 * (t)][3]); w_.z = pk(S[2 * (t) + 1][0], S[2 * (t) + 1][1]); w_.w = pk(S[2 * (t) + 1][2], S[2 * (t) + 1][3]); __builtin_bit_cast(bf16x8, w_); })
#define SC_MMQ(src, t) do { const bf16x8 sf_ = SC_SF(t); __builtin_amdgcn_s_setprio(1); _Pragma("unroll") for (int tt = 0; tt < 4; ++tt) OT[tt] = __builtin_amdgcn_mfma_f32_16x16x32_bf16(sf_, src[tt], OT[tt], 0, 0, 0); __builtin_amdgcn_s_setprio(0); } while (0)
        { bf16x8 qa[4], qb_[4], fa[6];
          SC_RDQ(qa, 0); SC_SB();
#pragma unroll
          for (int t = 0; t < 8; t += 2) { SC_RDQ(qb_, t + 1); SC_SB(); SC_MMQ(qa, t); SC_SB();
              if (t + 2 < 8) { SC_RDQ(qa, t + 2); } else {
#pragma unroll
                  for (int k = 0; k < 6; ++k) fa[k] = SC_FRAG(32 + k); }
              SC_SB(); SC_MMQ(qb_, t + 1); SC_SB(); }
          OT[0] = __builtin_amdgcn_mfma_f32_16x16x32_bf16(vf0, fa[0], OT[0], 0, 0, 0);
          OT[1] = __builtin_amdgcn_mfma_f32_16x16x32_bf16(vf0, fa[1], OT[1], 0, 0, 0);
          OT[2] = __builtin_amdgcn_mfma_f32_16x16x32_bf16(vf0, fa[2], OT[2], 0, 0, 0); OT[2] = __builtin_amdgcn_mfma_f32_16x16x32_bf16(vf1, fa[3], OT[2], 0, 0, 0);
          OT[3] = __builtin_amdgcn_mfma_f32_16x16x32_bf16(vf0, fa[4], OT[3], 0, 0, 0); OT[3] = __builtin_amdgcn_mfma_f32_16x16x32_bf16(vf1, fa[5], OT[3], 0, 0, 0); }
        const __attribute__((address_space(3))) float* E = (const __attribute__((address_space(3))) float*)(L + buf * SC_BUF + 70 * 1024);
#define SC_RDK(kd, ed, q) do { _Pragma("unroll") for (int i_ = 0; i_ < 4; ++i_) { kd[2 * i_] = SC_FRAG(38 + ((q) * 4 + i_) * 2); kd[2 * i_ + 1] = SC_FRAG(39 + ((q) * 4 + i_) * 2); \
            ed[i_] = *(const __attribute__((address_space(3))) f32x4a*)(E + 16 * ((q) * 4 + i_) + 4 * g4); } } while (0)
#define SC_UPD(kd, ed, q) do { _Pragma("unroll") for (int i_ = 0; i_ < 4; ++i_) { const int dt_ = (q) * 4 + i_; S[dt_] = S[dt_] * ed[i_]; } __builtin_amdgcn_s_setprio(1); \
            _Pragma("unroll") for (int i_ = 0; i_ < 4; ++i_) { const int dt_ = (q) * 4 + i_; S[dt_] = __builtin_amdgcn_mfma_f32_16x16x32_bf16(kd[2 * i_], vf0, S[dt_], 0, 0, 0); S[dt_] = __builtin_amdgcn_mfma_f32_16x16x32_bf16(kd[2 * i_ + 1], vf1, S[dt_], 0, 0, 0); } __builtin_amdgcn_s_setprio(0); } while (0)
        { bf16x8 ka[8], kb_[8]; f32x4a ea[4], eb_[4];
          SC_RDK(ka, ea, 0); SC_SB();
#pragma unroll
          for (int tt = 0; tt < 4; ++tt) { uint2 w; w.x = pk(OT[tt][0], OT[tt][1]); w.y = pk(OT[tt][2], OT[tt][3]);
              if (MODE != 2 || c < 1) *(uint2*)(ogp + (size_t)(64 * c + 16 * tt) * DM) = w; }
          SC_RDK(kb_, eb_, 1); SC_SB(); SC_UPD(ka, ea, 0); SC_SB();
          SC_RDK(ka, ea, 2); SC_SB(); SC_UPD(kb_, eb_, 1); SC_SB();
          SC_RDK(kb_, eb_, 3); SC_SB(); SC_UPD(ka, ea, 2); SC_SB();
          SC_UPD(kb_, eb_, 3); }
#undef SC_SB
#undef SC_RDQ
#undef SC_SF
#undef SC_MMQ
#undef SC_RDK
#undef SC_UPD
#undef SC_FRAG
}
template <int MODE>
__device__ __forceinline__ void scan_phase(LAS unsigned char* L, unsigned char* ws, bf16_t* og, int bh, int sub, int wave, int lane_) {
    const int lane = fresh_tid() & 63;
    const bf16_t* vT = (const bf16_t*)(ws + WS_VT);
    const int nsl = sub < 2 ? 6 : 5, slice = (sub < 2 ? 6 * sub : 12 + 5 * (sub - 2)) + wave, b = bh >> 2, h = bh & 3, l15 = lane & 15, g4 = lane >> 4; const bool comp = wave < nsl;
    const unsigned char* img = ws + WS_IMG + (size_t)bh * 64 * IMG_STRIDE + lane * 16;
#define SC_BARRIER() do { asm volatile("" ::: "memory"); __builtin_amdgcn_s_barrier(); asm volatile("" ::: "memory"); } while (0)
    if (!comp) { const int dw = wave - nsl, ndma = 8 - nsl;
#define SC_DMA(c, buf) do { for (int p = dw; p < SC_NP; p += ndma) \
        __builtin_amdgcn_global_load_lds((const unsigned*)(img + (size_t)(c) * IMG_STRIDE + p * 1024), (LAS unsigned*)(L + (buf) * SC_BUF + p * 1024), 16, 0, 0); } while (0)
        SC_DMA(0, 0); asm volatile("s_waitcnt vmcnt(0)" ::: "memory"); SC_BARRIER();
        for (int c = 0; c < 64; ++c) { if (c + 1 < 64 && (MODE != 1 || c < 1)) SC_DMA(c + 1, (c & 1) ^ 1); asm volatile("s_waitcnt vmcnt(0)" ::: "memory"); SC_BARRIER(); }
#undef SC_DMA
        return; }
    f32x4a S[16];
#pragma unroll
    for (int dt = 0; dt < 16; ++dt) S[dt] = (f32x4a){0.f, 0.f, 0.f, 0.f};
    const bf16_t* vbase = vT + ((size_t)bh * 64 * 512 + 16 * slice + l15) * 64 + 8 * g4;
    bf16x8 va0 = *(const bf16x8*)(vbase), va1 = *(const bf16x8*)(vbase + 32);
    { pg8::u32x4 t0 = __builtin_bit_cast(pg8::u32x4, va0), t1 = __builtin_bit_cast(pg8::u32x4, va1); asm volatile("" : "+v"(t0), "+v"(t1)); va0 = __builtin_bit_cast(bf16x8, t0); va1 = __builtin_bit_cast(bf16x8, t1); }
    SC_BARRIER();
    bf16_t* ogp = og + ((size_t)b * SEQ + l15) * DM + h * 512 + 16 * slice + 4 * g4;
    for (int c = 0; c < 64; c += 2) {
        bf16x8 vb0 = *(const bf16x8*)(vbase + (size_t)(c + 1) * 512 * 64), vb1 = *(const bf16x8*)(vbase + (size_t)(c + 1) * 512 * 64 + 32);
        scan_chunk<MODE>(L, S, va0, va1, c, ogp, lane, g4);
        SC_BARRIER();
        { const int cn = c + 2 < 64 ? c + 2 : 63; va0 = *(const bf16x8*)(vbase + (size_t)cn * 512 * 64); va1 = *(const bf16x8*)(vbase + (size_t)cn * 512 * 64 + 32); }
        scan_chunk<MODE>(L, S, vb0, vb1, c + 1, ogp, lane, g4);
        SC_BARRIER();
    }
#undef SC_BARRIER
}
}
#ifndef EXTRA_BARRIERS
#define EXTRA_BARRIERS 0
#endif
#ifndef STAMP_Q
#define STAMP_Q 10.f
#endif
#ifndef DBG_STAMP
#define DBG_STAMP 0
#endif
#ifndef REP0_PART
#define REP0_PART 0
#endif
#ifndef REP5_ROLE
#define REP5_ROLE 0
#endif
#ifndef REPEAT_MASK
#define REPEAT_MASK 0u
#endif
#ifndef SCAN_DIAG
#define SCAN_DIAG 0
#endif
#ifndef DBG_SCAN
#define DBG_SCAN 0
#endif
#if DBG_SCAN
#define DBG_SCAN_OUT ((bf16_t*)(ws + WS_Q))
#else
#define DBG_SCAN_OUT og
#endif
constexpr size_t WS_HLAST = 1 * MiB + 512 * 1024, WS_HFIRST = 4 * MiB;
constexpr size_t WS_RX = 7 * MiB;
constexpr int CW_RX = 24576;
constexpr int WUP_EARLY = 1792, WUP_SCAN = 384;
constexpr size_t WS_WUP = 376 * MiB, WS_WDN = 134 * MiB;
__global__ void __launch_bounds__(NWAVES * 64, 2) mk_fwd(Args args) {
    extern __shared__ __attribute__((aligned(16))) unsigned char lds[];
    LAS unsigned char* L = (LAS unsigned char*)lds;
    volatile LAS unsigned* MISC = (volatile LAS unsigned*)(L + MISC_OFF);
    const int tid = threadIdx.x, wave = __builtin_amdgcn_readfirstlane(tid >> 6);
#define FL (fresh_tid() & 63)
#define STAMPP_BEGIN(ph) unsigned long long tsp_##ph = 0; if (DBG_STAMP == 10 + (ph) && bx == 0) tsp_##ph = __builtin_amdgcn_s_memrealtime();
#define STAMPP_END(ph) do { if (DBG_STAMP == 10 + (ph) && bx == 0) { __syncthreads(); if (threadIdx.x == 0) { const float us_ = STAMP_Q * (float)(int)((float)(__builtin_amdgcn_s_memrealtime() - tsp_##ph) * 0.01f / STAMP_Q + 0.5f); __hip_atomic_store((unsigned*)(ctl + 512), __float_as_uint(us_), RLX_AGENT); } } } while (0)
#define STAMP_BEGIN(id, cond) unsigned long long ts_##id = 0; if (DBG_STAMP == (id) && (cond)) ts_##id = __builtin_amdgcn_s_memrealtime();
#define STAMP_END(id, cond) do { if (DBG_STAMP == (id) && (cond)) { __syncthreads(); if (threadIdx.x == 0) { const float us_ = STAMP_Q * (float)(int)((float)(__builtin_amdgcn_s_memrealtime() - ts_##id) * 0.01f / STAMP_Q + 0.5f);     __hip_atomic_store((unsigned*)(ctl + 512), __float_as_uint(us_), RLX_AGENT); } } } while (0)
    const int G = gridDim.x, bx = blockIdx.x; const int vcu = (G % 8 == 0) ? (bx % 8) * (G / 8) + bx / 8 : bx;
    const int gw = vcu * NWAVES + wave, NGW = G * NWAVES;
    unsigned char* ws = args.ws;
    gu32* ctl = (gu32*)(ws + WS_CTL);
    for (int u = tid; u < (LDS_BYTES - LDSCTL_OFF) / 4; u += NWAVES * 64) ((LAS unsigned*)(L + LDSCTL_OFF))[u] = 0u;
    __syncthreads();
    XcdBarrier bar = xcd_barrier_post((unsigned*)(ctl + CW_BAR), MISC + 8);
    const int lo = args.ph_lo, hi = args.ph_hi;
#define IN(k) (lo <= (k) && (k) < hi)
#define SEAM(k) do { if (IN(k) && IN((k) + 1)) { unsigned long long tb_ = 0; if (DBG_STAMP == 40 + (k) && bx == 0) tb_ = __builtin_amdgcn_s_memrealtime(); xcd_barrier(bar); \
        if (DBG_STAMP == 40 + (k) && bx == 0 && threadIdx.x == 0) { const float us_ = STAMP_Q * (float)(int)((float)(__builtin_amdgcn_s_memrealtime() - tb_) * 0.01f / STAMP_Q + 0.5f); __hip_atomic_store((unsigned*)(ctl + 512), __float_as_uint(us_), RLX_AGENT); } } } while (0)
    const float* x = (const float*)args.in[0]; float* out = args.out;
    float* mod = (float*)(ws + WS_MOD); float2* cs = (float2*)(ws + WS_CS);
    float* statq = (float*)(ws + WS_RSTD); float* statkv = statq + MTOK * 8;
    bf16_t* hbuf = (bf16_t*)(ws + WS_H); bf16_t* zA = (bf16_t*)(ws + WS_ZA); bf16_t* zB = (bf16_t*)(ws + WS_ZB);
    bf16_t* Win_t = (bf16_t*)(ws + WS_WIN); bf16_t* Wq_t = (bf16_t*)(ws + WS_WQ); bf16_t* Wkv_t = (bf16_t*)(ws + WS_WKV);
    bf16_t* Wa_t = (bf16_t*)(ws + WS_WA); bf16_t* Wb_t = (bf16_t*)(ws + WS_WB); bf16_t* Wmix_t = (bf16_t*)(ws + WS_WMIX);
    bf16_t* Wup_t = (bf16_t*)(ws + WS_WUP); bf16_t* Wdn_t = (bf16_t*)(ws + WS_WDN);
    bf16_t* Q = (bf16_t*)(ws + WS_Q); bf16_t* Kf = (bf16_t*)(ws + WS_K); bf16_t* V = (bf16_t*)(ws + WS_V);
    bf16_t* om = (bf16_t*)(ws + WS_OM); bf16_t* og = (bf16_t*)(ws + WS_OG); bf16_t* t1 = (bf16_t*)(ws + WS_T1); bf16_t* merged = (bf16_t*)(ws + WS_MERGED);
    bf16_t* y = (bf16_t*)(ws + WS_Y); bf16_t* h2 = (bf16_t*)(ws + WS_H); bf16_t* act = (bf16_t*)(ws + WS_ACT_N); bf16_t* f = (bf16_t*)(ws + WS_F); bf16_t* x1b = (bf16_t*)(ws + WS_F);

    STAMPP_BEGIN(0);
    for (int rep_ = 0; rep_ < 1 + (int)((REPEAT_MASK >> 0) & 1u); ++rep_) if (IN(0)) { const int lane = FL;
        if (rep_ == 0 || REP0_PART == 1) p0_ada((const float*)args.in[1], (const float*)args.in[3], (const float*)args.in[4], mod, (LAS float*)L, vcu, wave, FL);
        LAS float* scr = (LAS float*)(L + wave * 16640);
        int cursor = 0;
        if (rep_ == 0 || REP0_PART == 3) tr_matrix((const float*)args.in[6], DM, DIN, LDZ, Win_t, scr, cursor, gw, NGW, lane, ScIn{}, nullptr, 1.f);
    }
    STAMPP_END(0); SEAM(0);
    STAMPP_BEGIN(1);
    for (int rep_ = 0; rep_ < 1 + (int)((REPEAT_MASK >> 1) & 1u); ++rep_) if (IN(1)) {
        const float* g = (const float*)args.in[5]; const int lane = FL;
        f32x4 v[8], vn[8];
        int m = gw; if (m < MTOK) {
#pragma unroll
            for (int j = 0; j < 8; ++j) v[j] = __builtin_nontemporal_load((const f32x4*)(x + (size_t)m * DM) + lane + 64 * j); }
        for (; m < MTOK; m += NGW) { const int b = m / SEQ, mn = m + NGW;
            if (mn < MTOK) {
#pragma unroll
                for (int j = 0; j < 8; ++j) vn[j] = __builtin_nontemporal_load((const f32x4*)(x + (size_t)mn * DM) + lane + 64 * j); }
            float s = 0.f;
#pragma unroll
            for (int j = 0; j < 8; ++j) s += (v[j].x * v[j].x + v[j].y * v[j].y) + (v[j].z * v[j].z + v[j].w * v[j].w);
            const float rstd = rsqrtf(wave_sum(s) * (1.f / DM) + EPSN);
            const f32x4* gp = (const f32x4*)g + lane; const f32x4* shp = (const f32x4*)(mod + b * 12288) + lane; const f32x4* scp = (const f32x4*)(mod + b * 12288 + 2048) + lane;
            unsigned long long* o8 = (unsigned long long*)(hbuf + (size_t)m * DM) + lane;
#pragma unroll
            for (int j = 0; j < 8; ++j) { const f32x4 r = v[j] * rstd * gp[64 * j] * (1.f + scp[64 * j]) + shp[64 * j];
                o8[64 * j] = (unsigned long long)pk2(r.x, r.y) | ((unsigned long long)pk2(r.z, r.w) << 32); }
#pragma unroll
            for (int j = 0; j < 8; ++j) v[j] = vn[j]; }
    }
    STAMPP_END(1); SEAM(1);
    STAMPP_BEGIN(2);
    for (int rep_ = 0; rep_ < 1 + (int)((REPEAT_MASK >> 2) & 1u); ++rep_) if (IN(2)) {
        pg8::Gemm g{hbuf, Win_t, MTOK, LDZ, DM, DM}; pg8::StaticOrder S; S.init(MTOK, LDZ, G, bx);
        pg8::EpiZ E{zA, zB, statq, statkv};
        pg8::gemm_phase<pg8::EpiZ, pg8::StaticOrder, true, true>(L, g, S, E);
        if (rep_ == 0 && G == 256 && bx >= 128) { const int lane = FL, sgw = (bx - 128) * NWAVES + wave, SNGW = 128 * NWAVES; LAS float* scr = (LAS float*)(L + wave * 16640); int cursor = 0;
            p0_cs((const int*)args.in[2], cs, sgw, SNGW, lane);
            tr_matrix((const float*)args.in[8], 512, 1536, 1536, Wq_t, scr, cursor, sgw, SNGW, lane, ScQ{}, (const float*)args.in[7], QK_C2);
            tr_matrix((const float*)args.in[10], 256, 2048, 2048, Wkv_t, scr, cursor, sgw, SNGW, lane, ScNat{2048}, (const float*)args.in[9], 1.f);
            tr_matrix((const float*)args.in[14], 1024, DM, DM, Wa_t, scr, cursor, sgw, SNGW, lane, ScNat{DM}, nullptr, 1.f);
            tr_matrix((const float*)args.in[15], DM, DM, DM, Wb_t, scr, cursor, sgw, SNGW, lane, ScNat{DM}, nullptr, 1.f);
            tr_matrix((const float*)args.in[16], DM, DM, DM, Wmix_t, scr, cursor, sgw, SNGW, lane, ScNat{DM}, nullptr, 1.f);
            tr_matrix((const float*)args.in[19], DM, DFF2, DFF2, Wup_t, scr, cursor, sgw, SNGW, lane, ScUp{}, nullptr, 1.f, 0, WUP_EARLY); }
    }
    STAMPP_END(2); SEAM(2);
    STAMPP_BEGIN(3);
    for (int rep_ = 0; rep_ < 1 + (int)((REPEAT_MASK >> 3) & 1u); ++rep_) if (IN(3)) {
        { pg8::Gemm g{zB + OFF_QLAT, Wq_t, MTOK, 1536, 512, ZB_LD}; pg8::StaticOrder S; S.init(MTOK, 1536, G, bx);
          pg8::EpiQo E{Q, statq, cs}; pg8::gemm_phase<pg8::EpiQo, pg8::StaticOrder, true, true>(L, g, S, E); }
        { pg8::Gemm g{zB + OFF_KVLAT, Wkv_t, MTOK, 2048, 256, ZB_LD}; pg8::StaticOrder S; S.init(MTOK, 2048, G, bx);
          pg8::EpiKVo E{Kf, V, statkv}; pg8::gemm_phase<pg8::EpiKVo, pg8::StaticOrder, true, true>(L, g, S, E); }
        ph_kpe(zB, Kf, cs, gw, NGW, FL);
    }
    STAMPP_END(3);
    STAMPP_BEGIN(4);
    for (int rep_ = 0; rep_ < 1 + (int)((REPEAT_MASK >> 4) & 1u); ++rep_) if (IN(4)) gla::prep_phase(L, zB, (const float*)args.in[11], (const float*)args.in[12], ws, vcu, G, wave, FL);
    STAMPP_END(4); SEAM(4);
    STAMPP_BEGIN(5);
    for (int rep_ = 0; rep_ < 1 + (int)((REPEAT_MASK >> 5) & 1u); ++rep_) if (IN(5)) {
        const int xg = vcu >> 5, jj = vcu & 31;
        if (G != 256) {   }
        else if (jj < 6) {
#if SCAN_DIAG
            { STAMP_BEGIN(4, vcu == 0) gla::scan_phase<SCAN_DIAG>(L, ws, DBG_SCAN_OUT, xg, jj, wave, FL); STAMP_END(4, vcu == 0); __syncthreads(); }
#endif
            STAMP_BEGIN(2, vcu == 0) if (rep_ == 0 || REP5_ROLE != 2) gla::scan_phase<0>(L, ws, DBG_SCAN_OUT, xg, jj, wave, FL); STAMP_END(2, vcu == 0);
            if (rep_ == 0) { __syncthreads(); const int lane = FL, sgw = (xg * 6 + jj) * NWAVES + wave, SNGW = 48 * NWAVES; LAS float* scr = (LAS float*)(L + wave * 16640); int cursor = 0;
                tr_matrix((const float*)args.in[19], DM, DFF2, DFF2, Wup_t, scr, cursor, sgw, SNGW, lane, ScUp{}, nullptr, 1.f, WUP_EARLY, WUP_EARLY + WUP_SCAN); } }
        else { STAMP_BEGIN(1, vcu == 6) STAMP_BEGIN(3, vcu == 6) if (rep_ == 0 || REP5_ROLE != 1) att::phase(L, Q, Kf, V, om, ws, 2 * xg + (jj - 6) / 13, (jj - 6) % 13, wave, FL); STAMP_END(1, vcu == 6);
            if (rep_ == 0) { const int lane = FL, agw = (xg * 26 + (jj - 6)) * NWAVES + wave, ANGW = 208 * NWAVES; LAS float* scr = (LAS float*)(L + wave * 16640); int cursor = 0;
                tr_matrix((const float*)args.in[19], DM, DFF2, DFF2, Wup_t, scr, cursor, agw, ANGW, lane, ScUp{}, nullptr, 1.f, WUP_EARLY + WUP_SCAN, 0x7fffffff); }
            STAMP_END(3, vcu == 6); }
    }
    STAMPP_END(5); SEAM(5);
    STAMPP_BEGIN(7);
    for (int rep_ = 0; rep_ < 1 + (int)((REPEAT_MASK >> 7) & 1u); ++rep_) if (IN(7)) { att::combine(om, ws, gw, NGW, FL); ph_glanorm(og, zA, (const float*)args.in[13], gw, NGW, FL); }
    STAMPP_END(7); SEAM(7);
    STAMPP_BEGIN(8);
    for (int rep_ = 0; rep_ < 1 + (int)((REPEAT_MASK >> 8) & 1u); ++rep_) if (IN(8)) {
        { pg8::Gemm g{om, Wa_t, MTOK, DM, 1024, 1024}; pg8::StaticOrder S; S.init(MTOK, DM, G, bx);
          pg8::EpiGateo E{t1, zA, OFF_GA, nullptr}; pg8::gemm_phase<pg8::EpiGateo, pg8::StaticOrder, true, true>(L, g, S, E); }
        { pg8::Gemm g{og, Wb_t, MTOK, DM, DM, DM}; pg8::StaticOrder S; S.init(MTOK, DM, G, bx);
          pg8::EpiGateo E{merged, zA, OFF_GB, t1}; pg8::gemm_phase<pg8::EpiGateo, pg8::StaticOrder, true, true>(L, g, S, E); }
    }
    STAMPP_END(8); SEAM(8);
    for (int xb_ = 0; xb_ < EXTRA_BARRIERS; ++xb_) xcd_barrier(bar);
    STAMPP_BEGIN(9);
    for (int rep_ = 0; rep_ < 1 + (int)((REPEAT_MASK >> 9) & 1u); ++rep_) if (IN(9) && G == 256) { pg8::Gemm g{merged, Wmix_t, MTOK, DM, DM, DM}; pg8::StaticOrder S; S.init(MTOK, DM, G, bx);
        pg8::Unit u0; (void)S.next(0, u0); float* rx = (float*)(ws + WS_RX); unsigned* cw = (unsigned*)(ctl + CW_RX); unsigned* bw = (unsigned*)(ctl + CW_BAR);
        pg8::EpiResMid E{x, mod, (const float*)args.in[17], (const float*)args.in[18], x1b, h2, pg8::RowX{rx, cw + (rep_ * 96 + u0.pm) * 64, bw}, pg8::RowX{rx + MTOK * 8, cw + (rep_ * 96 + 32 + u0.pm) * 64, bw}};
        pg8::gemm_phase<pg8::EpiResMid, pg8::StaticOrder, true, true>(L, g, S, E); }
    STAMPP_END(9); SEAM(9);
    STAMPP_BEGIN(12);
    for (int rep_ = 0; rep_ < 1 + (int)((REPEAT_MASK >> 12) & 1u); ++rep_) if (IN(12)) { pg8::Gemm g{h2, Wup_t, MTOK, DFF2, DM, DM}; pg8::StaticOrder S; S.init(MTOK, DFF2, G, bx);
        pg8::EpiConv E{act, (const float*)args.in[20], (const float*)args.in[21], (bf16_t*)(ws + WS_HLAST), (float*)(ws + WS_HFIRST), (LAS float*)(L + RING_BYTES)};
        pg8::gemm_phase<pg8::EpiConv, pg8::StaticOrder, true, true>(L, g, S, E);
        if (rep_ == 0 && G == 256 && bx >= 128) { const int lane = FL, sgw = (bx - 128) * NWAVES + wave, SNGW = 128 * NWAVES; LAS float* scr = (LAS float*)(L + wave * 16640); int cursor = 0;
            tr_matrix((const float*)args.in[22], DFF, DM, DM, Wdn_t, scr, cursor, sgw, SNGW, lane, ScNat{DM}, nullptr, 1.f); } }
    STAMPP_END(12); SEAM(12);
    STAMPP_BEGIN(14);
    for (int rep_ = 0; rep_ < 1 + (int)((REPEAT_MASK >> 14) & 1u); ++rep_) if (IN(14) && G == 256) { pg8::Gemm g{act, Wdn_t, MTOK, DM, DFF, DFF}; pg8::StaticOrder S; S.init(MTOK, DM, G, bx);
        { pg8::Unit u0; for (int i = 0; S.next(i, u0); ++i) ph_convfix((const bf16_t*)(ws + WS_HLAST), (const float*)(ws + WS_HFIRST), (const float*)args.in[20], act, u0.pm, wave, FL);
          VM_WAIT(); __syncthreads(); }
        pg8::Unit u1; (void)S.next(0, u1); const float osc = 1.f;
        pg8::EpiResOut E{x1b, mod + 10240, (const float*)args.in[23], out, pg8::RowX{(float*)(ws + WS_RX) + 2 * MTOK * 8, (unsigned*)(ctl + CW_RX) + (rep_ * 96 + 64 + u1.pm) * 64, (unsigned*)(ctl + CW_BAR)}, osc};
        pg8::gemm_phase<pg8::EpiResOut, pg8::StaticOrder, true, true>(L, g, S, E); }
    STAMPP_END(14);
#if DBG_STAMP
    xcd_barrier(bar);
    { const float sc_ = 1.f + 1e-3f * (40.f + __uint_as_float(__hip_atomic_load((unsigned*)(ctl + 512), RLX_AGENT)));     const int lane = FL;
      for (size_t i = (size_t)gw * 64 + lane; i < (size_t)MTOK * DM / 4; i += (size_t)NGW * 64) ((f32x4*)out)[i] *= sc_; }
#endif
#undef IN
#undef SEAM
#undef FL
}

#ifndef OPT_MASK
#define OPT_MASK 0xFFFFu
#endif
static int mk_grid = 0;
static void launch_mk(void* const* d_in, float* out, void* ws, int lo, int hi, hipStream_t stream) {
    if (mk_grid == 0) {
        int dev = 0, cus = 0, per_cu = 0;
        (void)hipGetDevice(&dev); (void)hipDeviceGetAttribute(&cus, hipDeviceAttributeMultiprocessorCount, dev);
        (void)hipFuncSetAttribute((const void*)mk_fwd, hipFuncAttributeMaxDynamicSharedMemorySize, LDS_BYTES);
        (void)hipOccupancyMaxActiveBlocksPerMultiprocessor(&per_cu, (const void*)mk_fwd, NWAVES * 64, LDS_BYTES);
        if (per_cu < 1) { fprintf(stderr, "occupancy query says %d blocks/CU\n", per_cu); per_cu = 1; }
        if (per_cu > 1) per_cu = 1;
        mk_grid = cus * per_cu; (void)hipGetLastError();
    }
    (void)hipMemsetAsync((char*)ws + WS_CTL, 0, 1 * MiB, stream);
    Args a{}; for (int i = 0; i < 24; ++i) a.in[i] = d_in[i]; a.out = out; a.ws = (unsigned char*)ws; a.ph_lo = lo; a.ph_hi = hi;
    void* kargs[] = {&a};
#ifndef MK_COOP
#define MK_COOP 1
#endif
#if MK_COOP
    hipError_t e = hipLaunchCooperativeKernel((const void*)mk_fwd, dim3(mk_grid), dim3(NWAVES * 64), kargs, LDS_BYTES, stream);
#else
    (void)kargs; hipLaunchKernelGGL(mk_fwd, dim3(mk_grid), dim3(NWAVES * 64), LDS_BYTES, stream, a); hipError_t e = hipPeekAtLastError();
#endif
    if (e != hipSuccess) fprintf(stderr, "megakernel launch failed: %s (grid %d)\n", hipGetErrorString(e), mk_grid);
}
extern "C" void kernel_launch(void* const* d_in, const int* in_sizes, int n_in, void* d_out, int out_size, void* d_ws, size_t ws_size, hipStream_t stream) {
    const float* x = (const float*)d_in[0]; const float* c = (const float*)d_in[1]; const int* pos = (const int*)d_in[2];
    const float* w_ada = (const float*)d_in[3]; const float* b_ada = (const float*)d_in[4]; const float* g_pre_mix = (const float*)d_in[5];
    const float* w_in = (const float*)d_in[6]; const float* g_q = (const float*)d_in[7]; const float* w_q_up = (const float*)d_in[8];
    const float* g_kv = (const float*)d_in[9]; const float* w_kv_up = (const float*)d_in[10]; const float* w_gate = (const float*)d_in[11];
    const float* b_gate = (const float*)d_in[12]; const float* g_gla = (const float*)d_in[13]; const float* w_a = (const float*)d_in[14];
    const float* w_b = (const float*)d_in[15]; const float* w_mix = (const float*)d_in[16]; const float* g_post_mix = (const float*)d_in[17];
    const float* g_pre_ffn = (const float*)d_in[18]; const float* w_up = (const float*)d_in[19]; const float* conv_w = (const float*)d_in[20];
    const float* conv_b = (const float*)d_in[21]; const float* w_dn = (const float*)d_in[22]; const float* g_post_ffn = (const float*)d_in[23];
    float* out = (float*)d_out; char* ws = (char*)d_ws;
    if (ws_size < 420 * MiB) { fprintf(stderr, "ws too small: %zu\n", ws_size); return; }
    float* mod = (float*)(ws + WS_MOD); float* rstd = (float*)(ws + WS_RSTD); float2* cs = (float2*)(ws + WS_CS);
    bf16_t* h = (bf16_t*)(ws + WS_H); bf16_t* zA = (bf16_t*)(ws + WS_ZA); bf16_t* z = (bf16_t*)(ws + WS_ZB);   bf16_t* Q = (bf16_t*)(ws + WS_Q); bf16_t* Kf = (bf16_t*)(ws + WS_K); bf16_t* V = (bf16_t*)(ws + WS_V);
    bf16_t* om = (bf16_t*)(ws + WS_OM); bf16_t* og = (bf16_t*)(ws + WS_OG); bf16_t* t1 = (bf16_t*)(ws + WS_T1); bf16_t* merged = (bf16_t*)(ws + WS_MERGED);
    bf16_t* y = (bf16_t*)(ws + WS_Y); bf16_t* h2 = (bf16_t*)(ws + WS_H); bf16_t* act = (bf16_t*)(ws + WS_ACT_N); bf16_t* uq = (bf16_t*)(ws + WS_UQ); bf16_t* f = (bf16_t*)(ws + WS_F);
    int pend_lo = -1, pend_hi = -1;
#define FLUSH() do { if (pend_lo >= 0) { launch_mk(d_in, out, d_ws, pend_lo, pend_hi, stream); pend_lo = -1; } } while (0)
#ifndef MK_SPLIT
#define MK_SPLIT 0
#endif
#define PHASE(p, ...) do { if ((OPT_MASK >> (p)) & 1u) { if (pend_lo >= 0 && (pend_hi != (p) || MK_SPLIT)) FLUSH(); if (pend_lo < 0) pend_lo = (p); pend_hi = (p) + 1; } else { FLUSH(); __VA_ARGS__ } } while (0)
    PHASE(0, { n_mod<<<12288 / 256, 256, 0, stream>>>(c, w_ada, b_ada, mod);
        n_cs<<<MTOK * 32 / 256, 256, 0, stream>>>(pos, cs); });
    PHASE(1, { n_normmod<<<MTOK, 256, 0, stream>>>(x, g_pre_mix, mod, 0, 2048, h); });
    PHASE(2, { n_gemm<EpiStore><<<dim3((DIN + 63) / 64, MTOK / 64), 256, 0, stream>>>(h, DM, w_in, DIN, nullptr, 0, MTOK, DIN, DM, EpiStore{z, ZB_LD, 0});   });
    PHASE(3, { n_latrstd<<<MTOK / 4, 256, 0, stream>>>(z, rstd);
        n_gemm<EpiQ><<<dim3(1536 / 64, MTOK / 64), 256, 0, stream>>>(z + OFF_QLAT, ZB_LD, w_q_up, 1536, g_q, 0, MTOK, 1536, 512, EpiQ{Q, rstd});
        n_rope_q<<<MTOK, 256, 0, stream>>>(Q, cs);
        n_gemm<EpiKV><<<dim3(2048 / 64, MTOK / 64), 256, 0, stream>>>(z + OFF_KVLAT, ZB_LD, w_kv_up, 2048, g_kv, 0, MTOK, 2048, 256, EpiKV{Kf, V, rstd});
        n_rope_k<<<MTOK * 32 / 256, 256, 0, stream>>>(z, Kf, cs); });
    PHASE(4, {  });
    PHASE(5, { n_attn<<<NB * 8 * SEQ, 256, 0, stream>>>(Q, Kf, V, om); });
    PHASE(6, { n_gla<<<64, 256, 0, stream>>>(z, w_gate, b_gate, og); });
#if DBG_SCAN
    FLUSH(); n_gla<<<64, 256, 0, stream>>>(z, w_gate, b_gate, og);
    (void)hipMemsetAsync(ws + WS_MOD + 256 * 1024, 0, 64, stream);
    { unsigned* res = (unsigned*)(ws + WS_MOD + 256 * 1024);
      n_countnf<<<1024, 256, 0, stream>>>(ws + 32 * MiB, (size_t)MTOK * 1024, 0, res + 0);
      n_countnf<<<1024, 256, 0, stream>>>(ws + 48 * MiB, (size_t)MTOK * 1024, 0, res + 1);
      n_countnf<<<1024, 256, 0, stream>>>(ws + 64 * MiB, (size_t)512 * 4096, 0, res + 2);
      n_countnf<<<1024, 256, 0, stream>>>(ws + 68 * MiB, (size_t)512 * 256, 1, res + 3);
      n_countnf<<<1024, 256, 0, stream>>>(ws + 252 * MiB, (size_t)MTOK * 2048, 0, res + 4); }
#endif
    PHASE(7, { n_glanorm<<<MTOK, 256, 0, stream>>>(og, zA, g_gla); });
    PHASE(8, { n_gemm<EpiGate><<<dim3(DM / 64, MTOK / 64), 256, 0, stream>>>(om, 1024, w_a, DM, nullptr, 0, MTOK, DM, 1024, EpiGate{t1, zA, OFF_GA, nullptr});
        n_gemm<EpiGate><<<dim3(DM / 64, MTOK / 64), 256, 0, stream>>>(og, DM, w_b, DM, nullptr, 0, MTOK, DM, DM, EpiGate{merged, zA, OFF_GB, t1}); });
    PHASE(9, { n_gemm<EpiStore><<<dim3(DM / 64, MTOK / 64), 256, 0, stream>>>(merged, DM, w_mix, DM, nullptr, 0, MTOK, DM, DM, EpiStore{y, DM, 0}); });
    PHASE(10, { n_resnorm<<<MTOK, 256, 0, stream>>>(x, y, g_post_mix, mod, 4096, out, g_pre_ffn, 6144, 8192, h2); });
    PHASE(11, {  });
    PHASE(12, { for (int q = 0; q < 4; ++q) { const int q0 = q * 2048, r0 = (q0 % SEQ == 0) ? q0 : q0 - 2, r1 = q0 + 2048;
            n_gemm<EpiStore><<<dim3(DFF2 / 64, (r1 - r0 + 63) / 64), 256, 0, stream>>>(h2, DM, w_up, DFF2, nullptr, r0, r1, DFF2, DM, EpiStore{uq, DFF2, r0});
            n_convact<<<dim3(DFF / 256, 2048), 256, 0, stream>>>(uq, r0, q0, conv_w, conv_b, act); } });
    PHASE(13, {  });
    PHASE(14, { n_gemm<EpiStore><<<dim3(DM / 64, MTOK / 64), 256, 0, stream>>>(act, DFF, w_dn, DM, nullptr, 0, MTOK, DM, DFF, EpiStore{f, DM, 0}); });
    PHASE(15, { n_resnorm<<<MTOK, 256, 0, stream>>>(out, f, g_post_ffn, mod, 10240, out, nullptr, 0, 0, nullptr); });
    FLUSH();
#if DBG_SCAN
    n_scale_bits<<<1024, 256, 0, stream>>>(out, (size_t)MTOK * DM, (const unsigned*)(ws + WS_MOD + 256 * 1024), 5);
#endif
}
```

```cpp
#include <hip/hip_runtime.h>
#include <hip/hip_bf16.h>
#include <cstdint>
#include <cstdio>

typedef unsigned short bf16_t;
constexpr int NB = 2, SEQ = 4096, DM = 2048, MTOK = NB * SEQ;
constexpr int DIN = 11088, LDZ = 11264, ZA_LD = 6144, ZB_LD = 5120;
constexpr int OFF_QLAT = 0, OFF_KVLAT = 512, OFF_KROPE = 768, OFF_GQ = 832, OFF_GK = 1856, OFF_GV = 2880, OFF_GLR = 4928  , OFF_GOG = 0, OFF_GA = 2048, OFF_GB = 4096  ;
constexpr int DFF = 5632, DFF2 = 11264;
constexpr float EPSN = 1e-6f;
constexpr float QK_C2 = 0.07216878364870322f * 1.4426950408889634f;
constexpr size_t MiB = 1u << 20;
constexpr size_t WS_CTL = 0, WS_MOD = 1 * MiB, WS_RSTD = 1 * MiB + 512 * 1024, WS_CS = 2 * MiB, WS_PART = 4 * MiB;
constexpr size_t WS_WQ = 8 * MiB, WS_WKV = 10 * MiB, WS_WA = 12 * MiB, WS_WB = 16 * MiB, WS_WMIX = 24 * MiB;
constexpr size_t WS_WIN = 32 * MiB, WS_ZB = 76 * MiB, WS_ZA = 156 * MiB, WS_H = 252 * MiB, WS_Q = 284 * MiB, WS_K = 308 * MiB, WS_V = 332 * MiB, WS_OM = 348 * MiB, WS_OG = 76 * MiB  , WS_MISC = 396 * MiB;
constexpr size_t WS_MERGED = WS_WIN, WS_Y = 284 * MiB, WS_ACT_N = 284 * MiB  , WS_UQ = 196 * MiB  , WS_F = 196 * MiB, WS_T1 = WS_H;

__device__ __forceinline__ int fresh_tid() { int t = threadIdx.x; asm volatile("" : "+v"(t)); return t; }
__device__ __forceinline__ float bf2f(bf16_t v) { return __uint_as_float(((unsigned)v) << 16); }
__device__ __forceinline__ bf16_t f2bf(float f) { unsigned u = __float_as_uint(f); return (bf16_t)((u + 0x7fffu + ((u >> 16) & 1u)) >> 16); }
__device__ __forceinline__ float sigmoidf_(float x) { return 1.f / (1.f + __expf(-x)); }
__device__ __forceinline__ float siluf_(float x) { return x / (1.f + __expf(-x)); }
__device__ __forceinline__ float gelu_tanh(float a) { const float u = 0.7978845608028654f * (a + 0.044715f * a * a * a); return 0.5f * a * (1.f + tanhf(u)); }
__device__ __forceinline__ int rope_pos(int d) { return d < 32 ? (8 * (d >> 2) + (d & 3)) : (8 * ((d - 32) >> 2) + 4 + (d & 3)); }

__device__ __forceinline__ float block_sum256(float v, float* red) {
#pragma unroll
    for (int o = 32; o > 0; o >>= 1) v += __shfl_xor(v, o);
    __syncthreads();
    if ((threadIdx.x & 63) == 0) red[threadIdx.x >> 6] = v;
    __syncthreads();
    return red[0] + red[1] + red[2] + red[3];
}


__global__ void __launch_bounds__(256) n_cmp(const bf16_t* t, const bf16_t* r, size_t n, unsigned* res) {
    unsigned nf = 0; float md = 0.f, mr = 0.f;
    for (size_t i = (size_t)blockIdx.x * 256 + threadIdx.x; i < n; i += (size_t)gridDim.x * 256) { const float a = bf2f(t[i]), b = bf2f(r[i]);
        if (!(fabsf(a) < 1e30f)) { ++nf; } else md = fmaxf(md, fabsf(a - b)); mr = fmaxf(mr, fabsf(b)); }
    if (nf) atomicAdd(res, nf); atomicMax(res + 1, __float_as_uint(md)); atomicMax(res + 2, __float_as_uint(mr));
}
__global__ void n_scale(float* out, size_t n, const unsigned* res) {
    const float md = __uint_as_float(res[1]), mr = __uint_as_float(res[2]); const float rel = md / fmaxf(mr, 1e-20f);
    int code = rel < 1e-2f ? 0 : rel < 3e-2f ? 1 : rel < 0.1f ? 2 : rel < 0.3f ? 3 : rel < 1.f ? 4 : 5; if (res[0]) code = 6 + (res[0] > 1000u) + (res[0] > 1000000u);
    const float f = 1.f + 0.1f * code;
    for (size_t i = (size_t)blockIdx.x * 256 + threadIdx.x; i < n; i += (size_t)gridDim.x * 256) out[i] *= f;
}

__global__ void __launch_bounds__(256) n_countnf(const void* p, size_t n, int isf32, unsigned* res) {
    unsigned nf = 0;
    for (size_t i = (size_t)blockIdx.x * 256 + threadIdx.x; i < n; i += (size_t)gridDim.x * 256) { const float a = isf32 ? ((const float*)p)[i] : bf2f(((const bf16_t*)p)[i]); if (!(fabsf(a) < 1e30f)) ++nf; }
    if (nf) atomicAdd(res, nf);
}
__global__ void n_scale_bits(float* out, size_t n, const unsigned* res, int nres) {
    int code = 0; for (int k = 0; k < nres; ++k) if (res[k]) code |= 1 << k;
    const float f = 1.f + 0.05f * code;
    for (size_t i = (size_t)blockIdx.x * 256 + threadIdx.x; i < n; i += (size_t)gridDim.x * 256) out[i] *= f;
}
__global__ void __launch_bounds__(256) n_mod(const float* c, const float* w_ada, const float* b_ada, float* mod) {
    __shared__ float ca[2][DM];
    for (int i = threadIdx.x; i < 2 * DM; i += 256) ca[i / DM][i % DM] = siluf_(c[i]);
    __syncthreads();
    const int j = blockIdx.x * 256 + threadIdx.x;
    float a0 = b_ada[j], a1 = a0;
    for (int k = 0; k < DM; ++k) { const float w = w_ada[(size_t)k * 12288 + j]; a0 += ca[0][k] * w; a1 += ca[1][k] * w; }
    mod[j] = a0; mod[12288 + j] = a1;
}
__global__ void __launch_bounds__(256) n_cs(const int* pos, float2* cs) {
    const int idx = blockIdx.x * 256 + threadIdx.x; const int m = idx >> 5, i = idx & 31;
    const float inv = 1.0f / powf(10000.0f, (float)(2 * i) / 64.0f);
    const float ang = (float)pos[m] * inv;
    float s, c; sincosf(ang, &s, &c); cs[idx] = make_float2(c, s);
}
__global__ void __launch_bounds__(256) n_normmod(const float* x, const float* g, const float* mod, int off_shift, int off_scale, bf16_t* h) {
    __shared__ float red[4];
    const int m = blockIdx.x, b = m / SEQ; const float* xr = x + (size_t)m * DM;
    float v[8], s = 0.f;
#pragma unroll
    for (int i = 0; i < 8; ++i) { v[i] = xr[threadIdx.x + i * 256]; s += v[i] * v[i]; }
    const float rstd = rsqrtf(block_sum256(s, red) / DM + EPSN);
#pragma unroll
    for (int i = 0; i < 8; ++i) { const int k = threadIdx.x + i * 256;
        h[(size_t)m * DM + k] = f2bf(v[i] * rstd * g[k] * (1.f + mod[b * 12288 + off_scale + k]) + mod[b * 12288 + off_shift + k]); }
}
template <class Epi>
__global__ void __launch_bounds__(256) n_gemm(const bf16_t* A, int lda, const float* W, int ldw, const float* ks, int M0, int M1, int N, int K, Epi epi) {
    __shared__ float As[16][68]; __shared__ float Ws[16][68];
    const int tx = threadIdx.x & 15, ty = threadIdx.x >> 4;
    const int m0 = M0 + blockIdx.y * 64, n0 = blockIdx.x * 64;
    float acc[4][4];
#pragma unroll
    for (int i = 0; i < 4; ++i)
#pragma unroll
        for (int j = 0; j < 4; ++j) acc[i][j] = 0.f;
    for (int k0 = 0; k0 < K; k0 += 16) {
#pragma unroll
        for (int i = 0; i < 4; ++i) { const int e = threadIdx.x + i * 256, r = e >> 4, kk = e & 15, m = m0 + r;
            float a = (m < M1) ? bf2f(A[(size_t)m * lda + k0 + kk]) : 0.f; if (ks) a *= ks[k0 + kk]; As[kk][r] = a; }
#pragma unroll
        for (int i = 0; i < 4; ++i) { const int e = threadIdx.x + i * 256, kk = e >> 6, cc = e & 63, n = n0 + cc;
            Ws[kk][cc] = (n < N) ? W[(size_t)(k0 + kk) * ldw + n] : 0.f; }
        __syncthreads();
#pragma unroll
        for (int kk = 0; kk < 16; ++kk) {
            float a[4], b[4];
#pragma unroll
            for (int i = 0; i < 4; ++i) { a[i] = As[kk][ty * 4 + i]; b[i] = Ws[kk][tx * 4 + i]; }
#pragma unroll
            for (int i = 0; i < 4; ++i)
#pragma unroll
                for (int j = 0; j < 4; ++j) acc[i][j] += a[i] * b[j];
        }
        __syncthreads();
    }
#pragma unroll
    for (int i = 0; i < 4; ++i)
#pragma unroll
        for (int j = 0; j < 4; ++j) { const int m = m0 + ty * 4 + i, n = n0 + tx * 4 + j; if (m < M1 && n < N) epi(m, n, acc[i][j]); }
}
struct EpiStore { bf16_t* C; int ldc; int row_off; __device__ void operator()(int m, int n, float v) const { C[(size_t)(m - row_off) * ldc + n] = f2bf(v); } };
struct EpiQ { bf16_t* Q; const float* rstd; __device__ void operator()(int m, int n, float v) const { Q[(size_t)m * 1536 + n] = f2bf(v * rstd[m]); } };
struct EpiKV { bf16_t* Kf; bf16_t* V; const float* rstd; __device__ void operator()(int m, int n, float v) const {
    const int h = n >> 8, w = n & 255; v *= rstd[MTOK + m];
    if (w < 128) Kf[(size_t)m * 1536 + h * 192 + w] = f2bf(v); else V[(size_t)m * 1024 + h * 128 + (w - 128)] = f2bf(v); } };
struct EpiGate { bf16_t* C; const bf16_t* z; int goff; const bf16_t* add; __device__ void operator()(int m, int n, float v) const {
    float r = v * sigmoidf_(bf2f(z[(size_t)m * ZA_LD + goff + n])); if (add) r += bf2f(add[(size_t)m * DM + n]); C[(size_t)m * DM + n] = f2bf(r); } };

__global__ void __launch_bounds__(256) n_latrstd(const bf16_t* z, float* rstd) {
    const int m = blockIdx.x * 4 + (threadIdx.x >> 6), lane = threadIdx.x & 63; const bf16_t* zr = z + (size_t)m * ZB_LD;
    float s = 0.f, s2 = 0.f;
    for (int i = lane; i < 512; i += 64) { const float v = bf2f(zr[i]); s += v * v; }
    for (int i = lane; i < 256; i += 64) { const float v = bf2f(zr[512 + i]); s2 += v * v; }
#pragma unroll
    for (int o = 32; o > 0; o >>= 1) { s += __shfl_xor(s, o); s2 += __shfl_xor(s2, o); }
    if (lane == 0) { rstd[m] = rsqrtf(s / 512.f + EPSN); rstd[MTOK + m] = rsqrtf(s2 / 256.f + EPSN); }
}
__global__ void __launch_bounds__(256) n_rope_q(bf16_t* Q, const float2* cs) {
    const int m = blockIdx.x, h = threadIdx.x >> 5, i = threadIdx.x & 31; bf16_t* q = Q + (size_t)m * 1536 + h * 192;
    const float x1 = bf2f(q[128 + i]), x2 = bf2f(q[160 + i]); const float2 c = cs[m * 32 + i];
    float nope[4];
#pragma unroll
    for (int j = 0; j < 4; ++j) nope[j] = bf2f(q[i * 4 + j]);
    __syncthreads();
    q[128 + rope_pos(i)] = f2bf((x1 * c.x - x2 * c.y) * QK_C2); q[128 + rope_pos(32 + i)] = f2bf((x2 * c.x + x1 * c.y) * QK_C2);
#pragma unroll
    for (int j = 0; j < 4; ++j) q[i * 4 + j] = f2bf(nope[j] * QK_C2);
}
__global__ void __launch_bounds__(256) n_rope_k(const bf16_t* z, bf16_t* Kf, const float2* cs) {
    const int idx = blockIdx.x * 256 + threadIdx.x, m = idx >> 5, i = idx & 31; const bf16_t* zr = z + (size_t)m * ZB_LD + OFF_KROPE;
    const float x1 = bf2f(zr[i]), x2 = bf2f(zr[32 + i]); const float2 c = cs[m * 32 + i];
    const bf16_t o1 = f2bf(x1 * c.x - x2 * c.y), o2 = f2bf(x2 * c.x + x1 * c.y);
#pragma unroll
    for (int h = 0; h < 8; ++h) { Kf[(size_t)m * 1536 + h * 192 + 128 + rope_pos(i)] = o1; Kf[(size_t)m * 1536 + h * 192 + 128 + rope_pos(32 + i)] = o2; }
}
__global__ void __launch_bounds__(256) n_attn(const bf16_t* Q, const bf16_t* Kf, const bf16_t* V, bf16_t* O) {
    __shared__ float qs[192]; __shared__ float p[SEQ]; __shared__ float red[4]; __shared__ float op[2][128];
    const int t = blockIdx.x % SEQ, h = (blockIdx.x / SEQ) % 8, b = blockIdx.x / (SEQ * 8); const size_t m = (size_t)b * SEQ + t;
    if (threadIdx.x < 192) qs[threadIdx.x] = bf2f(Q[m * 1536 + h * 192 + threadIdx.x]);
    __syncthreads();
    float mx = -1e30f;
    for (int j = threadIdx.x; j <= t; j += 256) { const bf16_t* kr = Kf + ((size_t)b * SEQ + j) * 1536 + h * 192; float s = 0.f;
        for (int d = 0; d < 192; ++d) s += qs[d] * bf2f(kr[d]);
        p[j] = s; mx = fmaxf(mx, s); }
#pragma unroll
    for (int o = 32; o > 0; o >>= 1) mx = fmaxf(mx, __shfl_xor(mx, o));
    if ((threadIdx.x & 63) == 0) red[threadIdx.x >> 6] = mx;
    __syncthreads();
    mx = fmaxf(fmaxf(red[0], red[1]), fmaxf(red[2], red[3]));
    float l = 0.f;
    for (int j = threadIdx.x; j <= t; j += 256) { const float e = exp2f(p[j] - mx); p[j] = e; l += e; }
    l = block_sum256(l, red);
    const int e = threadIdx.x & 127, g = threadIdx.x >> 7; float acc = 0.f;
    for (int j = g; j <= t; j += 2) acc += p[j] * bf2f(V[((size_t)b * SEQ + j) * 1024 + h * 128 + e]);
    op[g][e] = acc; __syncthreads();
    if (threadIdx.x < 128) O[m * 1024 + h * 128 + threadIdx.x] = f2bf((op[0][threadIdx.x] + op[1][threadIdx.x]) / l);
}
__global__ void __launch_bounds__(256) n_gla(const bf16_t* z, const float* wg, const float* bg, bf16_t* og) {
    constexpr int TS = 8;
    __shared__ float al[TS][256], kk[TS][256], qq[TS][256], vv[TS][64], opart[TS][4][64];
    const int bh = blockIdx.x >> 3, eb = blockIdx.x & 7, b = bh >> 2, h = bh & 3; const int e = threadIdx.x & 63, dg = threadIdx.x >> 6;
    float S[64];
#pragma unroll
    for (int i = 0; i < 64; ++i) S[i] = 0.f;
    for (int t0 = 0; t0 < SEQ; t0 += TS) {
        __syncthreads();
        for (int idx = threadIdx.x; idx < TS * 256; idx += 256) { const int tt = idx >> 8, d = idx & 255; const bf16_t* zr = z + ((size_t)b * SEQ + t0 + tt) * ZB_LD;
            float xg = bg[h * 256 + d];
#pragma unroll
            for (int r = 0; r < 16; ++r) xg += bf2f(zr[OFF_GLR + r]) * wg[r * 1024 + h * 256 + d];
            const float ls = fminf(xg, 0.f) - log1pf(__expf(-fabsf(xg)));
            al[tt][d] = __expf(ls * (1.f / 16.f));
            kk[tt][d] = bf2f(zr[OFF_GK + h * 256 + d]); qq[tt][d] = bf2f(zr[OFF_GQ + h * 256 + d]) * 0.0625f; }
        for (int idx = threadIdx.x; idx < TS * 64; idx += 256) { const int tt = idx >> 6, ee = idx & 63;
            vv[tt][ee] = bf2f(z[((size_t)b * SEQ + t0 + tt) * ZB_LD + OFF_GV + h * 512 + eb * 64 + ee]); }
        __syncthreads();
        for (int tt = 0; tt < TS; ++tt) { const float ve = vv[tt][e]; float o = 0.f;
#pragma unroll
            for (int i = 0; i < 64; ++i) { S[i] = al[tt][dg * 64 + i] * S[i] + kk[tt][dg * 64 + i] * ve; o += qq[tt][dg * 64 + i] * S[i]; }
            opart[tt][dg][e] = o; }
        __syncthreads();
        for (int idx = threadIdx.x; idx < TS * 64; idx += 256) { const int tt = idx >> 6, ee = idx & 63;
            og[((size_t)b * SEQ + t0 + tt) * DM + h * 512 + eb * 64 + ee] = f2bf(opart[tt][0][ee] + opart[tt][1][ee] + opart[tt][2][ee] + opart[tt][3][ee]); }
    }
}
__global__ void __launch_bounds__(256) n_glanorm(bf16_t* og, const bf16_t* z, const float* g) {
    const int m = blockIdx.x, h = threadIdx.x >> 6, lane = threadIdx.x & 63; bf16_t* o = og + (size_t)m * DM + h * 512;
    float v[8], s = 0.f;
#pragma unroll
    for (int i = 0; i < 8; ++i) { v[i] = bf2f(o[lane + i * 64]); s += v[i] * v[i]; }
#pragma unroll
    for (int of = 32; of > 0; of >>= 1) s += __shfl_xor(s, of);
    const float rstd = rsqrtf(s / 512.f + EPSN);
#pragma unroll
    for (int i = 0; i < 8; ++i) { const int ee = lane + i * 64; const float nv = v[i] * rstd * g[ee];
        o[ee] = f2bf(nv * siluf_(bf2f(z[(size_t)m * ZA_LD + OFF_GOG + h * 512 + ee]))); }
}
__global__ void __launch_bounds__(256) n_resnorm(const float* xin, const bf16_t* y, const float* g1, const float* mod, int off_gate, float* xout, const float* g2, int off_shift, int off_scale, bf16_t* h2) {
    __shared__ float red[4];
    const int m = blockIdx.x, b = m / SEQ;
    float yv[8], s = 0.f;
#pragma unroll
    for (int i = 0; i < 8; ++i) { yv[i] = bf2f(y[(size_t)m * DM + threadIdx.x + i * 256]); s += yv[i] * yv[i]; }
    const float rstd = rsqrtf(block_sum256(s, red) / DM + EPSN);
    float xv[8], s2 = 0.f;
#pragma unroll
    for (int i = 0; i < 8; ++i) { const int k = threadIdx.x + i * 256; xv[i] = xin[(size_t)m * DM + k] + mod[b * 12288 + off_gate + k] * (yv[i] * rstd * g1[k]); s2 += xv[i] * xv[i];
        xout[(size_t)m * DM + k] = xv[i]; }
    if (h2) { const float r2 = rsqrtf(block_sum256(s2, red) / DM + EPSN);
#pragma unroll
        for (int i = 0; i < 8; ++i) { const int k = threadIdx.x + i * 256;
            h2[(size_t)m * DM + k] = f2bf(xv[i] * r2 * g2[k] * (1.f + mod[b * 12288 + off_scale + k]) + mod[b * 12288 + off_shift + k]); } }
}
__global__ void __launch_bounds__(256) n_convact(const bf16_t* ubuf, int r0, int q0, const float* cw, const float* cb, bf16_t* act) {
    const int m = q0 + blockIdx.y, t = m % SEQ, j = blockIdx.x * 256 + threadIdx.x;
    float ca = cb[j], cv = cb[DFF + j];
#pragma unroll
    for (int i = 0; i < 3; ++i) { const int tt = t - 2 + i; if (tt >= 0) { const bf16_t* ur = ubuf + (size_t)(m - 2 + i - r0) * DFF2;
        ca += cw[i * DFF2 + j] * bf2f(ur[j]); cv += cw[i * DFF2 + DFF + j] * bf2f(ur[DFF + j]); } }
    act[(size_t)m * DFF + j] = f2bf(gelu_tanh(ca) * cv);
}

namespace pg8 {
#define PG8_LAS __attribute__((address_space(3)))
typedef short bf16x8 __attribute__((ext_vector_type(8)));
typedef float f32x4 __attribute__((ext_vector_type(4)));
typedef unsigned u32x4 __attribute__((ext_vector_type(4)));
constexpr int BM = 256, BK = 64, HALF = 128, HTB = HALF * BK * 2  , STAGE_BYTES = 8 * HTB, NXCD = 8, WGM = 8;

__host__ __device__ __forceinline__ int lds_byte(int r, int c) { const int st = (r >> 4) * 2 + (c >> 5), rr = r & 15, cc = c & 31, ob = rr * 64 + cc * 2; return st * 1024 + (ob ^ (((ob >> 9) & 1) << 5)); }
__host__ __device__ __forceinline__ void stage_rc(int b, int& R, int& C) { const int st = b / 1024, sb = b % 1024, swz = sb ^ (((sb >> 9) & 1) << 5); R = (st >> 1) * 16 + swz / 64; C = (st & 1) * 32 + (swz % 64) / 2; }
__host__ __device__ __forceinline__ int perm32(int rho) { const int n = rho >> 4, i = rho & 15; return 8 * (i >> 2) + 4 * n + (i & 3); }

struct Unit { int pm, pn; };
struct Gemm { const bf16_t* A; const bf16_t* Bt; int M, N, K, lda; };
__host__ __device__ __forceinline__ int arow(int R, bool perm) { return perm ? (128 * (R >> 6) + 8 * (R & 15) + ((R >> 4) & 3)) : R; }
typedef float f32x2c_t __attribute__((ext_vector_type(2))); typedef __bf16 bf16x2c_t __attribute__((ext_vector_type(2)));
__device__ __forceinline__ unsigned cvt_pk_bf16(float lo, float hi) { f32x2c_t v = {lo, hi}; bf16x2c_t b = __builtin_convertvector(v, bf16x2c_t); return __builtin_bit_cast(unsigned, b); }
typedef float f32x2 __attribute__((ext_vector_type(2)));
struct StaticOrder {
    int nM, nN, nwg, G, c;
    __host__ __device__ __forceinline__ void init(int M, int N, int G_, int c_) { nM = M / BM; nN = N / BM; nwg = nM * nN; G = G_; c = c_; }
    __host__ __device__ __forceinline__ bool next(int i, Unit& u) const {
        const long L = (long)i * G + c; if (L >= nwg) return false;
        int wgid = (int)L; { const int q = nwg / NXCD, r = nwg % NXCD, xcd = wgid % NXCD, off = wgid / NXCD; wgid = (xcd < r ? xcd * (q + 1) : r * (q + 1) + (xcd - r) * q) + off; }
        const int nig = WGM * nN, gid = wgid / nig, fm = gid * WGM, gsz = (nM - fm) < WGM ? (nM - fm) : WGM;
        u.pm = fm + ((wgid % nig) % gsz); u.pn = (wgid % nig) / gsz; return true;
    }
    __device__ __forceinline__ void a_ready(const Unit&) const {}
    __device__ __forceinline__ void done(const Unit&) const {}
};
template <class Epi, class Sched, bool ALIGN_EPI = false, bool SP2 = false>
__device__ __forceinline__ void gemm_phase(PG8_LAS unsigned char* lds, const Gemm g, const Sched& S, const Epi& E) {
    const int tid = fresh_tid(), wid = __builtin_amdgcn_readfirstlane(tid >> 6), lane = tid & 63, wr = wid >> 2, wc = wid & 3, fr = lane & 15, fq = lane >> 4;
    const int K = g.K, nt = K / BK;
    unsigned voffA[2], voffB[2];
#pragma unroll
    for (int i = 0; i < 2; ++i) { int R, C; stage_rc(tid * 16 + i * 8192, R, C); const int Rb = Epi::PERM ? ((R & ~31) + perm32(R & 31)) : R;
        voffA[i] = (unsigned)(arow(R, Epi::APERM) * g.lda + C) * 2u; voffB[i] = (unsigned)(Rb * K + C) * 2u; }
    const size_t kstep = (size_t)(BK * 2);
    const size_t hstepA = Epi::APERM ? (size_t)4 * g.lda * 2 : (size_t)HALF * g.lda * 2, hstepB = (size_t)HALF * K * 2;
    const size_t tstepA = (size_t)BM * g.lda * 2, tstepB = 2 * hstepB;
    const unsigned ldsw = (unsigned)wid * 1024u;
    const int aoff = lds_byte(wr * 64 + fr, fq * 8), boff = lds_byte(wc * 32 + fr, fq * 8);
#define PG8_SA(b, h) (((b) * 2 + (h)) * HTB)
#define PG8_SB(b, h) ((4 + (b) * 2 + (h)) * HTB)
#define PG8_STAGE(bufoff, gbase, voff) do { _Pragma("unroll") for (int _i = 0; _i < 2; ++_i) \
        __builtin_amdgcn_global_load_lds((const unsigned*)((const char*)(gbase) + (voff)[_i]), (PG8_LAS unsigned*)(lds + (bufoff) + ldsw + _i * 8192), 16, 0, 0); } while (0)
#define PG8_LDA(dst, b, h) do { _Pragma("unroll") for (int m = 0; m < 4; ++m) _Pragma("unroll") for (int k = 0; k < 2; ++k) dst[m][k] = *(const PG8_LAS bf16x8*)(lds + PG8_SA(b, h) + aoff + m * 2048 + k * 1024); } while (0)
#define PG8_LDB(dst, b, h) do { _Pragma("unroll") for (int n = 0; n < 2; ++n) _Pragma("unroll") for (int k = 0; k < 2; ++k) dst[n][k] = *(const PG8_LAS bf16x8*)(lds + PG8_SB(b, h) + boff + n * 2048 + k * 1024); } while (0)
#define PG8_MMA(ai, bj, At, Bt) do { __builtin_amdgcn_s_setprio(1); _Pragma("unroll") for (int m = 0; m < 4; ++m) _Pragma("unroll") for (int n = 0; n < 2; ++n) _Pragma("unroll") for (int k = 0; k < 2; ++k) \
        acc[ai][bj][m][n] = __builtin_amdgcn_mfma_f32_16x16x32_bf16(Bt[n][k], At[m][k], acc[ai][bj][m][n], 0, 0, 0); __builtin_amdgcn_s_setprio(0); } while (0)
#define PG8_WAIT_V(n) asm volatile("s_waitcnt vmcnt(" #n ")" ::: "memory")
#define PG8_WAIT_L(n) asm volatile("s_waitcnt lgkmcnt(" #n ")" ::: "memory")
#define PG8_BAR __builtin_amdgcn_s_barrier()
#define PG8_SCHED __builtin_amdgcn_sched_barrier(0)
    Unit cur, nxt; int ui = 0;
    if (!S.next(0, cur)) return;
    f32x4 acc[2][2][4][2];
#pragma unroll
    for (int a = 0; a < 2; ++a)
#pragma unroll
        for (int b = 0; b < 2; ++b)
#pragma unroll
            for (int m = 0; m < 4; ++m)
#pragma unroll
                for (int n = 0; n < 2; ++n) acc[a][b][m][n] = (f32x4){0.f, 0.f, 0.f, 0.f};
    bf16x8 At[4][2], B0[2][2], B1[2][2];
    const char* cA = (const char*)g.A + (size_t)cur.pm * tstepA; const char* cB = (const char*)g.Bt + (size_t)cur.pn * tstepB;
    S.a_ready(cur);
    if constexpr (SP2) {
        PG8_STAGE(PG8_SB(0, 0), cB, voffB); PG8_STAGE(PG8_SB(0, 1), cB + hstepB, voffB); PG8_STAGE(PG8_SA(0, 0), cA, voffA); PG8_STAGE(PG8_SA(0, 1), cA + hstepA, voffA);
        if (wr == 1) PG8_BAR;
        PG8_WAIT_V(2); PG8_BAR;
        PG8_STAGE(PG8_SB(1, 0), cB + kstep, voffB); PG8_STAGE(PG8_SA(1, 0), cA + kstep, voffA); PG8_STAGE(PG8_SB(1, 1), cB + hstepB + kstep, voffB);
        PG8_WAIT_V(6); PG8_BAR;
    } else {
        PG8_STAGE(PG8_SB(0, 0), cB, voffB); PG8_STAGE(PG8_SA(0, 0), cA, voffA); PG8_STAGE(PG8_SB(0, 1), cB + hstepB, voffB); PG8_STAGE(PG8_SA(0, 1), cA + hstepA, voffA);
        if (wr == 1) PG8_BAR;
        PG8_WAIT_V(4); PG8_BAR;
        PG8_STAGE(PG8_SB(1, 0), cB + kstep, voffB); PG8_STAGE(PG8_SA(1, 0), cA + kstep, voffA); PG8_STAGE(PG8_SB(1, 1), cB + hstepB + kstep, voffB);
        PG8_WAIT_V(6); PG8_BAR;
    }
    for (;;) {
        const bool has_next = S.next(ui + 1, nxt);
        const char* nA = has_next ? (const char*)g.A + (size_t)nxt.pm * tstepA : cA; const char* nB = has_next ? (const char*)g.Bt + (size_t)nxt.pn * tstepB : cB;
        for (int t = 0; t < nt; t += 2) {
            const bool last = (t == nt - 2);
            const char* a1 = cA + (size_t)(t + 1) * kstep;
            const char* a2 = last ? nA : cA + (size_t)(t + 2) * kstep; const char* b2 = last ? nB : cB + (size_t)(t + 2) * kstep;
            const char* a3 = a2 + kstep; const char* b3 = b2 + kstep;
            if (last && has_next) S.a_ready(nxt);
            if constexpr (SP2) {
            PG8_LDB(B0, 0, 0); PG8_LDB(B1, 0, 1); PG8_SCHED; PG8_LDA(At, 0, 0); PG8_STAGE(PG8_SA(1, 1), a1 + hstepA, voffA);
            PG8_WAIT_V(8); PG8_WAIT_L(0); PG8_BAR; PG8_MMA(0, 0, At, B0); PG8_MMA(0, 1, At, B1); PG8_BAR; PG8_SCHED;
            PG8_LDA(At, 0, 1); PG8_STAGE(PG8_SB(0, 0), b2, voffB); PG8_STAGE(PG8_SB(0, 1), b2 + hstepB, voffB); PG8_STAGE(PG8_SA(0, 0), a2, voffA);
            PG8_WAIT_V(8); PG8_WAIT_L(0); PG8_BAR; PG8_MMA(1, 0, At, B0); PG8_MMA(1, 1, At, B1); PG8_BAR; PG8_SCHED;
            PG8_LDB(B0, 1, 0); PG8_LDB(B1, 1, 1); PG8_SCHED; PG8_LDA(At, 1, 0); PG8_STAGE(PG8_SA(0, 1), a2 + hstepA, voffA);
            PG8_WAIT_V(8); PG8_WAIT_L(0); PG8_BAR; PG8_MMA(0, 0, At, B0); PG8_MMA(0, 1, At, B1); PG8_BAR; PG8_SCHED;
            PG8_LDA(At, 1, 1); PG8_STAGE(PG8_SB(1, 0), b3, voffB); PG8_STAGE(PG8_SB(1, 1), b3 + hstepB, voffB); PG8_STAGE(PG8_SA(1, 0), a3, voffA);
            PG8_WAIT_V(8); PG8_WAIT_L(0); PG8_BAR; PG8_MMA(1, 0, At, B0); PG8_MMA(1, 1, At, B1); PG8_BAR; PG8_SCHED;
            } else {
            PG8_LDB(B0, 0, 0); PG8_SCHED; PG8_LDA(At, 0, 0); PG8_STAGE(PG8_SA(1, 1), a1 + hstepA, voffA);
            PG8_WAIT_L(8); PG8_BAR; PG8_WAIT_L(0); PG8_MMA(0, 0, At, B0); PG8_BAR; PG8_SCHED;
            PG8_LDB(B1, 0, 1); PG8_STAGE(PG8_SB(0, 0), b2, voffB);
            PG8_BAR; PG8_WAIT_L(0); PG8_MMA(0, 1, At, B1); PG8_BAR;
            PG8_LDA(At, 0, 1); PG8_STAGE(PG8_SA(0, 0), a2, voffA);
            PG8_BAR; PG8_WAIT_L(0); PG8_MMA(1, 0, At, B0); PG8_BAR; PG8_SCHED;
            PG8_STAGE(PG8_SB(0, 1), b2 + hstepB, voffB);
            PG8_WAIT_V(6); PG8_BAR; PG8_MMA(1, 1, At, B1); PG8_BAR;
            PG8_LDB(B0, 1, 0); PG8_SCHED; PG8_LDA(At, 1, 0); PG8_STAGE(PG8_SA(0, 1), a2 + hstepA, voffA);
            PG8_WAIT_L(8); PG8_BAR; PG8_WAIT_L(0); PG8_MMA(0, 0, At, B0); PG8_BAR; PG8_SCHED;
            PG8_LDB(B1, 1, 1); PG8_STAGE(PG8_SB(1, 0), b3, voffB);
            PG8_BAR; PG8_WAIT_L(0); PG8_MMA(0, 1, At, B1); PG8_BAR;
            PG8_LDA(At, 1, 1); PG8_STAGE(PG8_SA(1, 0), a3, voffA);
            PG8_BAR; PG8_WAIT_L(0); PG8_MMA(1, 0, At, B0); PG8_BAR; PG8_SCHED;
            PG8_STAGE(PG8_SB(1, 1), b3 + hstepB, voffB);
            PG8_WAIT_V(6); PG8_BAR; PG8_MMA(1, 1, At, B1); PG8_BAR;
            }
        }
        if constexpr (ALIGN_EPI) { if (wr == 0) PG8_BAR; }
        if constexpr (!Epi::AFTER_DRAIN) { E(acc, cur, wr, wc, fr, fq); S.done(cur); }
        if (!has_next) break;
#pragma unroll
        for (int a = 0; a < 2; ++a)
#pragma unroll
            for (int b = 0; b < 2; ++b)
#pragma unroll
                for (int m = 0; m < 4; ++m)
#pragma unroll
                    for (int n = 0; n < 2; ++n) acc[a][b][m][n] = (f32x4){0.f, 0.f, 0.f, 0.f};
        cur = nxt; cA = nA; cB = nB; ++ui;
        if constexpr (ALIGN_EPI) { if (wr == 1) PG8_BAR; }
    }
    PG8_WAIT_V(0);
    if constexpr (!ALIGN_EPI) { if (wr == 0) PG8_BAR; }
    PG8_BAR;
    if constexpr (Epi::AFTER_DRAIN) { E.fused(acc, cur, wr, wc, fr, fq, lds, wid, lane); S.done(cur); }
#undef PG8_SA
#undef PG8_SB
#undef PG8_STAGE
#undef PG8_LDA
#undef PG8_LDB
#undef PG8_MMA
#undef PG8_WAIT_V
#undef PG8_WAIT_L
#undef PG8_BAR
#undef PG8_SCHED
}
}

#define GAS __attribute__((address_space(1)))
#define LAS __attribute__((address_space(3)))
typedef unsigned v4u __attribute__((ext_vector_type(4)));
typedef float f32x4 __attribute__((ext_vector_type(4)));
typedef GAS unsigned gu32;
#define RLX_AGENT __ATOMIC_RELAXED, __HIP_MEMORY_SCOPE_AGENT
#define LDS_WAIT() asm volatile("s_waitcnt lgkmcnt(0)" ::: "memory")
#define VM_WAIT() asm volatile("s_waitcnt vmcnt(0)" ::: "memory")
constexpr int NWAVES = 8;
constexpr int RING_BYTES = 131072, LDS_BYTES = 163840, LDSCTL_OFF = LDS_BYTES - 1024, MISC_OFF = LDSCTL_OFF + 320;
constexpr int CW_BAR = 4096, CW_PROG = 20480  , CW_ADA = 16384  ;
__device__ __forceinline__ unsigned pk2(float lo, float hi) { return (unsigned)f2bf(lo) | ((unsigned)f2bf(hi) << 16); }

#define XB_TMO      128
#define XB_XCNT(j)  (256  + 64 * (j))
#define XB_XSUB(j)  (1280 + 64 * (j))
#define XB_XGEN(j)  (2304 + 64 * (j))
#define XB_TOP      3328
#define XB_TOPGEN   3392
#define XCD_BAR_WORDS 3456
#define XB_SPIN_CAP (1u << 18)

__device__ __forceinline__ unsigned xb_ld(unsigned* p)              { return __hip_atomic_load(p, __ATOMIC_RELAXED, __HIP_MEMORY_SCOPE_AGENT); }
__device__ __forceinline__ unsigned xb_add(unsigned* p, unsigned v) { return __hip_atomic_fetch_add(p, v, __ATOMIC_RELAXED, __HIP_MEMORY_SCOPE_AGENT); }
__device__ __forceinline__ unsigned xb_xcc_id() { return (unsigned)__builtin_amdgcn_s_getreg((3 << 11) | 20) & 0xFu; }
#define XB_SPIN(cond, bar) do { unsigned _sp = 0; while (cond) { __builtin_amdgcn_s_sleep(1); \
    if ((++_sp & 255u) == 0u) { if (xb_ld(&(bar)[XB_TMO])) break; if (_sp > XB_SPIN_CAP) { atomicAdd(&(bar)[XB_TMO], 1u); break; } } } } while (0)

struct XcdBarrier {
    unsigned* bar; unsigned x;
    volatile LAS unsigned* st;
};

__device__ __forceinline__ XcdBarrier xcd_barrier_post(unsigned* bar, volatile LAS unsigned* st) {
    XcdBarrier b; b.bar = bar; b.x = xb_xcc_id(); b.st = st;
    if (threadIdx.x == 0) (void)xb_add(&bar[XB_XCNT(b.x)], 1u);
    return b;
}
__device__ __forceinline__ void xcd_barrier_complete(unsigned* bar, unsigned x, unsigned& nloc, unsigned& nx) {
    const unsigned G = gridDim.x * gridDim.y * gridDim.z;
    unsigned sum, cnt, mine, sp = 0u;
    for (;;) {
        sum = 0u; cnt = 0u; mine = 0u;
#pragma unroll
        for (unsigned j = 0; j < 16; ++j) { const unsigned c = xb_ld(&bar[XB_XCNT(j)]); sum += c; cnt += (c > 0u) ? 1u : 0u; mine = (j == x) ? c : mine; }
        if (sum == G) break;
        __builtin_amdgcn_s_sleep(1);
        if ((++sp & 255u) == 0u) { if (xb_ld(&bar[XB_TMO])) break; if (sp > XB_SPIN_CAP) { atomicAdd(&bar[XB_TMO], 1u); break; } }
    }
    nloc = mine > 0u ? mine : 1u; nx = cnt > 0u ? cnt : 1u;
}

__device__ __forceinline__ void xcd_barrier(const XcdBarrier& b) {
    asm volatile("s_waitcnt vmcnt(0)" ::: "memory");
    __syncthreads();
    if (threadIdx.x == 0) {
        unsigned* bar = b.bar;
        __builtin_amdgcn_s_waitcnt(0);
        unsigned nloc = b.st[0], nx = b.st[1];
        if (nloc == 0u) { xcd_barrier_complete(bar, b.x, nloc, nx); b.st[0] = nloc; b.st[1] = nx; }
        const unsigned old = xb_add(&bar[XB_XSUB(b.x)], 1u);
        const unsigned gen = old / nloc;
        if (old + 1u == (gen + 1u) * nloc) {
            __builtin_amdgcn_fence(__ATOMIC_RELEASE, "agent");
            asm volatile("s_waitcnt vmcnt(0)" ::: "memory");
            const unsigned og = xb_add(&bar[XB_TOP], 1u);
            const unsigned tg = og / nx;
            if (og + 1u == (tg + 1u) * nx) xb_add(&bar[XB_TOPGEN], 1u);
            else XB_SPIN(xb_ld(&bar[XB_TOPGEN]) == tg, bar);
            __builtin_amdgcn_fence(__ATOMIC_ACQUIRE, "agent");
            xb_add(&bar[XB_XGEN(b.x)], 1u);
            asm volatile("s_waitcnt vmcnt(0)" ::: "memory");
        } else {
            XB_SPIN(xb_ld(&bar[XB_XGEN(b.x)]) == gen, bar);
            __builtin_amdgcn_fence(__ATOMIC_ACQUIRE, "agent");
            asm volatile("s_waitcnt vmcnt(0)" ::: "memory");
        }
    }
    __syncthreads();
}


__device__ __forceinline__ float wave_sum(float v) {
#pragma unroll
    for (int o = 1; o < 64; o <<= 1) v += __shfl_xor(v, o);
    return v;
}

struct Args { const void* in[24]; float* out; unsigned char* ws; int ph_lo, ph_hi; };

__device__ __forceinline__ void p0_ada(const float* c, const float* w_ada, const float* b_ada, float* mod, LAS float* lds, int cg, int wave, int lane) {
    if (cg >= 192) return;
    LAS float* ct = lds; LAS float* red = lds + 2 * DM;
    const int tid = wave * 64 + lane;
#pragma unroll
    for (int i = 0; i < 8; ++i) ct[tid + 512 * i] = siluf_(c[tid + 512 * i]);
    LDS_WAIT(); __syncthreads();
    const int r = lane >> 4, c4 = (lane & 15) * 4, k0 = wave * 256 + r;
    f32x4 a0[2] = {{0.f, 0.f, 0.f, 0.f}, {0.f, 0.f, 0.f, 0.f}}, a1[2] = {{0.f, 0.f, 0.f, 0.f}, {0.f, 0.f, 0.f, 0.f}};
    const float* wp = w_ada + (size_t)k0 * 12288 + cg * 64 + c4;
#pragma unroll 16
    for (int i = 0; i < 64; ++i) { const f32x4 w = __builtin_nontemporal_load((const f32x4*)(wp + (size_t)(4 * i) * 12288)); const float s0 = ct[k0 + 4 * i], s1 = ct[DM + k0 + 4 * i];
        a0[i & 1] += s0 * w; a1[i & 1] += s1 * w; }
    f32x4 s0 = a0[0] + a0[1], s1 = a1[0] + a1[1];
#pragma unroll
    for (int e = 0; e < 4; ++e) { s0[e] += __shfl_xor(s0[e], 16); s0[e] += __shfl_xor(s0[e], 32); s1[e] += __shfl_xor(s1[e], 16); s1[e] += __shfl_xor(s1[e], 32); }
    if (lane < 16) { *(LAS f32x4*)(red + (wave * 2 + 0) * 64 + c4) = s0; *(LAS f32x4*)(red + (wave * 2 + 1) * 64 + c4) = s1; }
    LDS_WAIT(); __syncthreads();
    if (tid < 128) { const int b = tid >> 6, l = tid & 63; float s = b_ada[cg * 64 + l];
#pragma unroll
        for (int w = 0; w < 8; ++w) s += red[(w * 2 + b) * 64 + l];
        mod[b * 12288 + cg * 64 + l] = s; }
    __syncthreads();
}
__device__ __forceinline__ void p0_cs(const int* pos, float2* cs, int gw, int NGW, int lane) {
    for (int it = gw; it < MTOK * 32 / 64; it += NGW) { const int idx = it * 64 + lane, m = idx >> 5, i = idx & 31;
        const float inv = 1.0f / powf(10000.0f, (float)(2 * i) / 64.0f); const float ang = (float)pos[m] * inv;
        float s, c; sincosf(ang, &s, &c); cs[idx] = make_float2(c, s); }
}
template <class SrcCol>
__device__ __forceinline__ void tr_load(f32x4 (&v)[16], const float* W, int Nsrc, int kb, int nb, int lane, SrcCol sc) {
    const int k0 = 64 * kb + 8 * (lane >> 3), n0 = 64 * nb + 4 * (lane & 7); const int nc0 = sc(n0), nc1 = sc(n0 + 32);
#pragma unroll
    for (int i = 0; i < 8; ++i) { v[2 * i] = (f32x4){0.f, 0.f, 0.f, 0.f}; v[2 * i + 1] = (f32x4){0.f, 0.f, 0.f, 0.f};
        if (nc0 >= 0) v[2 * i] = __builtin_nontemporal_load((const f32x4*)(W + (size_t)(k0 + i) * Nsrc + nc0));
        if (nc1 >= 0) v[2 * i + 1] = __builtin_nontemporal_load((const f32x4*)(W + (size_t)(k0 + i) * Nsrc + nc1)); }
}
__device__ __forceinline__ void tr_proc(const f32x4 (&v)[16], int K, bf16_t* WT, LAS float* scr, int kb, int nb, int lane, const float* kgain, float scale) {
    const int k0 = 64 * kb + 8 * (lane >> 3), n0 = 64 * nb + 4 * (lane & 7);
    float s[8];
#pragma unroll
    for (int i = 0; i < 8; ++i) s[i] = scale;
    if (kgain) { const f32x4 ga = *(const f32x4*)(kgain + k0), gb = *(const f32x4*)(kgain + k0 + 4);
#pragma unroll
        for (int i = 0; i < 4; ++i) { s[i] *= ga[i]; s[4 + i] *= gb[i]; } }
#pragma unroll
    for (int c = 0; c < 8; ++c) { const int h = c >> 2, e = c & 3;
        v4u o; o.x = pg8::cvt_pk_bf16(v[h][e] * s[0], v[2 + h][e] * s[1]); o.y = pg8::cvt_pk_bf16(v[4 + h][e] * s[2], v[6 + h][e] * s[3]); o.z = pg8::cvt_pk_bf16(v[8 + h][e] * s[4], v[10 + h][e] * s[5]); o.w = pg8::cvt_pk_bf16(v[12 + h][e] * s[6], v[14 + h][e] * s[7]);
        *(v4u*)(WT + (size_t)(n0 + 32 * h + e) * K + k0) = o; }
}
struct ScNat { int N; __device__ int operator()(int n) const { return n < N ? n : -1; } };
struct ScIn { __device__ int operator()(int n) const { return n < 6144 ? 4944 + n : (n < DIN ? n - 6144 : -1); } };
struct ScQ { __device__ int operator()(int n) const { const int h = n / 192, w = n % 192; if (w < 128) return n; const int p = w - 128, g = p >> 3, e = p & 7; return h * 192 + 128 + (e < 4 ? 4 * g + e : 32 + 4 * g + (e - 4)); } };
struct ScUp { __device__ int operator()(int n) const { const int pn = n >> 8, r = n & 255; return r < 128 ? 128 * pn + r : DFF + 128 * pn + (r - 128); } };
template <class SrcCol>
__device__ __forceinline__ void tr_matrix(const float* W, int K, int Nsrc, int Ndst, bf16_t* WT, LAS float* scr, int& cursor, int gw, int NGW, int lane, SrcCol sc, const float* kgain, float scale, int item_lo = 0, int item_hi = 0x7fffffff) {
    const int nblk = Ndst / 64, nall = (K / 64) * nblk, nitems = item_hi < nall ? item_hi : nall;
    int it = gw - cursor % NGW; if (it < 0) it += NGW; it += item_lo;
    f32x4 cur[16], nxt[16];
    if (it < nitems) tr_load(cur, W, Nsrc, it / nblk, it % nblk, lane, sc);
    for (; it < nitems; it += NGW) { const int itn = it + NGW;
        if (itn < nitems) tr_load(nxt, W, Nsrc, itn / nblk, itn % nblk, lane, sc);
        tr_proc(cur, K, WT, scr, it / nblk, it % nblk, lane, kgain, scale);
#pragma unroll
        for (int i = 0; i < 16; ++i) cur[i] = nxt[i]; }
    cursor += nitems - item_lo;
}

namespace pg8 {
struct EpiZ {
    static constexpr bool PERM = true, AFTER_DRAIN = false, APERM = false;
    bf16_t* ZA; bf16_t* ZB; float* statq; float* statkv;
    __device__ __forceinline__ void operator()(const f32x4 (&acc)[2][2][4][2], const Unit& u, int wr, int wc, int fr, int fq) const {
        const int row0 = u.pm * BM + wr * 64 + fr, col0 = u.pn * BM + wc * 32 + 8 * fq;
#pragma unroll
        for (int ai = 0; ai < 2; ++ai)
#pragma unroll
            for (int m = 0; m < 4; ++m) { const int row = row0 + ai * HALF + m * 16; bf16_t* rowp = (u.pn < 24) ? ZA + (size_t)row * ZA_LD + col0 : ZB + (size_t)row * ZB_LD + (col0 - 6144); float ss = 0.f;
#pragma unroll
                for (int bj = 0; bj < 2; ++bj) { const f32x4 v0 = acc[ai][bj][m][0], v1 = acc[ai][bj][m][1];
                    u32x4 w; w.x = cvt_pk_bf16(v0[0], v0[1]); w.y = cvt_pk_bf16(v0[2], v0[3]); w.z = cvt_pk_bf16(v1[0], v1[1]); w.w = cvt_pk_bf16(v1[2], v1[3]);
                    *(u32x4*)(rowp + bj * HALF) = w;
                    ss += (v0[0] * v0[0] + v0[1] * v0[1]) + (v0[2] * v0[2] + v0[3] * v0[3]) + (v1[0] * v1[0] + v1[1] * v1[1]) + (v1[2] * v1[2] + v1[3] * v1[3]); }
                if (u.pn >= 24 && u.pn < 27) { ss += __shfl_xor(ss, 16); ss += __shfl_xor(ss, 32);
                    if (fq == 0) { if (u.pn < 26) statq[row * 8 + (u.pn - 24) * 4 + wc] = ss; else statkv[row * 4 + wc] = ss; } } }
    }
};
}


namespace pg8 {
__device__ __forceinline__ u32x4 pack8(const f32x4 v0, const f32x4 v1) { u32x4 w; w.x = cvt_pk_bf16(v0[0], v0[1]); w.y = cvt_pk_bf16(v0[2], v0[3]); w.z = cvt_pk_bf16(v1[0], v1[1]); w.w = cvt_pk_bf16(v1[2], v1[3]); return w; }
__device__ __forceinline__ void unpack8(const u32x4 w, f32x4& a, f32x4& b) {
    a[0] = __uint_as_float(w.x << 16); a[1] = __uint_as_float(w.x & 0xffff0000u); a[2] = __uint_as_float(w.y << 16); a[3] = __uint_as_float(w.y & 0xffff0000u);
    b[0] = __uint_as_float(w.z << 16); b[1] = __uint_as_float(w.z & 0xffff0000u); b[2] = __uint_as_float(w.w << 16); b[3] = __uint_as_float(w.w & 0xffff0000u); }
struct EpiStoreB {
    static constexpr bool PERM = true, AFTER_DRAIN = false, APERM = false;
    bf16_t* C; int ldc;
    __device__ __forceinline__ void operator()(const f32x4 (&acc)[2][2][4][2], const Unit& u, int wr, int wc, int fr, int fq) const {
        const int row0 = u.pm * BM + wr * 64 + fr, col0 = u.pn * BM + wc * 32 + 8 * fq;
#pragma unroll
        for (int ai = 0; ai < 2; ++ai)
#pragma unroll
            for (int m = 0; m < 4; ++m) { bf16_t* rowp = C + (size_t)(row0 + ai * HALF + m * 16) * ldc + col0;
#pragma unroll
                for (int bj = 0; bj < 2; ++bj) *(u32x4*)(rowp + bj * HALF) = pack8(acc[ai][bj][m][0], acc[ai][bj][m][1]); }
    }
};
struct EpiQo {
    static constexpr bool PERM = true, AFTER_DRAIN = false, APERM = false;
    bf16_t* Q; const float* statq; const float2* cs;
    __device__ __forceinline__ void operator()(const f32x4 (&acc)[2][2][4][2], const Unit& u, int wr, int wc, int fr, int fq) const {
        const int row0 = u.pm * BM + wr * 64 + fr, col0 = u.pn * BM + wc * 32 + 8 * fq;
        const int hw0 = (u.pn * BM + wc * 32) % 192, hw1 = (u.pn * BM + HALF + wc * 32) % 192;
        const bool rp0 = hw0 >= 128, rp1 = hw1 >= 128;
#pragma unroll
        for (int aq = 0; aq < 4; ++aq) { const int ai = aq >> 1, mb = (aq & 1) * 2;
            f32x4 s0[4], s1[4]; f32x4 c0[4][2], c1[4][2];
#pragma unroll
            for (int m = mb; m < mb + 2; ++m) { const int row = row0 + ai * HALF + m * 16;
                s0[m] = *(const f32x4*)(statq + row * 8); s1[m] = *(const f32x4*)(statq + row * 8 + 4);
                if (rp0) { const f32x4* c = (const f32x4*)(cs + row * 32 + 4 * (((hw0 - 128) >> 3) + fq)); c0[m][0] = c[0]; c0[m][1] = c[1]; }
                if (rp1) { const f32x4* c = (const f32x4*)(cs + row * 32 + 4 * (((hw1 - 128) >> 3) + fq)); c1[m][0] = c[0]; c1[m][1] = c[1]; } }
#pragma unroll
            for (int m = mb; m < mb + 2; ++m) { const int row = row0 + ai * HALF + m * 16; bf16_t* rowp = Q + (size_t)row * 1536 + col0;
                const float rstd = rsqrtf(((s0[m][0] + s0[m][1]) + (s0[m][2] + s0[m][3]) + (s1[m][0] + s1[m][1]) + (s1[m][2] + s1[m][3])) * (1.f / 512.f) + EPSN);
#pragma unroll
                for (int bj = 0; bj < 2; ++bj) { f32x4 v0 = acc[ai][bj][m][0] * rstd, v1 = acc[ai][bj][m][1] * rstd;
                    if (bj == 0 ? rp0 : rp1) { const f32x4 ca = bj == 0 ? c0[m][0] : c1[m][0], cb = bj == 0 ? c0[m][1] : c1[m][1];
                        const float cx[4] = {ca[0], ca[2], cb[0], cb[2]}, sx[4] = {ca[1], ca[3], cb[1], cb[3]};
#pragma unroll
                        for (int j = 0; j < 4; ++j) { const float x1 = v0[j], x2 = v1[j]; v0[j] = x1 * cx[j] - x2 * sx[j]; v1[j] = x2 * cx[j] + x1 * sx[j]; } }
                    *(u32x4*)(rowp + bj * HALF) = pack8(v0, v1); } } }
    }
};
struct EpiKVo {
    static constexpr bool PERM = true, AFTER_DRAIN = false, APERM = false;
    bf16_t* Kf; bf16_t* V; const float* statkv;
    __device__ __forceinline__ void operator()(const f32x4 (&acc)[2][2][4][2], const Unit& u, int wr, int wc, int fr, int fq) const {
        const int row0 = u.pm * BM + wr * 64 + fr, c0 = wc * 32 + 8 * fq;
        f32x4 st[2][4];
#pragma unroll
        for (int ai = 0; ai < 2; ++ai)
#pragma unroll
            for (int m = 0; m < 4; ++m) st[ai][m] = *(const f32x4*)(statkv + (row0 + ai * HALF + m * 16) * 4);
#pragma unroll
        for (int ai = 0; ai < 2; ++ai)
#pragma unroll
            for (int m = 0; m < 4; ++m) { const int row = row0 + ai * HALF + m * 16; const f32x4 s0 = st[ai][m];
                const float rstd = rsqrtf(((s0[0] + s0[1]) + (s0[2] + s0[3])) * (1.f / 256.f) + EPSN);
                *(u32x4*)(Kf + (size_t)row * 1536 + u.pn * 192 + c0) = pack8(acc[ai][0][m][0] * rstd, acc[ai][0][m][1] * rstd);
                *(u32x4*)(V + (size_t)row * 1024 + u.pn * 128 + c0) = pack8(acc[ai][1][m][0] * rstd, acc[ai][1][m][1] * rstd); }
    }
};
struct EpiGateo {
    static constexpr bool PERM = true, AFTER_DRAIN = false, APERM = false;
    bf16_t* C; const bf16_t* z; int goff; const bf16_t* add;
    __device__ __forceinline__ void operator()(const f32x4 (&acc)[2][2][4][2], const Unit& u, int wr, int wc, int fr, int fq) const {
        const int row0 = u.pm * BM + wr * 64 + fr, col0 = u.pn * BM + wc * 32 + 8 * fq;
#pragma unroll
        for (int aq = 0; aq < 4; ++aq) { const int ai = aq >> 1, mb = (aq & 1) * 2;
            u32x4 gr[4][2], ar[4][2];
#pragma unroll
            for (int m = mb; m < mb + 2; ++m)
#pragma unroll
                for (int bj = 0; bj < 2; ++bj) { const int row = row0 + ai * HALF + m * 16, col = col0 + bj * HALF;
                    gr[m][bj] = *(const u32x4*)(z + (size_t)row * ZA_LD + goff + col); if (add) ar[m][bj] = *(const u32x4*)(add + (size_t)row * DM + col); }
#pragma unroll
            for (int m = mb; m < mb + 2; ++m) { const int row = row0 + ai * HALF + m * 16;
#pragma unroll
                for (int bj = 0; bj < 2; ++bj) { const int col = col0 + bj * HALF;
                    f32x4 g0, g1; unpack8(gr[m][bj], g0, g1);
                    f32x4 v0 = acc[ai][bj][m][0], v1 = acc[ai][bj][m][1];
#pragma unroll
                    for (int j = 0; j < 4; ++j) { v0[j] *= sigmoidf_(g0[j]); v1[j] *= sigmoidf_(g1[j]); }
                    if (add) { f32x4 a0, a1; unpack8(ar[m][bj], a0, a1); v0 += a0; v1 += a1; }
                    *(u32x4*)(C + (size_t)row * DM + col) = pack8(v0, v1); } } }
    }
};
}

__device__ __forceinline__ void ph_kpe(const bf16_t* z, bf16_t* Kf, const float2* cs, int gw, int NGW, int lane) {
    for (int m2 = gw; m2 < MTOK / 2; m2 += NGW) { const int m = m2 * 2 + (lane >> 5), i = lane & 31; const bf16_t* zr = z + (size_t)m * ZB_LD + OFF_KROPE;
        const float x1 = bf2f(zr[i]), x2 = bf2f(zr[32 + i]); const float2 c = cs[m * 32 + i];
        const bf16_t o1 = f2bf(x1 * c.x - x2 * c.y), o2 = f2bf(x2 * c.x + x1 * c.y); const int p1 = rope_pos(i), p2 = rope_pos(32 + i);
#pragma unroll
        for (int h = 0; h < 8; ++h) { Kf[(size_t)m * 1536 + h * 192 + 128 + p1] = o1; Kf[(size_t)m * 1536 + h * 192 + 128 + p2] = o2; } }
}
__device__ __forceinline__ void ph_glanorm(bf16_t* og, const bf16_t* z, const float* g, int gw, int NGW, int lane) {
    const f32x4 ga = *((const f32x4*)g + lane * 2), gb = *((const f32x4*)g + lane * 2 + 1);
    pg8::u32x4 o0, z0, o1, z1, o2, z2, o3, z3;
#define GN_LOAD(O, Z, it_) do { if ((it_) < MTOK * 4) { const int m_ = (it_) >> 2, h_ = (it_) & 3; O = *(const pg8::u32x4*)(og + (size_t)m_ * DM + h_ * 512 + lane * 8); Z = *(const pg8::u32x4*)(z + (size_t)m_ * ZA_LD + OFF_GOG + h_ * 512 + lane * 8); } } while (0)
    int it = gw; GN_LOAD(o0, z0, it); GN_LOAD(o1, z1, it + NGW); GN_LOAD(o2, z2, it + 2 * NGW);
    for (; it < MTOK * 4; it += NGW) { GN_LOAD(o3, z3, it + 3 * NGW);
        const int m = it >> 2, h = it & 3; bf16_t* o = og + (size_t)m * DM + h * 512 + lane * 8;
        f32x4 a, b, za, zb; pg8::unpack8(o0, a, b); pg8::unpack8(z0, za, zb);
        float s = (a[0] * a[0] + a[1] * a[1]) + (a[2] * a[2] + a[3] * a[3]) + (b[0] * b[0] + b[1] * b[1]) + (b[2] * b[2] + b[3] * b[3]);
        const float rstd = rsqrtf(wave_sum(s) * (1.f / 512.f) + EPSN);
#pragma unroll
        for (int j = 0; j < 4; ++j) { a[j] = a[j] * rstd * ga[j] * siluf_(za[j]); b[j] = b[j] * rstd * gb[j] * siluf_(zb[j]); }
        *(pg8::u32x4*)o = pg8::pack8(a, b);
        o0 = o1; z0 = z1; o1 = o2; z1 = z2; o2 = o3; z2 = z3; }
#undef GN_LOAD
}
template <bool H2, bool XB>
__device__ __forceinline__ void ph_resnorm(const float* xin, const bf16_t* y, const float* g1, const float* mod, int off_gate, float* xout, const float* g2, int off_shift, int off_scale, bf16_t* h2, int gw, int NGW, int lane, float oscale) {
    constexpr bool XIN16 = XB && !H2;
    pg8::u32x4 yr[4], yn[4]; f32x4 xr[8], xn[8];
#define RN_LOAD(Y, X, m_) do { _Pragma("unroll") for (int j = 0; j < 4; ++j) { const int e = 8 * (lane + 64 * j); Y[j] = *(const pg8::u32x4*)(y + (size_t)(m_) * DM + e); \
        if (XIN16) X[j] = __builtin_bit_cast(f32x4, *(const pg8::u32x4*)((const bf16_t*)xin + (size_t)(m_) * DM + e)); \
        else { X[2 * j] = __builtin_nontemporal_load((const f32x4*)(xin + (size_t)(m_) * DM + e)); X[2 * j + 1] = __builtin_nontemporal_load((const f32x4*)(xin + (size_t)(m_) * DM + e + 4)); } } } while (0)
    int m = gw; if (m < MTOK) RN_LOAD(yr, xr, m);
    for (; m < MTOK; m += NGW) { const int mn = m + NGW; if (mn < MTOK) RN_LOAD(yn, xn, mn);
        const float* mb = mod + (m / SEQ) * 12288;
        f32x4 ya[4], yb[4]; float s = 0.f;
#pragma unroll
        for (int j = 0; j < 4; ++j) { pg8::unpack8(yr[j], ya[j], yb[j]);
            s += (ya[j][0] * ya[j][0] + ya[j][1] * ya[j][1]) + (ya[j][2] * ya[j][2] + ya[j][3] * ya[j][3]) + (yb[j][0] * yb[j][0] + yb[j][1] * yb[j][1]) + (yb[j][2] * yb[j][2] + yb[j][3] * yb[j][3]); }
        const float rstd = rsqrtf(wave_sum(s) * (1.f / DM) + EPSN); float s2 = 0.f;
#pragma unroll
        for (int j = 0; j < 4; ++j) { const int e = 8 * (lane + 64 * j);
            f32x4 xa, xb; if (XIN16) pg8::unpack8(__builtin_bit_cast(pg8::u32x4, xr[j]), xa, xb); else { xa = xr[2 * j]; xb = xr[2 * j + 1]; }
            ya[j] = xa + *(const f32x4*)(mb + off_gate + e) * (ya[j] * rstd * *(const f32x4*)(g1 + e));
            yb[j] = xb + *(const f32x4*)(mb + off_gate + e + 4) * (yb[j] * rstd * *(const f32x4*)(g1 + e + 4));
            if (XB && H2) *(pg8::u32x4*)((bf16_t*)xout + (size_t)m * DM + e) = pg8::pack8(ya[j], yb[j]); else { *(f32x4*)(xout + (size_t)m * DM + e) = ya[j] * oscale; *(f32x4*)(xout + (size_t)m * DM + e + 4) = yb[j] * oscale; }
            s2 += (ya[j][0] * ya[j][0] + ya[j][1] * ya[j][1]) + (ya[j][2] * ya[j][2] + ya[j][3] * ya[j][3]) + (yb[j][0] * yb[j][0] + yb[j][1] * yb[j][1]) + (yb[j][2] * yb[j][2] + yb[j][3] * yb[j][3]); }
        if (H2) { const float r2 = rsqrtf(wave_sum(s2) * (1.f / DM) + EPSN);
#pragma unroll
            for (int j = 0; j < 4; ++j) { const int e = 8 * (lane + 64 * j);
                const f32x4 ha = ya[j] * r2 * *(const f32x4*)(g2 + e) * (1.f + *(const f32x4*)(mb + off_scale + e)) + *(const f32x4*)(mb + off_shift + e);
                const f32x4 hb = yb[j] * r2 * *(const f32x4*)(g2 + e + 4) * (1.f + *(const f32x4*)(mb + off_scale + e + 4)) + *(const f32x4*)(mb + off_shift + e + 4);
                *(pg8::u32x4*)(h2 + (size_t)m * DM + e) = pg8::pack8(ha, hb); } }
#pragma unroll
        for (int j = 0; j < 4; ++j) { yr[j] = yn[j]; xr[2 * j] = xn[2 * j]; xr[2 * j + 1] = xn[2 * j + 1]; } }
#undef RN_LOAD
}
__device__ __forceinline__ void ph_convact(const bf16_t* u, const float* cw, const float* cb, bf16_t* act, int gw, int NGW, int lane) {
    for (int it = gw; it < 256 * 11; it += NGW) { const int r0 = (it / 11) * 32, j = (it % 11) * 512 + 8 * lane;
        f32x4 wa[3][2], wv[3][2];
#pragma unroll
        for (int k = 0; k < 3; ++k) { wa[k][0] = *(const f32x4*)(cw + k * DFF2 + j); wa[k][1] = *(const f32x4*)(cw + k * DFF2 + j + 4); wv[k][0] = *(const f32x4*)(cw + k * DFF2 + DFF + j); wv[k][1] = *(const f32x4*)(cw + k * DFF2 + DFF + j + 4); }
        const f32x4 ba0 = *(const f32x4*)(cb + j), ba1 = *(const f32x4*)(cb + j + 4), bv0 = *(const f32x4*)(cb + DFF + j), bv1 = *(const f32x4*)(cb + DFF + j + 4);
        f32x4 a2[2], a1[2], v2[2], v1[2];
        if (r0 % SEQ == 0) { a2[0] = a2[1] = a1[0] = a1[1] = v2[0] = v2[1] = v1[0] = v1[1] = (f32x4){0.f, 0.f, 0.f, 0.f}; }
        else { pg8::unpack8(*(const pg8::u32x4*)(u + (size_t)(r0 - 2) * DFF2 + j), a2[0], a2[1]); pg8::unpack8(*(const pg8::u32x4*)(u + (size_t)(r0 - 1) * DFF2 + j), a1[0], a1[1]);
               pg8::unpack8(*(const pg8::u32x4*)(u + (size_t)(r0 - 2) * DFF2 + DFF + j), v2[0], v2[1]); pg8::unpack8(*(const pg8::u32x4*)(u + (size_t)(r0 - 1) * DFF2 + DFF + j), v1[0], v1[1]); }
#pragma unroll 4
        for (int r = 0; r < 32; ++r) { const size_t m = (size_t)r0 + r; f32x4 a0[2], v0[2];
            pg8::unpack8(*(const pg8::u32x4*)(u + m * DFF2 + j), a0[0], a0[1]); pg8::unpack8(*(const pg8::u32x4*)(u + m * DFF2 + DFF + j), v0[0], v0[1]);
            f32x4 ca0 = ba0 + wa[0][0] * a2[0] + wa[1][0] * a1[0] + wa[2][0] * a0[0], ca1 = ba1 + wa[0][1] * a2[1] + wa[1][1] * a1[1] + wa[2][1] * a0[1];
            const f32x4 cv0 = bv0 + wv[0][0] * v2[0] + wv[1][0] * v1[0] + wv[2][0] * v0[0], cv1 = bv1 + wv[0][1] * v2[1] + wv[1][1] * v1[1] + wv[2][1] * v0[1];
#pragma unroll
            for (int q = 0; q < 4; ++q) { ca0[q] = gelu_tanh(ca0[q]) * cv0[q]; ca1[q] = gelu_tanh(ca1[q]) * cv1[q]; }
            *(pg8::u32x4*)(act + m * DFF + j) = pg8::pack8(ca0, ca1);
            a2[0] = a1[0]; a2[1] = a1[1]; a1[0] = a0[0]; a1[1] = a0[1]; v2[0] = v1[0]; v2[1] = v1[1]; v1[0] = v0[0]; v1[1] = v0[1]; } }
}
namespace pg8 {
struct EpiU {
    static constexpr bool PERM = true, AFTER_DRAIN = false, APERM = false;
    bf16_t* U;
    __device__ __forceinline__ void operator()(const f32x4 (&acc)[2][2][4][2], const Unit& u, int wr, int wc, int fr, int fq) const {
        const int row0 = u.pm * BM + wr * 64 + fr, c0 = u.pn * 128 + wc * 32 + 8 * fq;
#pragma unroll
        for (int ai = 0; ai < 2; ++ai)
#pragma unroll
            for (int m = 0; m < 4; ++m) { bf16_t* rowp = U + (size_t)(row0 + ai * HALF + m * 16) * DFF2 + c0;
                *(u32x4*)(rowp) = pack8(acc[ai][0][m][0], acc[ai][0][m][1]); *(u32x4*)(rowp + DFF) = pack8(acc[ai][1][m][0], acc[ai][1][m][1]); }
    }
};
}

namespace pg8 {
__device__ __forceinline__ float dpp_shr1(float v) { return __builtin_bit_cast(float, __builtin_amdgcn_update_dpp(0, __builtin_bit_cast(int, v), 0x111, 0xf, 0xf, true)); }
__device__ __forceinline__ float gelu_fast(float a) { const float u2 = a * (1.5957691216057308f + 0.07135481627f * a * a); return a * __builtin_amdgcn_rcpf(1.f + __builtin_amdgcn_exp2f(-1.4426950408889634f * u2)); }
struct EpiConv {
    static constexpr bool PERM = true, AFTER_DRAIN = false, APERM = true;
    bf16_t* act; const float* cw; const float* cb; bf16_t* hlast; float* hfirst; PG8_LAS float* xch;
    __device__ __forceinline__ void operator()(f32x4 (&acc)[2][2][4][2], const Unit& u, int wr, int wc, int fr, int fq) const {
        const int tok0 = u.pm * BM + 128 * wr + 8 * fr, chb = u.pn * 128 + wc * 32 + 8 * fq, colb = u.pn * BM + wc * 32 + 8 * fq;
        f32x4 cwt[8];
#define EC_LOADW(ch_) do { cwt[0] = *(const f32x4*)(cw + (ch_)); cwt[1] = *(const f32x4*)(cw + DFF2 + (ch_)); cwt[2] = *(const f32x4*)(cw + 2 * DFF2 + (ch_)); cwt[3] = *(const f32x4*)(cb + (ch_)); \
        cwt[4] = *(const f32x4*)(cw + DFF + (ch_)); cwt[5] = *(const f32x4*)(cw + DFF2 + DFF + (ch_)); cwt[6] = *(const f32x4*)(cw + 2 * DFF2 + DFF + (ch_)); cwt[7] = *(const f32x4*)(cb + DFF + (ch_)); } while (0)
        EC_LOADW(chb);
        PG8_LAS float* xp = xch + (wc * 4 + fq) * 32;
        if (wr == 0 && fr == 15) {
#pragma unroll
            for (int n = 0; n < 2; ++n)
#pragma unroll
                for (int e = 0; e < 4; ++e) { xp[n * 4 + e] = acc[1][0][2][n][e]; xp[8 + n * 4 + e] = acc[1][0][3][n][e]; xp[16 + n * 4 + e] = acc[1][1][2][n][e]; xp[24 + n * 4 + e] = acc[1][1][3][n][e]; } }
        asm volatile("s_waitcnt lgkmcnt(0)" ::: "memory"); __builtin_amdgcn_s_barrier(); asm volatile("" ::: "memory");
        if (wr == 1 && fr == 15) {
#pragma unroll
            for (int s = 0; s < 2; ++s) { bf16_t* hp = hlast + ((size_t)u.pm * 2 + s) * DFF2 + colb;
                *(u32x4*)(hp) = pack8(acc[1][0][2 + s][0], acc[1][0][2 + s][1]); *(u32x4*)(hp + HALF) = pack8(acc[1][1][2 + s][0], acc[1][1][2 + s][1]); } }
        unsigned keep[8][2];
#pragma unroll
        for (int n = 0; n < 2; ++n) { if (n == 1) EC_LOADW(chb + 4);
            const f32x4 wa0 = cwt[0], wa1 = cwt[1], wa2 = cwt[2], ba = cwt[3], wv0 = cwt[4], wv1 = cwt[5], wv2 = cwt[6], bv = cwt[7];
            f32x4 pa6, pa7, pv6, pv7;
#pragma unroll
            for (int e = 0; e < 4; ++e) { pa6[e] = dpp_shr1(acc[1][0][2][n][e]); pa7[e] = dpp_shr1(acc[1][0][3][n][e]); pv6[e] = dpp_shr1(acc[1][1][2][n][e]); pv7[e] = dpp_shr1(acc[1][1][3][n][e]); }
            if (wr == 1 && fr == 0) {
#pragma unroll
                for (int e = 0; e < 4; ++e) { pa6[e] = xp[n * 4 + e]; pa7[e] = xp[8 + n * 4 + e]; pv6[e] = xp[16 + n * 4 + e]; pv7[e] = xp[24 + n * 4 + e]; } }
            f32x4 a2 = pa6, a1 = pa7, v2 = pv6, v1 = pv7;
#pragma unroll
            for (int s = 0; s < 8; ++s) { const f32x4 a0 = acc[s >> 2][0][s & 3][n], v0 = acc[s >> 2][1][s & 3][n];
                f32x4 ca = ba + wa0 * a2 + wa1 * a1 + wa2 * a0; const f32x4 cv = bv + wv0 * v2 + wv1 * v1 + wv2 * v0;
                if (s < 2 && wr == 0 && fr == 0) { float* hp = hfirst + ((size_t)u.pm * 2 + s) * DFF2 + colb + 4 * n; *(f32x4*)hp = ca; *(f32x4*)(hp + HALF) = cv; }
#pragma unroll
                for (int e = 0; e < 4; ++e) ca[e] = gelu_fast(ca[e]) * cv[e];
                const unsigned lo = cvt_pk_bf16(ca[0], ca[1]), hi = cvt_pk_bf16(ca[2], ca[3]);
                if (n == 0) { keep[s][0] = lo; keep[s][1] = hi; }
                else { u32x4 w; w.x = keep[s][0]; w.y = keep[s][1]; w.z = lo; w.w = hi; *(u32x4*)(act + (size_t)(tok0 + s) * DFF + chb) = w; }
                a2 = a1; a1 = a0; v2 = v1; v1 = v0; } }
#undef EC_LOADW
    }
};
}
namespace pg8 {
struct RowX { float* slots; unsigned* cnt; unsigned* bar; };
__device__ __forceinline__ void rowx_publish(const f32x4 (&acc)[2][2][4][2], const RowX& X, const Unit& u, int wr, int wc, int fr, int fq, PG8_LAS float* part, int tid) {
#pragma unroll
    for (int ai = 0; ai < 2; ++ai)
#pragma unroll
        for (int m = 0; m < 4; ++m) { float s = 0.f;
#pragma unroll
            for (int bj = 0; bj < 2; ++bj)
#pragma unroll
                for (int n = 0; n < 2; ++n) { const f32x4 v = acc[ai][bj][m][n]; s += (v[0] * v[0] + v[1] * v[1]) + (v[2] * v[2] + v[3] * v[3]); }
            part[(wc * 4 + fq) * 272 + wr * 64 + ai * HALF + m * 16 + fr] = s; }
    asm volatile("s_waitcnt lgkmcnt(0)" ::: "memory"); __syncthreads();
    if (tid < 256) { float t = 0.f;
#pragma unroll
        for (int s = 0; s < 16; ++s) t += part[s * 272 + tid];
        __hip_atomic_store(X.slots + ((size_t)u.pm * BM + tid) * 8 + u.pn, t, RLX_AGENT); }
    asm volatile("s_waitcnt vmcnt(0)" ::: "memory"); __syncthreads();
    if (tid == 0) (void)xb_add(X.cnt, 1u);
}
__device__ __forceinline__ void rowx_wait(const RowX& X, const Unit& u, PG8_LAS float* rs, int tid) {
    if (tid == 0) { XB_SPIN(xb_ld(X.cnt) < 8u, X.bar); }
    __syncthreads();
    if (tid < 256) { unsigned* sp = (unsigned*)(X.slots + ((size_t)u.pm * BM + tid) * 8); float t = 0.f;
#pragma unroll
        for (int j = 0; j < 8; ++j) t += __uint_as_float(xb_ld(sp + j));
        rs[tid] = rsqrtf(t * (1.f / DM) + EPSN); }
    asm volatile("s_waitcnt lgkmcnt(0)" ::: "memory"); __syncthreads();
}
struct EpiResOut {
    static constexpr bool PERM = true, AFTER_DRAIN = true, APERM = false;
    const bf16_t* x1b; const float* gate; const float* g; float* out; RowX X; float oscale;
    __device__ __forceinline__ void fused(f32x4 (&acc)[2][2][4][2], const Unit& u, int wr, int wc, int fr, int fq, PG8_LAS unsigned char* lds, int wid, int lane) const {
        const int tid = wid * 64 + lane; PG8_LAS float* part = (PG8_LAS float*)lds; PG8_LAS float* rs = part + 16 * 272;
        rowx_publish(acc, X, u, wr, wc, fr, fq, part, tid);
        const int lrow0 = wr * 64 + fr, row0 = u.pm * BM + lrow0, col0 = u.pn * BM + wc * 32 + 8 * fq; const float* gb = gate + (u.pm / 16) * 12288;
        f32x4 gg[2][2];
#pragma unroll
        for (int bj = 0; bj < 2; ++bj)
#pragma unroll
            for (int n = 0; n < 2; ++n) gg[bj][n] = *(const f32x4*)(gb + col0 + bj * HALF + 4 * n) * *(const f32x4*)(g + col0 + bj * HALF + 4 * n);
        u32x4 xr[2][2][2];
#define RO_LOAD(buf, aq_) do { _Pragma("unroll") for (int mm = 0; mm < 2; ++mm) _Pragma("unroll") for (int bj = 0; bj < 2; ++bj) \
            xr[buf][mm][bj] = *(const u32x4*)(x1b + (size_t)(row0 + ((aq_) >> 1) * HALF + (((aq_) & 1) * 2 + mm) * 16) * DM + col0 + bj * HALF); } while (0)
        RO_LOAD(0, 0);
        rowx_wait(X, u, rs, tid);
#pragma unroll
        for (int aq = 0; aq < 4; ++aq) { const int ai = aq >> 1, mb = (aq & 1) * 2;
            if (aq + 1 < 4) RO_LOAD((aq + 1) & 1, aq + 1);
            __builtin_amdgcn_sched_barrier(0);
#pragma unroll
            for (int mm = 0; mm < 2; ++mm) { const int m = mb + mm, row = row0 + ai * HALF + m * 16; const float r = rs[lrow0 + ai * HALF + m * 16];
#pragma unroll
                for (int bj = 0; bj < 2; ++bj) { f32x4 xa, xb; unpack8(xr[aq & 1][mm][bj], xa, xb); float* op = out + (size_t)row * DM + col0 + bj * HALF;
                    *(f32x4*)op = (xa + gg[bj][0] * (acc[ai][bj][m][0] * r)) * oscale; *(f32x4*)(op + 4) = (xb + gg[bj][1] * (acc[ai][bj][m][1] * r)) * oscale; } }
            __builtin_amdgcn_sched_barrier(0); }
#undef RO_LOAD
    }
};
struct EpiResMid {
    static constexpr bool PERM = true, AFTER_DRAIN = true, APERM = false;
    const float* x; const float* mod; const float* g1; const float* g2; bf16_t* x1b; bf16_t* h2; RowX X1, X2;
    __device__ __forceinline__ void fused(f32x4 (&acc)[2][2][4][2], const Unit& u, int wr, int wc, int fr, int fq, PG8_LAS unsigned char* lds, int wid, int lane) const {
        const int tid = wid * 64 + lane; PG8_LAS float* part = (PG8_LAS float*)lds; PG8_LAS float* rs = part + 16 * 272;
        rowx_publish(acc, X1, u, wr, wc, fr, fq, part, tid);
        const int lrow0 = wr * 64 + fr, row0 = u.pm * BM + lrow0, col0 = u.pn * BM + wc * 32 + 8 * fq; const float* mb_ = mod + (u.pm / 16) * 12288;
        { f32x4 gg[2][2];
#pragma unroll
          for (int bj = 0; bj < 2; ++bj)
#pragma unroll
              for (int n = 0; n < 2; ++n) gg[bj][n] = *(const f32x4*)(mb_ + 4096 + col0 + bj * HALF + 4 * n) * *(const f32x4*)(g1 + col0 + bj * HALF + 4 * n);
          f32x4 xr[2][2][2];
#define RM_LOAD(buf, aq_) do { _Pragma("unroll") for (int bj = 0; bj < 2; ++bj) { const float* xp = x + (size_t)(row0 + ((aq_) >> 2) * HALF + ((aq_) & 3) * 16) * DM + col0 + bj * HALF; \
              xr[buf][bj][0] = __builtin_nontemporal_load((const f32x4*)xp); xr[buf][bj][1] = __builtin_nontemporal_load((const f32x4*)xp + 1); } } while (0)
          RM_LOAD(0, 0);
          rowx_wait(X1, u, rs, tid);
#pragma unroll
          for (int aq = 0; aq < 8; ++aq) { const int ai = aq >> 2, m = aq & 3;
              if (aq + 1 < 8) RM_LOAD((aq + 1) & 1, aq + 1);
              __builtin_amdgcn_sched_barrier(0);
              const float r = rs[lrow0 + ai * HALF + m * 16];
#pragma unroll
              for (int bj = 0; bj < 2; ++bj)
#pragma unroll
                  for (int n = 0; n < 2; ++n) acc[ai][bj][m][n] = xr[aq & 1][bj][n] + gg[bj][n] * (acc[ai][bj][m][n] * r);
              __builtin_amdgcn_sched_barrier(0); } }
#undef RM_LOAD
        __syncthreads();
        rowx_publish(acc, X2, u, wr, wc, fr, fq, part, tid);
#pragma unroll
        for (int ai = 0; ai < 2; ++ai)
#pragma unroll
            for (int m = 0; m < 4; ++m)
#pragma unroll
                for (int bj = 0; bj < 2; ++bj) *(u32x4*)(x1b + (size_t)(row0 + ai * HALF + m * 16) * DM + col0 + bj * HALF) = pack8(acc[ai][bj][m][0], acc[ai][bj][m][1]);
        rowx_wait(X2, u, rs, tid);
#pragma unroll
        for (int bj = 0; bj < 2; ++bj) { f32x4 gs[2], sh[2];
#pragma unroll
            for (int n = 0; n < 2; ++n) { const int c = col0 + bj * HALF + 4 * n; gs[n] = *(const f32x4*)(g2 + c) * (1.f + *(const f32x4*)(mb_ + 8192 + c)); sh[n] = *(const f32x4*)(mb_ + 6144 + c); }
#pragma unroll
            for (int ai = 0; ai < 2; ++ai)
#pragma unroll
                for (int m = 0; m < 4; ++m) { const float r = rs[lrow0 + ai * HALF + m * 16];
                    *(u32x4*)(h2 + (size_t)(row0 + ai * HALF + m * 16) * DM + col0 + bj * HALF) = pack8(acc[ai][bj][m][0] * r * gs[0] + sh[0], acc[ai][bj][m][1] * r * gs[1] + sh[1]); } }
    }
};
}
__device__ __forceinline__ void ph_convfix(const bf16_t* hlast, const float* hfirst, const float* cw, bf16_t* act, int pm, int wave, int lane) {
    if (pm % 16 == 0) return;
    for (int it = wave; it < 2 * 22; it += 8) { const int s = it / 22, seg = it % 22;
        const int ch = seg * 256 + 4 * lane, pn = ch >> 7, col = pn * 256 + (ch & 127);
        f32x4 ca = *(const f32x4*)(hfirst + ((size_t)pm * 2 + s) * DFF2 + col), cv = *(const f32x4*)(hfirst + ((size_t)pm * 2 + s) * DFF2 + col + 128);
        const bf16_t* h0 = hlast + ((size_t)(pm - 1) * 2) * DFF2 + col; const bf16_t* h1 = h0 + DFF2;
        const uint2 a0r = *(const uint2*)h0, a1r = *(const uint2*)h1, v0r = *(const uint2*)(h0 + 128), v1r = *(const uint2*)(h1 + 128);
        f32x4 a0, a1, v0, v1;
        a0[0] = __uint_as_float(a0r.x << 16); a0[1] = __uint_as_float(a0r.x & 0xffff0000u); a0[2] = __uint_as_float(a0r.y << 16); a0[3] = __uint_as_float(a0r.y & 0xffff0000u);
        a1[0] = __uint_as_float(a1r.x << 16); a1[1] = __uint_as_float(a1r.x & 0xffff0000u); a1[2] = __uint_as_float(a1r.y << 16); a1[3] = __uint_as_float(a1r.y & 0xffff0000u);
        v0[0] = __uint_as_float(v0r.x << 16); v0[1] = __uint_as_float(v0r.x & 0xffff0000u); v0[2] = __uint_as_float(v0r.y << 16); v0[3] = __uint_as_float(v0r.y & 0xffff0000u);
        v1[0] = __uint_as_float(v1r.x << 16); v1[1] = __uint_as_float(v1r.x & 0xffff0000u); v1[2] = __uint_as_float(v1r.y << 16); v1[3] = __uint_as_float(v1r.y & 0xffff0000u);
        const f32x4 wa0 = *(const f32x4*)(cw + ch), wa1 = *(const f32x4*)(cw + DFF2 + ch), wv0 = *(const f32x4*)(cw + DFF + ch), wv1 = *(const f32x4*)(cw + DFF2 + DFF + ch);
        if (s == 0) { ca += wa0 * a0 + wa1 * a1; cv += wv0 * v0 + wv1 * v1; } else { ca += wa0 * a1; cv += wv0 * v1; }
#pragma unroll
        for (int e = 0; e < 4; ++e) ca[e] = pg8::gelu_fast(ca[e]) * cv[e];
        uint2 w; w.x = pg8::cvt_pk_bf16(ca[0], ca[1]); w.y = pg8::cvt_pk_bf16(ca[2], ca[3]);
        *(uint2*)(act + ((size_t)pm * 256 + s) * DFF + ch) = w; }
}
namespace att {
typedef short bf16x8 __attribute__((ext_vector_type(8)));
typedef short s16x4 __attribute__((ext_vector_type(4)));
typedef float f32x16 __attribute__((ext_vector_type(16)));
typedef __attribute__((address_space(3))) const unsigned char* lcp;
constexpr int KROW = 400, VROW = 320, KBYTES = 64 * KROW, VBYTES = 64 * VROW, BUFB = KBYTES + VBYTES;
constexpr size_t WS_ATTP = 108 * MiB, WS_ATTML = 68 * MiB + 512 * 1024;
__device__ __forceinline__ int crow(int r, int hi) { return (r & 3) + 8 * (r >> 2) + 4 * hi; }
__device__ __forceinline__ s16x4 vtr(lcp p) { typedef short v4i16_t __attribute__((ext_vector_type(4))); return __builtin_bit_cast(s16x4, __builtin_amdgcn_ds_read_tr16_b64_v4i16((__attribute__((address_space(3))) v4i16_t*)p)); }
__device__ __forceinline__ float hswap_max(float x) { auto rr = __builtin_amdgcn_permlane32_swap(__float_as_uint(x), __float_as_uint(x), false, false); return fmaxf(__uint_as_float(rr[0]), __uint_as_float(rr[1])); }
__device__ __forceinline__ float hswap_add(float x) { auto rr = __builtin_amdgcn_permlane32_swap(__float_as_uint(x), __float_as_uint(x), false, false); return __uint_as_float(rr[0]) + __uint_as_float(rr[1]); }
__device__ __forceinline__ bf16x8 packp(const f32x16& p, int b) { pg8::u32x4 w; w.x = pg8::cvt_pk_bf16(p[b], p[b + 1]); w.y = pg8::cvt_pk_bf16(p[b + 2], p[b + 3]); w.z = pg8::cvt_pk_bf16(p[b + 4], p[b + 5]); w.w = pg8::cvt_pk_bf16(p[b + 6], p[b + 7]); return __builtin_bit_cast(bf16x8, w); }

__device__ __forceinline__ void segment(LAS unsigned char* L, const bf16_t* Q, const bf16_t* Kf, const bf16_t* V, int b, int h, int qblk, int t0, int t1, bf16_t* outp, int ostride, float2* ml, int wave, int lane_) {
    const int tid = fresh_tid(), lane = tid & 63, r32 = lane & 31, hh = lane >> 5;
    const size_t rowbase = (size_t)b * SEQ; const int R0 = qblk * 256, qrow = R0 + 32 * wave + r32;
    bf16x8 qf[12];
    { const bf16_t* qp = Q + (rowbase + qrow) * 1536 + h * 192 + 8 * hh;
#pragma unroll
      for (int d0 = 0; d0 < 12; ++d0) qf[d0] = *(const bf16x8*)(qp + 16 * d0); }
    f32x16 O[4];
#pragma unroll
    for (int d0 = 0; d0 < 4; ++d0)
#pragma unroll
        for (int r = 0; r < 16; ++r) O[d0][r] = 0.f;
    float m = -1e30f, l = 0.f;
    const int srow = tid >> 3, sch = tid & 7;
    const int kgo = srow * 1536 + sch * 8, klo = srow * KROW + sch * 16, vgo = srow * 1024 + sch * 8, vlo = KBYTES + srow * VROW + sch * 16;
    const bf16_t* Kh = Kf + rowbase * 1536 + h * 192; const bf16_t* Vh = V + rowbase * 1024 + h * 128;
    pg8::u32x4 skA[3], svA[2], skB[3], svB[2];
#define ATT_LOAD(sk, sv, t) do { _Pragma("unroll") for (int i = 0; i < 3; ++i) sk[i] = *(const pg8::u32x4*)(Kh + (size_t)(t) * 64 * 1536 + kgo + 64 * i); \
                         _Pragma("unroll") for (int i = 0; i < 2; ++i) sv[i] = *(const pg8::u32x4*)(Vh + (size_t)(t) * 64 * 1024 + vgo + 64 * i); } while (0)
#define ATT_WRITE(sk, sv, buf) do { _Pragma("unroll") for (int i = 0; i < 3; ++i) *(LAS pg8::u32x4*)(L + (buf) * BUFB + klo + 128 * i) = sk[i]; \
                            _Pragma("unroll") for (int i = 0; i < 2; ++i) *(LAS pg8::u32x4*)(L + (buf) * BUFB + vlo + 128 * i) = sv[i]; } while (0)
    typedef __attribute__((address_space(3))) const bf16x8* lfp;
#define AT_SB() __builtin_amdgcn_sched_barrier(0)
#define AT_RDK(dst, d0) do { dst[0] = *(lfp)(ka + (d0) * 32); dst[1] = *(lfp)(ka + 32 * KROW + (d0) * 32); dst[2] = *(lfp)(ka + ((d0) + 1) * 32); dst[3] = *(lfp)(ka + 32 * KROW + ((d0) + 1) * 32); } while (0)
#define AT_MMK(src, d0) do { p0 = __builtin_amdgcn_mfma_f32_32x32x16_bf16(src[0], qf[d0], p0, 0, 0, 0); p1 = __builtin_amdgcn_mfma_f32_32x32x16_bf16(src[1], qf[d0], p1, 0, 0, 0); \
            p0 = __builtin_amdgcn_mfma_f32_32x32x16_bf16(src[2], qf[(d0) + 1], p0, 0, 0, 0); p1 = __builtin_amdgcn_mfma_f32_32x32x16_bf16(src[3], qf[(d0) + 1], p1, 0, 0, 0); } while (0)
#define AT_RDV(dst, d0) do { _Pragma("unroll") for (int ks = 0; ks < 4; ++ks) { const s16x4 lo_ = vtr(va + (16 * ks) * VROW + 64 * (d0)), hi_ = vtr(va + (16 * ks + 8) * VROW + 64 * (d0)); \
            dst[ks] = (bf16x8){lo_[0], lo_[1], lo_[2], lo_[3], hi_[0], hi_[1], hi_[2], hi_[3]}; } } while (0)
#define AT_MMV(src, d0) do { _Pragma("unroll") for (int ks = 0; ks < 4; ++ks) O[d0] = __builtin_amdgcn_mfma_f32_32x32x16_bf16(src[ks], pf[ks], O[d0], 0, 0, 0); } while (0)
#define AT_PV(slot) do { lcp va = (lcp)(L + (slot) * BUFB + KBYTES) + (4 * hh + ((lane & 15) >> 2)) * VROW + (16 * ((lane >> 4) & 1) + 4 * (lane & 3)) * 2; bf16x8 v0[4], v1[4]; \
            AT_RDV(v0, 0); AT_SB(); AT_RDV(v1, 1); AT_SB(); AT_MMV(v0, 0); AT_SB(); AT_RDV(v0, 2); AT_SB(); AT_MMV(v1, 1); AT_SB(); AT_RDV(v1, 3); AT_SB(); AT_MMV(v0, 2); AT_SB(); AT_MMV(v1, 3); AT_SB(); } while (0)
    const bool lag = wave >= 4; bool pend = false; int pslot = 0; bf16x8 pf[4];
    constexpr int AHEAD = 1;
    ATT_LOAD(skA, svA, t0); ATT_WRITE(skA, svA, 0);
    if (AHEAD == 2 && t0 + 1 < t1) ATT_LOAD(skB, svB, t0 + 1);
    __syncthreads();
    int cur = 0;
    auto step = [&](const int t, pg8::u32x4 (&lk)[3], pg8::u32x4 (&lv)[2], pg8::u32x4 (&wk)[3], pg8::u32x4 (&wv)[2]) __attribute__((always_inline)) {
        const bool more = (t + 1 < t1);
        if (t + AHEAD < t1) ATT_LOAD(lk, lv, t + AHEAD);
        if (lag && pend) { AT_PV(pslot); pend = false; }
        if (64 * t <= R0 + 32 * wave + 31) {
            lcp Kb = (lcp)(L + cur * BUFB);
            f32x16 p0, p1;
#pragma unroll
            for (int r = 0; r < 16; ++r) { p0[r] = 0.f; p1[r] = 0.f; }
            lcp ka = Kb + r32 * KROW + hh * 16;
            { bf16x8 fa[4], fb[4];
              AT_RDK(fa, 0); AT_SB();
              AT_RDK(fb, 2); AT_SB(); AT_MMK(fa, 0); AT_SB();
              AT_RDK(fa, 4); AT_SB(); AT_MMK(fb, 2); AT_SB();
              AT_RDK(fb, 6); AT_SB(); AT_MMK(fa, 4); AT_SB();
              AT_RDK(fa, 8); AT_SB(); AT_MMK(fb, 6); AT_SB();
              AT_RDK(fb, 10); AT_SB(); AT_MMK(fa, 8); AT_SB();
              AT_MMK(fb, 10); AT_SB(); }
            if (64 * t + 63 > R0 + 32 * wave) {
                const float NEG = -__builtin_inff();
#pragma unroll
                for (int r = 0; r < 16; ++r) { const int key = 64 * t + crow(r, hh); if (key > qrow) p0[r] = NEG; if (key + 32 > qrow) p1[r] = NEG; }
            }
            float mxa[4];
#pragma unroll
            for (int q = 0; q < 4; ++q) mxa[q] = fmaxf(p0[q], p1[q]);
#pragma unroll
            for (int r = 4; r < 16; ++r) mxa[r & 3] = fmaxf(mxa[r & 3], fmaxf(p0[r], p1[r]));
            float mx = fmaxf(fmaxf(mxa[0], mxa[1]), fmaxf(mxa[2], mxa[3]));
            mx = hswap_max(mx);
            if (__any(mx > m + 8.f)) { const float mn = fmaxf(m, mx), alpha = __builtin_amdgcn_exp2f(m - mn); m = mn; l *= alpha;
#pragma unroll
                for (int d0 = 0; d0 < 4; ++d0)
#pragma unroll
                    for (int r = 0; r < 16; ++r) O[d0][r] *= alpha; }
            float psa[4] = {0.f, 0.f, 0.f, 0.f};
#pragma unroll
            for (int r = 0; r < 16; ++r) { p0[r] = __builtin_amdgcn_exp2f(p0[r] - m); p1[r] = __builtin_amdgcn_exp2f(p1[r] - m); psa[r & 3] += p0[r] + p1[r]; }
            l += (psa[0] + psa[1]) + (psa[2] + psa[3]);
            pf[0] = packp(p0, 0); pf[1] = packp(p0, 8); pf[2] = packp(p1, 0); pf[3] = packp(p1, 8);
            AT_SB();
            if (lag) { pend = true; pslot = cur; } else AT_PV(cur);
        }
        const int nx = cur == 2 ? 0 : cur + 1;
        if (more) ATT_WRITE(wk, wv, nx);
        __syncthreads();
        cur = nx;
    };
    if (AHEAD == 2) { for (int t = t0; t < t1; t += 2) { step(t, skA, svA, skB, svB); if (t + 1 < t1) step(t + 1, skB, svB, skA, svA); } }
    else { for (int t = t0; t < t1; ++t) step(t, skA, svA, skA, svA); }
    if (lag && pend) AT_PV(pslot);
#undef AT_PV
#undef AT_SB
#undef AT_RDK
#undef AT_MMK
#undef AT_RDV
#undef AT_MMV
#undef ATT_LOAD
#undef ATT_WRITE
    const float lt = hswap_add(l), inv = lt > 0.f ? 1.f / lt : 0.f;
    bf16_t* op = outp + (size_t)(32 * wave + r32) * ostride + 4 * hh;
#pragma unroll
    for (int d0 = 0; d0 < 4; ++d0)
#pragma unroll
        for (int g = 0; g < 4; ++g) { uint2 w; w.x = pg8::cvt_pk_bf16(O[d0][4 * g] * inv, O[d0][4 * g + 1] * inv); w.y = pg8::cvt_pk_bf16(O[d0][4 * g + 2] * inv, O[d0][4 * g + 3] * inv);
            *(uint2*)(op + 32 * d0 + 8 * g) = w; }
    if (ml && hh == 0) ml[32 * wave + r32] = make_float2(m, lt);
}
constexpr int ATT_NCU = 13;
__device__ __forceinline__ int att_B(int j) {
    constexpr int T[14] = {0, 45, 88, 131, 176, 219, 262, 305, 348, 391, 432, 475, 515, 544};
    int r = T[13];
#pragma unroll
    for (int k = 12; k >= 0; --k) r = (j <= k) ? T[k] : r;
    return r; }
static_assert(ATT_NCU == 13, "att_B table is for 13 CUs per (b,h)");
__device__ __forceinline__ int att_off(int u) { return 64 * u - 2 * u * (u - 1); }
__device__ __forceinline__ void phase(LAS unsigned char* L, const bf16_t* Q, const bf16_t* Kf, const bf16_t* V, bf16_t* om, unsigned char* ws, int bh, int j, int wave, int lane) {
    bf16_t* PO = (bf16_t*)(ws + WS_ATTP); float2* PML = (float2*)(ws + WS_ATTML);
    const int b = bh >> 3, h = bh & 7, lo = att_B(j), hi = att_B(j + 1);
    int pos = lo, u = 0;
    while (att_off(u + 1) <= pos) ++u;
    while (pos < hi) { const int off = att_off(u), n = 4 * (16 - u), t0 = pos - off, t1 = (hi - off < n) ? hi - off : n, qb = 15 - u;
        if (t0 == 0 && t1 == n) segment(L, Q, Kf, V, b, h, qb, 0, n, om + ((size_t)b * SEQ + 256 * qb) * 1024 + h * 128, 1024, nullptr, wave, lane);
        else { const int slot = bh * (2 * ATT_NCU) + (t0 > 0 ? 2 * j - 1 : 2 * j);
            segment(L, Q, Kf, V, b, h, qb, t0, t1, PO + (size_t)slot * 256 * 128, 128, PML + slot * 256, wave, lane); }
        pos = off + t1; ++u; }
}
constexpr int CB_ITEMS = 16 * 10 * 64;
__device__ __forceinline__ int cb_unit(int ci) { return ci < 8 ? ci : (ci == 8 ? 10 : 12); }
__device__ __forceinline__ void combine(bf16_t* om, unsigned char* ws, int gw, int NGW, int lane) {
    const bf16_t* PO = (const bf16_t*)(ws + WS_ATTP); const float2* PML = (const float2*)(ws + WS_ATTML);
    const int rsub = lane >> 4, c8 = (lane & 15) * 8;
#define CB_LOAD(NP, ML, POV, DST, it_) do { NP = 0; if ((it_) < CB_ITEMS) { const int q_ = (it_) >> 6, rg = (it_) & 63, bh = q_ / 10, u = cb_unit(q_ - bh * 10), b = bh >> 3, h = bh & 7; \
        const int off = att_off(u), n = 4 * (16 - u); int jf = 0, jl = 0; \
        _Pragma("unroll") for (int jj = 1; jj < ATT_NCU; ++jj) { if (att_B(jj) <= off) jf = jj; if (att_B(jj) < off + n) jl = jj; } \
        if (jf != jl) { const int row = rg * 4 + rsub; NP = jl - jf + 1; DST = om + ((size_t)b * SEQ + 256 * (15 - u) + row) * 1024 + h * 128 + c8; \
            _Pragma("unroll") for (int p = 0; p < 3; ++p) if (jf + p <= jl) { const int jj = jf + p, slot = bh * (2 * ATT_NCU) + (p == 0 ? 2 * jj : 2 * jj - 1); \
                ML[p] = PML[slot * 256 + row]; POV[p] = *(const pg8::u32x4*)(PO + ((size_t)slot * 256 + row) * 128 + c8); } } } } while (0)
    int npA, npB; float2 mlA[3], mlB[3]; pg8::u32x4 poA[3], poB[3]; bf16_t* dA; bf16_t* dB;
#define CB_PROC(NP, ML, POV, DST) do { if (NP) { float mm = ML[0].x; _Pragma("unroll") for (int p = 1; p < 3; ++p) if (p < NP) mm = fmaxf(mm, ML[p].x); \
        f32x4 o0 = {0.f, 0.f, 0.f, 0.f}, o1 = o0; float wsum = 0.f; \
        _Pragma("unroll") for (int p = 0; p < 3; ++p) if (p < NP) { const float w = ML[p].y * __builtin_amdgcn_exp2f(ML[p].x - mm); f32x4 a, c; pg8::unpack8(POV[p], a, c); o0 += w * a; o1 += w * c; wsum += w; } \
        const float inv = 1.f / wsum; *(pg8::u32x4*)(DST) = pg8::pack8(o0 * inv, o1 * inv); } } while (0)
    int it = gw;
    CB_LOAD(npA, mlA, poA, dA, it);
    for (; it < CB_ITEMS; it += 2 * NGW) {
        CB_LOAD(npB, mlB, poB, dB, it + NGW);
        CB_PROC(npA, mlA, poA, dA);
        CB_LOAD(npA, mlA, poA, dA, it + 2 * NGW);
        CB_PROC(npB, mlB, poB, dB);
    }
#undef CB_LOAD
#undef CB_PROC
}
}
namespace gla {
typedef short bf16x8 __attribute__((ext_vector_type(8)));
typedef float f32x16 __attribute__((ext_vector_type(16)));
typedef __attribute__((address_space(3))) const unsigned char* lcp;
constexpr size_t WS_IMG = 32 * MiB, WS_VT = 252 * MiB;
constexpr int IMG_STRIDE = 73728;
constexpr int PROW = 528;
constexpr int L_GL = 0, L_TOT = 4096, L_BLAST = 5120, L_QB = 8192, L_KB = L_QB + 64 * PROW, L_VS = L_KB + 64 * PROW;
__device__ __forceinline__ int crow(int r, int hi) { return (r & 3) + 8 * (r >> 2) + 4 * hi; }
__device__ __forceinline__ unsigned pk(float lo, float hi) { return pg8::cvt_pk_bf16(lo, hi); }
__device__ __forceinline__ bf16x8 packs(const f32x16& p, int b) { pg8::u32x4 w; w.x = pk(p[b], p[b + 1]); w.y = pk(p[b + 2], p[b + 3]); w.z = pk(p[b + 4], p[b + 5]); w.w = pk(p[b + 6], p[b + 7]); return __builtin_bit_cast(bf16x8, w); }

__device__ __forceinline__ void prep_item(LAS unsigned char* L, const bf16_t* z, const float* wg, const float* bg, unsigned char* ws, int bh, int c, int wave, int lane_) {
    const int tid = fresh_tid(), lane = tid & 63, b = bh >> 2, h = bh & 3; const size_t rb = (size_t)b * SEQ + 64 * c; const int ic = bh * 64 + c;
    unsigned char* img = ws + WS_IMG + (size_t)ic * IMG_STRIDE; bf16_t* vT = (bf16_t*)(ws + WS_VT);
    LAS float* GL = (LAS float*)(L + L_GL); LAS float* TOT = (LAS float*)(L + L_TOT); LAS float* BLAST = (LAS float*)(L + L_BLAST);
    pg8::u32x4 rq[4], rk[4], rv[4];
#pragma unroll
    for (int i = 0; i < 4; ++i) { const int q = tid + 512 * i, tok = q >> 5, ch = q & 31; rq[i] = *(const pg8::u32x4*)(z + (rb + tok) * ZB_LD + OFF_GQ + h * 256 + ch * 8); rk[i] = *(const pg8::u32x4*)(z + (rb + tok) * ZB_LD + OFF_GK + h * 256 + ch * 8);
        rv[i] = *(const pg8::u32x4*)(z + (rb + tok) * ZB_LD + OFF_GV + h * 512 + ch * 8); }
    for (int i = 0; i < 2; ++i) { const int idx = tid + 512 * i, tok = idx >> 4, r = idx & 15; GL[idx] = bf2f(z[(rb + tok) * ZB_LD + OFF_GLR + r]); }
    __syncthreads();
    const int d = tid & 255, half = tid >> 8;
    float wgc[16];
#pragma unroll
    for (int r = 0; r < 16; ++r) wgc[r] = wg[r * 1024 + h * 256 + d];
    const float bias = bg[h * 256 + d];
    float bl[32]; float run = 0.f;
#pragma unroll
    for (int i = 0; i < 32; ++i) { const int tok = 32 * half + i; float xg = bias;
#pragma unroll
        for (int r = 0; r < 16; ++r) xg += GL[tok * 16 + r] * wgc[r];
        const float ls = fminf(xg, 0.f) - __logf(1.f + __expf(-fabsf(xg)));
        run += ls * (1.f / 16.f); bl[i] = run; }
    if (half == 0) TOT[d] = run;
#pragma unroll
    for (int i = 0; i < 4; ++i) { const int q = tid + 512 * i, tok = q >> 5, ch = q & 31; *(LAS pg8::u32x4*)(L + L_QB + tok * PROW + ch * 16) = rq[i]; *(LAS pg8::u32x4*)(L + L_KB + tok * PROW + ch * 16) = rk[i]; *(LAS pg8::u32x4*)(L + L_VS + tok * PROW + ch * 16) = rv[i];
        rv[i] = *(const pg8::u32x4*)(z + (rb + tok) * ZB_LD + OFF_GV + h * 512 + 256 + ch * 8); }
    __syncthreads();
    if (half == 1) { const float t0 = TOT[d];
#pragma unroll
        for (int i = 0; i < 32; ++i) bl[i] += t0;
        BLAST[d] = bl[31]; }
    __syncthreads();
    const float blast = BLAST[d];
    if (half == 0) *(float*)(img + 70 * 1024 + d * 4) = __expf(blast);
#pragma unroll
    for (int g = 0; g < 4; ++g) { float klv[8];
#pragma unroll
        for (int j = 0; j < 8; ++j) { const int i = 8 * g + j, tok = 32 * half + i;
            const float qv = bf2f(*(const LAS bf16_t*)(L + L_QB + tok * PROW + d * 2)), kv = bf2f(*(const LAS bf16_t*)(L + L_KB + tok * PROW + d * 2));
            *(LAS bf16_t*)(L + L_QB + tok * PROW + d * 2) = f2bf(qv * 0.0625f * __expf(bl[i]));
            *(LAS bf16_t*)(L + L_KB + tok * PROW + d * 2) = f2bf(kv * __expf(-bl[i]));
            klv[j] = kv * __expf(blast - bl[i]); }
        pg8::u32x4 w; w.x = pk(klv[0], klv[1]); w.y = pk(klv[2], klv[3]); w.z = pk(klv[4], klv[5]); w.w = pk(klv[6], klv[7]);
        *(pg8::u32x4*)(img + (38 + (d >> 4) * 2 + half) * 1024 + (g * 16 + (d & 15)) * 16) = w; }
    __syncthreads();
#pragma unroll
    for (int i = 0; i < 4; ++i) { const int q = tid + 512 * i, tok = q >> 5, ch = q & 31, t = ch >> 2, gq = ch & 3;
        typedef unsigned u32x2_t __attribute__((ext_vector_type(2)));
        const u32x2_t lo = *(const LAS u32x2_t*)(L + L_QB + tok * PROW + (32 * t + 4 * gq) * 2), hi = *(const LAS u32x2_t*)(L + L_QB + tok * PROW + (32 * t + 16 + 4 * gq) * 2);
        pg8::u32x4 w; w.x = lo.x; w.y = lo.y; w.z = hi.x; w.w = hi.y;
        *(pg8::u32x4*)(img + ((tok >> 4) * 8 + t) * 1024 + (gq * 16 + (tok & 15)) * 16) = w; }
    if (wave < 4) { const int ti = wave >> 1, tj = wave & 1, r32 = lane & 31, hh = lane >> 5; f32x16 C;
#pragma unroll
        for (int r = 0; r < 16; ++r) C[r] = 0.f;
        if (tj <= ti) { lcp ka = (lcp)(L + L_KB + (32 * tj + r32) * PROW + hh * 16); lcp qa = (lcp)(L + L_QB + (32 * ti + r32) * PROW + hh * 16);
#pragma unroll
            for (int s = 0; s < 16; ++s) { const bf16x8 kf = *(const __attribute__((address_space(3))) bf16x8*)(ka + s * 32), qf = *(const __attribute__((address_space(3))) bf16x8*)(qa + s * 32);
                C = __builtin_amdgcn_mfma_f32_32x32x16_bf16(kf, qf, C, 0, 0, 0); } }
        const int irow = 32 * ti + r32;
#pragma unroll
        for (int g = 0; g < 4; ++g) { float v[4];
#pragma unroll
            for (int q = 0; q < 4; ++q) { const int j = 32 * tj + crow(4 * g + q, hh); v[q] = (j <= irow) ? C[4 * g + q] : 0.f; }
            uint2 w; w.x = pk(v[0], v[1]); w.y = pk(v[2], v[3]);
            const int tt = irow >> 4, P = tt < 2 ? 32 + tt : 34 + (tt - 2) * 2 + tj;
            if (tj <= ti) *(uint2*)(img + P * 1024 + (g * 16 + (irow & 15)) * 16 + hh * 8) = w; } }
    for (int e0 = 0; e0 < 512; e0 += 256) {
        if (e0) {
#pragma unroll
            for (int i = 0; i < 4; ++i) { const int q = tid + 512 * i, tok = q >> 5, ch = q & 31; *(LAS pg8::u32x4*)(L + L_VS + tok * PROW + ch * 16) = rv[i]; }
            __syncthreads(); }
#pragma unroll
        for (int g = 0; g < 4; ++g) { unsigned short t8[8];
#pragma unroll
            for (int j = 0; j < 8; ++j) t8[j] = *(const LAS bf16_t*)(L + L_VS + (32 * half + 8 * g + j) * PROW + d * 2);
            pg8::u32x4 w; w.x = t8[0] | ((unsigned)t8[1] << 16); w.y = t8[2] | ((unsigned)t8[3] << 16); w.z = t8[4] | ((unsigned)t8[5] << 16); w.w = t8[6] | ((unsigned)t8[7] << 16);
            *(pg8::u32x4*)(vT + ((size_t)ic * 512 + e0 + d) * 64 + 32 * half + 8 * g) = w; }
        __syncthreads();
    }
}
__device__ __forceinline__ void prep_phase(LAS unsigned char* L, const bf16_t* z, const float* wg, const float* bg, unsigned char* ws, int vcu, int G, int wave, int lane) {
    for (int it = vcu; it < 512; it += G) prep_item(L, z, wg, bg, ws, it >> 6, it & 63, wave, lane);
}
typedef float f32x4a __attribute__((ext_vector_type(4)));
constexpr int SC_NP = 71, SC_BUF = SC_NP * 1024;
template <int MODE>
__device__ __forceinline__ void scan_chunk(LAS unsigned char* L, f32x4a (&S)[16], const bf16x8 vf0, const bf16x8 vf1, const int c, bf16_t* ogp, const int lane, const int g4) {
        const int buf = c & 1;
        lcp F = (lcp)(L + buf * SC_BUF + lane * 16);
#define SC_FRAG(p) (*(const __attribute__((address_space(3))) bf16x8*)(F + (p) * 1024))
        f32x4a OT[4];
#pragma unroll
        for (int tt = 0; tt < 4; ++tt) OT[tt] = (f32x4a){0.f, 0.f, 0.f, 0.f};
#define SC_SB() __builtin_amdgcn_sched_barrier(0)
#define SC_RDQ(dst, t) do { _Pragma("unroll") for (int tt = 0; tt < 4; ++tt) dst[tt] = SC_FRAG(tt * 8 + (t)); } while (0)
#define SC_SF(t) ({ pg8::u32x4 w_; w_.x = pk(S[2 * (t)][0], S[2 * (t)][1]); w_.y = pk(S[2 * (t)][2], S[2 * (t)][3]); w_.z = pk(S[2 * (t) + 1][0], S[2 * (t) + 1][1]); w_.w = pk(S[2 * (t) + 1][2], S[2 * (t) + 1][3]); __builtin_bit_cast(bf16x8, w_); })
#define SC_MMQ(src, t) do { const bf16x8 sf_ = SC_SF(t); __builtin_amdgcn_s_setprio(1); _Pragma("unroll") for (int tt = 0; tt < 4; ++tt) OT[tt] = __builtin_amdgcn_mfma_f32_16x16x32_bf16(sf_, src[tt], OT[tt], 0, 0, 0); __builtin_amdgcn_s_setprio(0); } while (0)
        { bf16x8 qa[4], qb_[4], fa[6];
          SC_RDQ(qa, 0); SC_SB();
#pragma unroll
          for (int t = 0; t < 8; t += 2) { SC_RDQ(qb_, t + 1); SC_SB(); SC_MMQ(qa, t); SC_SB();
              if (t + 2 < 8) { SC_RDQ(qa, t + 2); } else {
#pragma unroll
                  for (int k = 0; k < 6; ++k) fa[k] = SC_FRAG(32 + k); }
              SC_SB(); SC_MMQ(qb_, t + 1); SC_SB(); }
          OT[0] = __builtin_amdgcn_mfma_f32_16x16x32_bf16(vf0, fa[0], OT[0], 0, 0, 0);
          OT[1] = __builtin_amdgcn_mfma_f32_16x16x32_bf16(vf0, fa[1], OT[1], 0, 0, 0);
          OT[2] = __builtin_amdgcn_mfma_f32_16x16x32_bf16(vf0, fa[2], OT[2], 0, 0, 0); OT[2] = __builtin_amdgcn_mfma_f32_16x16x32_bf16(vf1, fa[3], OT[2], 0, 0, 0);
          OT[3] = __builtin_amdgcn_mfma_f32_16x16x32_bf16(vf0, fa[4], OT[3], 0, 0, 0); OT[3] = __builtin_amdgcn_mfma_f32_16x16x32_bf16(vf1, fa[5], OT[3], 0, 0, 0); }
        const __attribute__((address_space(3))) float* E = (const __attribute__((address_space(3))) float*)(L + buf * SC_BUF + 70 * 1024);
#define SC_RDK(kd, ed, q) do { _Pragma("unroll") for (int i_ = 0; i_ < 4; ++i_) { kd[2 * i_] = SC_FRAG(38 + ((q) * 4 + i_) * 2); kd[2 * i_ + 1] = SC_FRAG(39 + ((q) * 4 + i_) * 2); \
            ed[i_] = *(const __attribute__((address_space(3))) f32x4a*)(E + 16 * ((q) * 4 + i_) + 4 * g4); } } while (0)
#define SC_UPD(kd, ed, q) do { _Pragma("unroll") for (int i_ = 0; i_ < 4; ++i_) { const int dt_ = (q) * 4 + i_; S[dt_] = S[dt_] * ed[i_]; } __builtin_amdgcn_s_setprio(1); \
            _Pragma("unroll") for (int i_ = 0; i_ < 4; ++i_) { const int dt_ = (q) * 4 + i_; S[dt_] = __builtin_amdgcn_mfma_f32_16x16x32_bf16(kd[2 * i_], vf0, S[dt_], 0, 0, 0); S[dt_] = __builtin_amdgcn_mfma_f32_16x16x32_bf16(kd[2 * i_ + 1], vf1, S[dt_], 0, 0, 0); } __builtin_amdgcn_s_setprio(0); } while (0)
        { bf16x8 ka[8], kb_[8]; f32x4a ea[4], eb_[4];
          SC_RDK(ka, ea, 0); SC_SB();
#pragma unroll
          for (int tt = 0; tt < 4; ++tt) { uint2 w; w.x = pk(OT[tt][0], OT[tt][1]); w.y = pk(OT[tt][2], OT[tt][3]);
              if (MODE != 2 || c < 1) *(uint2*)(ogp + (size_t)(64 * c + 16 * tt) * DM) = w; }
          SC_RDK(kb_, eb_, 1); SC_SB(); SC_UPD(ka, ea, 0); SC_SB();
          SC_RDK(ka, ea, 2); SC_SB(); SC_UPD(kb_, eb_, 1); SC_SB();
          SC_RDK(kb_, eb_, 3); SC_SB(); SC_UPD(ka, ea, 2); SC_SB();
          SC_UPD(kb_, eb_, 3); }
#undef SC_SB
#undef SC_RDQ
#undef SC_SF
#undef SC_MMQ
#undef SC_RDK
#undef SC_UPD
#undef SC_FRAG
}
template <int MODE>
__device__ __forceinline__ void scan_phase(LAS unsigned char* L, unsigned char* ws, bf16_t* og, int bh, int sub, int wave, int lane_) {
    const int lane = fresh_tid() & 63;
    const bf16_t* vT = (const bf16_t*)(ws + WS_VT);
    const int nsl = sub < 2 ? 6 : 5, slice = (sub < 2 ? 6 * sub : 12 + 5 * (sub - 2)) + wave, b = bh >> 2, h = bh & 3, l15 = lane & 15, g4 = lane >> 4; const bool comp = wave < nsl;
    const unsigned char* img = ws + WS_IMG + (size_t)bh * 64 * IMG_STRIDE + lane * 16;
#define SC_BARRIER() do { asm volatile("" ::: "memory"); __builtin_amdgcn_s_barrier(); asm volatile("" ::: "memory"); } while (0)
    if (!comp) { const int dw = wave - nsl, ndma = 8 - nsl;
#define SC_DMA(c, buf) do { for (int p = dw; p < SC_NP; p += ndma) \
        __builtin_amdgcn_global_load_lds((const unsigned*)(img + (size_t)(c) * IMG_STRIDE + p * 1024), (LAS unsigned*)(L + (buf) * SC_BUF + p * 1024), 16, 0, 0); } while (0)
        SC_DMA(0, 0); asm volatile("s_waitcnt vmcnt(0)" ::: "memory"); SC_BARRIER();
        for (int c = 0; c < 64; ++c) { if (c + 1 < 64 && (MODE != 1 || c < 1)) SC_DMA(c + 1, (c & 1) ^ 1); asm volatile("s_waitcnt vmcnt(0)" ::: "memory"); SC_BARRIER(); }
#undef SC_DMA
        return; }
    f32x4a S[16];
#pragma unroll
    for (int dt = 0; dt < 16; ++dt) S[dt] = (f32x4a){0.f, 0.f, 0.f, 0.f};
    const bf16_t* vbase = vT + ((size_t)bh * 64 * 512 + 16 * slice + l15) * 64 + 8 * g4;
    bf16x8 va0 = *(const bf16x8*)(vbase), va1 = *(const bf16x8*)(vbase + 32);
    { pg8::u32x4 t0 = __builtin_bit_cast(pg8::u32x4, va0), t1 = __builtin_bit_cast(pg8::u32x4, va1); asm volatile("" : "+v"(t0), "+v"(t1)); va0 = __builtin_bit_cast(bf16x8, t0); va1 = __builtin_bit_cast(bf16x8, t1); }
    SC_BARRIER();
    bf16_t* ogp = og + ((size_t)b * SEQ + l15) * DM + h * 512 + 16 * slice + 4 * g4;
    for (int c = 0; c < 64; c += 2) {
        bf16x8 vb0 = *(const bf16x8*)(vbase + (size_t)(c + 1) * 512 * 64), vb1 = *(const bf16x8*)(vbase + (size_t)(c + 1) * 512 * 64 + 32);
        scan_chunk<MODE>(L, S, va0, va1, c, ogp, lane, g4);
        SC_BARRIER();
        { const int cn = c + 2 < 64 ? c + 2 : 63; va0 = *(const bf16x8*)(vbase + (size_t)cn * 512 * 64); va1 = *(const bf16x8*)(vbase + (size_t)cn * 512 * 64 + 32); }
        scan_chunk<MODE>(L, S, vb0, vb1, c + 1, ogp, lane, g4);
        SC_BARRIER();
    }
#undef SC_BARRIER
}
}
#ifndef EXTRA_BARRIERS
#define EXTRA_BARRIERS 0
#endif
#ifndef STAMP_Q
#define STAMP_Q 10.f
#endif
#ifndef DBG_STAMP
#define DBG_STAMP 0
#endif
#ifndef REP0_PART
#define REP0_PART 0
#endif
#ifndef REP5_ROLE
#define REP5_ROLE 0
#endif
#ifndef REPEAT_MASK
#define REPEAT_MASK 0u
#endif
#ifndef SCAN_DIAG
#define SCAN_DIAG 0
#endif
#ifndef DBG_SCAN
#define DBG_SCAN 0
#endif
#if DBG_SCAN
#define DBG_SCAN_OUT ((bf16_t*)(ws + WS_Q))
#else
#define DBG_SCAN_OUT og
#endif
constexpr size_t WS_HLAST = 1 * MiB + 512 * 1024, WS_HFIRST = 4 * MiB;
constexpr size_t WS_RX = 7 * MiB;
constexpr int CW_RX = 24576;
constexpr int WUP_EARLY = 1792, WUP_SCAN = 384;
constexpr size_t WS_WUP = 376 * MiB, WS_WDN = 134 * MiB;
__global__ void __launch_bounds__(NWAVES * 64, 2) mk_fwd(Args args) {
    extern __shared__ __attribute__((aligned(16))) unsigned char lds[];
    LAS unsigned char* L = (LAS unsigned char*)lds;
    volatile LAS unsigned* MISC = (volatile LAS unsigned*)(L + MISC_OFF);
    const int tid = threadIdx.x, wave = __builtin_amdgcn_readfirstlane(tid >> 6);
#define FL (fresh_tid() & 63)
#define STAMPP_BEGIN(ph) unsigned long long tsp_##ph = 0; if (DBG_STAMP == 10 + (ph) && bx == 0) tsp_##ph = __builtin_amdgcn_s_memrealtime();
#define STAMPP_END(ph) do { if (DBG_STAMP == 10 + (ph) && bx == 0) { __syncthreads(); if (threadIdx.x == 0) { const float us_ = STAMP_Q * (float)(int)((float)(__builtin_amdgcn_s_memrealtime() - tsp_##ph) * 0.01f / STAMP_Q + 0.5f); __hip_atomic_store((unsigned*)(ctl + 512), __float_as_uint(us_), RLX_AGENT); } } } while (0)
#define STAMP_BEGIN(id, cond) unsigned long long ts_##id = 0; if (DBG_STAMP == (id) && (cond)) ts_##id = __builtin_amdgcn_s_memrealtime();
#define STAMP_END(id, cond) do { if (DBG_STAMP == (id) && (cond)) { __syncthreads(); if (threadIdx.x == 0) { const float us_ = STAMP_Q * (float)(int)((float)(__builtin_amdgcn_s_memrealtime() - ts_##id) * 0.01f / STAMP_Q + 0.5f);     __hip_atomic_store((unsigned*)(ctl + 512), __float_as_uint(us_), RLX_AGENT); } } } while (0)
    const int G = gridDim.x, bx = blockIdx.x; const int vcu = (G % 8 == 0) ? (bx % 8) * (G / 8) + bx / 8 : bx;
    const int gw = vcu * NWAVES + wave, NGW = G * NWAVES;
    unsigned char* ws = args.ws;
    gu32* ctl = (gu32*)(ws + WS_CTL);
    for (int u = tid; u < (LDS_BYTES - LDSCTL_OFF) / 4; u += NWAVES * 64) ((LAS unsigned*)(L + LDSCTL_OFF))[u] = 0u;
    __syncthreads();
    XcdBarrier bar = xcd_barrier_post((unsigned*)(ctl + CW_BAR), MISC + 8);
    const int lo = args.ph_lo, hi = args.ph_hi;
#define IN(k) (lo <= (k) && (k) < hi)
#define SEAM(k) do { if (IN(k) && IN((k) + 1)) { unsigned long long tb_ = 0; if (DBG_STAMP == 40 + (k) && bx == 0) tb_ = __builtin_amdgcn_s_memrealtime(); xcd_barrier(bar); \
        if (DBG_STAMP == 40 + (k) && bx == 0 && threadIdx.x == 0) { const float us_ = STAMP_Q * (float)(int)((float)(__builtin_amdgcn_s_memrealtime() - tb_) * 0.01f / STAMP_Q + 0.5f); __hip_atomic_store((unsigned*)(ctl + 512), __float_as_uint(us_), RLX_AGENT); } } } while (0)
    const float* x = (const float*)args.in[0]; float* out = args.out;
    float* mod = (float*)(ws + WS_MOD); float2* cs = (float2*)(ws + WS_CS);
    float* statq = (float*)(ws + WS_RSTD); float* statkv = statq + MTOK * 8;
    bf16_t* hbuf = (bf16_t*)(ws + WS_H); bf16_t* zA = (bf16_t*)(ws + WS_ZA); bf16_t* zB = (bf16_t*)(ws + WS_ZB);
    bf16_t* Win_t = (bf16_t*)(ws + WS_WIN); bf16_t* Wq_t = (bf16_t*)(ws + WS_WQ); bf16_t* Wkv_t = (bf16_t*)(ws + WS_WKV);
    bf16_t* Wa_t = (bf16_t*)(ws + WS_WA); bf16_t* Wb_t = (bf16_t*)(ws + WS_WB); bf16_t* Wmix_t = (bf16_t*)(ws + WS_WMIX);
    bf16_t* Wup_t = (bf16_t*)(ws + WS_WUP); bf16_t* Wdn_t = (bf16_t*)(ws + WS_WDN);
    bf16_t* Q = (bf16_t*)(ws + WS_Q); bf16_t* Kf = (bf16_t*)(ws + WS_K); bf16_t* V = (bf16_t*)(ws + WS_V);
    bf16_t* om = (bf16_t*)(ws + WS_OM); bf16_t* og = (bf16_t*)(ws + WS_OG); bf16_t* t1 = (bf16_t*)(ws + WS_T1); bf16_t* merged = (bf16_t*)(ws + WS_MERGED);
    bf16_t* y = (bf16_t*)(ws + WS_Y); bf16_t* h2 = (bf16_t*)(ws + WS_H); bf16_t* act = (bf16_t*)(ws + WS_ACT_N); bf16_t* f = (bf16_t*)(ws + WS_F); bf16_t* x1b = (bf16_t*)(ws + WS_F);

    STAMPP_BEGIN(0);
    for (int rep_ = 0; rep_ < 1 + (int)((REPEAT_MASK >> 0) & 1u); ++rep_) if (IN(0)) { const int lane = FL;
        if (rep_ == 0 || REP0_PART == 1) p0_ada((const float*)args.in[1], (const float*)args.in[3], (const float*)args.in[4], mod, (LAS float*)L, vcu, wave, FL);
        LAS float* scr = (LAS float*)(L + wave * 16640);
        int cursor = 0;
        if (rep_ == 0 || REP0_PART == 3) tr_matrix((const float*)args.in[6], DM, DIN, LDZ, Win_t, scr, cursor, gw, NGW, lane, ScIn{}, nullptr, 1.f);
    }
    STAMPP_END(0); SEAM(0);
    STAMPP_BEGIN(1);
    for (int rep_ = 0; rep_ < 1 + (int)((REPEAT_MASK >> 1) & 1u); ++rep_) if (IN(1)) {
        const float* g = (const float*)args.in[5]; const int lane = FL;
        f32x4 v[8], vn[8];
        int m = gw; if (m < MTOK) {
#pragma unroll
            for (int j = 0; j < 8; ++j) v[j] = __builtin_nontemporal_load((const f32x4*)(x + (size_t)m * DM) + lane + 64 * j); }
        for (; m < MTOK; m += NGW) { const int b = m / SEQ, mn = m + NGW;
            if (mn < MTOK) {
#pragma unroll
                for (int j = 0; j < 8; ++j) vn[j] = __builtin_nontemporal_load((const f32x4*)(x + (size_t)mn * DM) + lane + 64 * j); }
            float s = 0.f;
#pragma unroll
            for (int j = 0; j < 8; ++j) s += (v[j].x * v[j].x + v[j].y * v[j].y) + (v[j].z * v[j].z + v[j].w * v[j].w);
            const float rstd = rsqrtf(wave_sum(s) * (1.f / DM) + EPSN);
            const f32x4* gp = (const f32x4*)g + lane; const f32x4* shp = (const f32x4*)(mod + b * 12288) + lane; const f32x4* scp = (const f32x4*)(mod + b * 12288 + 2048) + lane;
            unsigned long long* o8 = (unsigned long long*)(hbuf + (size_t)m * DM) + lane;
#pragma unroll
            for (int j = 0; j < 8; ++j) { const f32x4 r = v[j] * rstd * gp[64 * j] * (1.f + scp[64 * j]) + shp[64 * j];
                o8[64 * j] = (unsigned long long)pk2(r.x, r.y) | ((unsigned long long)pk2(r.z, r.w) << 32); }
#pragma unroll
            for (int j = 0; j < 8; ++j) v[j] = vn[j]; }
    }
    STAMPP_END(1); SEAM(1);
    STAMPP_BEGIN(2);
    for (int rep_ = 0; rep_ < 1 + (int)((REPEAT_MASK >> 2) & 1u); ++rep_) if (IN(2)) {
        pg8::Gemm g{hbuf, Win_t, MTOK, LDZ, DM, DM}; pg8::StaticOrder S; S.init(MTOK, LDZ, G, bx);
        pg8::EpiZ E{zA, zB, statq, statkv};
        pg8::gemm_phase<pg8::EpiZ, pg8::StaticOrder, true, true>(L, g, S, E);
        if (rep_ == 0 && G == 256 && bx >= 128) { const int lane = FL, sgw = (bx - 128) * NWAVES + wave, SNGW = 128 * NWAVES; LAS float* scr = (LAS float*)(L + wave * 16640); int cursor = 0;
            p0_cs((const int*)args.in[2], cs, sgw, SNGW, lane);
            tr_matrix((const float*)args.in[8], 512, 1536, 1536, Wq_t, scr, cursor, sgw, SNGW, lane, ScQ{}, (const float*)args.in[7], QK_C2);
            tr_matrix((const float*)args.in[10], 256, 2048, 2048, Wkv_t, scr, cursor, sgw, SNGW, lane, ScNat{2048}, (const float*)args.in[9], 1.f);
            tr_matrix((const float*)args.in[14], 1024, DM, DM, Wa_t, scr, cursor, sgw, SNGW, lane, ScNat{DM}, nullptr, 1.f);
            tr_matrix((const float*)args.in[15], DM, DM, DM, Wb_t, scr, cursor, sgw, SNGW, lane, ScNat{DM}, nullptr, 1.f);
            tr_matrix((const float*)args.in[16], DM, DM, DM, Wmix_t, scr, cursor, sgw, SNGW, lane, ScNat{DM}, nullptr, 1.f);
            tr_matrix((const float*)args.in[19], DM, DFF2, DFF2, Wup_t, scr, cursor, sgw, SNGW, lane, ScUp{}, nullptr, 1.f, 0, WUP_EARLY); }
    }
    STAMPP_END(2); SEAM(2);
    STAMPP_BEGIN(3);
    for (int rep_ = 0; rep_ < 1 + (int)((REPEAT_MASK >> 3) & 1u); ++rep_) if (IN(3)) {
        { pg8::Gemm g{zB + OFF_QLAT, Wq_t, MTOK, 1536, 512, ZB_LD}; pg8::StaticOrder S; S.init(MTOK, 1536, G, bx);
          pg8::EpiQo E{Q, statq, cs}; pg8::gemm_phase<pg8::EpiQo, pg8::StaticOrder, true, true>(L, g, S, E); }
        { pg8::Gemm g{zB + OFF_KVLAT, Wkv_t, MTOK, 2048, 256, ZB_LD}; pg8::StaticOrder S; S.init(MTOK, 2048, G, bx);
          pg8::EpiKVo E{Kf, V, statkv}; pg8::gemm_phase<pg8::EpiKVo, pg8::StaticOrder, true, true>(L, g, S, E); }
        ph_kpe(zB, Kf, cs, gw, NGW, FL);
    }
    STAMPP_END(3);
    STAMPP_BEGIN(4);
    for (int rep_ = 0; rep_ < 1 + (int)((REPEAT_MASK >> 4) & 1u); ++rep_) if (IN(4)) gla::prep_phase(L, zB, (const float*)args.in[11], (const float*)args.in[12], ws, vcu, G, wave, FL);
    STAMPP_END(4); SEAM(4);
    STAMPP_BEGIN(5);
    for (int rep_ = 0; rep_ < 1 + (int)((REPEAT_MASK >> 5) & 1u); ++rep_) if (IN(5)) {
        const int xg = vcu >> 5, jj = vcu & 31;
        if (G != 256) {   }
        else if (jj < 6) {
#if SCAN_DIAG
            { STAMP_BEGIN(4, vcu == 0) gla::scan_phase<SCAN_DIAG>(L, ws, DBG_SCAN_OUT, xg, jj, wave, FL); STAMP_END(4, vcu == 0); __syncthreads(); }
#endif
            STAMP_BEGIN(2, vcu == 0) if (rep_ == 0 || REP5_ROLE != 2) gla::scan_phase<0>(L, ws, DBG_SCAN_OUT, xg, jj, wave, FL); STAMP_END(2, vcu == 0);
            if (rep_ == 0) { __syncthreads(); const int lane = FL, sgw = (xg * 6 + jj) * NWAVES + wave, SNGW = 48 * NWAVES; LAS float* scr = (LAS float*)(L + wave * 16640); int cursor = 0;
                tr_matrix((const float*)args.in[19], DM, DFF2, DFF2, Wup_t, scr, cursor, sgw, SNGW, lane, ScUp{}, nullptr, 1.f, WUP_EARLY, WUP_EARLY + WUP_SCAN); } }
        else { STAMP_BEGIN(1, vcu == 6) STAMP_BEGIN(3, vcu == 6) if (rep_ == 0 || REP5_ROLE != 1) att::phase(L, Q, Kf, V, om, ws, 2 * xg + (jj - 6) / 13, (jj - 6) % 13, wave, FL); STAMP_END(1, vcu == 6);
            if (rep_ == 0) { const int lane = FL, agw = (xg * 26 + (jj - 6)) * NWAVES + wave, ANGW = 208 * NWAVES; LAS float* scr = (LAS float*)(L + wave * 16640); int cursor = 0;
                tr_matrix((const float*)args.in[19], DM, DFF2, DFF2, Wup_t, scr, cursor, agw, ANGW, lane, ScUp{}, nullptr, 1.f, WUP_EARLY + WUP_SCAN, 0x7fffffff); }
            STAMP_END(3, vcu == 6); }
    }
    STAMPP_END(5); SEAM(5);
    STAMPP_BEGIN(7);
    for (int rep_ = 0; rep_ < 1 + (int)((REPEAT_MASK >> 7) & 1u); ++rep_) if (IN(7)) { att::combine(om, ws, gw, NGW, FL); ph_glanorm(og, zA, (const float*)args.in[13], gw, NGW, FL); }
    STAMPP_END(7); SEAM(7);
    STAMPP_BEGIN(8);
    for (int rep_ = 0; rep_ < 1 + (int)((REPEAT_MASK >> 8) & 1u); ++rep_) if (IN(8)) {
        { pg8::Gemm g{om, Wa_t, MTOK, DM, 1024, 1024}; pg8::StaticOrder S; S.init(MTOK, DM, G, bx);
          pg8::EpiGateo E{t1, zA, OFF_GA, nullptr}; pg8::gemm_phase<pg8::EpiGateo, pg8::StaticOrder, true, true>(L, g, S, E); }
        { pg8::Gemm g{og, Wb_t, MTOK, DM, DM, DM}; pg8::StaticOrder S; S.init(MTOK, DM, G, bx);
          pg8::EpiGateo E{merged, zA, OFF_GB, t1}; pg8::gemm_phase<pg8::EpiGateo, pg8::StaticOrder, true, true>(L, g, S, E); }
    }
    STAMPP_END(8); SEAM(8);
    for (int xb_ = 0; xb_ < EXTRA_BARRIERS; ++xb_) xcd_barrier(bar);
    STAMPP_BEGIN(9);
    for (int rep_ = 0; rep_ < 1 + (int)((REPEAT_MASK >> 9) & 1u); ++rep_) if (IN(9) && G == 256) { pg8::Gemm g{merged, Wmix_t, MTOK, DM, DM, DM}; pg8::StaticOrder S; S.init(MTOK, DM, G, bx);
        pg8::Unit u0; (void)S.next(0, u0); float* rx = (float*)(ws + WS_RX); unsigned* cw = (unsigned*)(ctl + CW_RX); unsigned* bw = (unsigned*)(ctl + CW_BAR);
        pg8::EpiResMid E{x, mod, (const float*)args.in[17], (const float*)args.in[18], x1b, h2, pg8::RowX{rx, cw + (rep_ * 96 + u0.pm) * 64, bw}, pg8::RowX{rx + MTOK * 8, cw + (rep_ * 96 + 32 + u0.pm) * 64, bw}};
        pg8::gemm_phase<pg8::EpiResMid, pg8::StaticOrder, true, true>(L, g, S, E); }
    STAMPP_END(9); SEAM(9);
    STAMPP_BEGIN(12);
    for (int rep_ = 0; rep_ < 1 + (int)((REPEAT_MASK >> 12) & 1u); ++rep_) if (IN(12)) { pg8::Gemm g{h2, Wup_t, MTOK, DFF2, DM, DM}; pg8::StaticOrder S; S.init(MTOK, DFF2, G, bx);
        pg8::EpiConv E{act, (const float*)args.in[20], (const float*)args.in[21], (bf16_t*)(ws + WS_HLAST), (float*)(ws + WS_HFIRST), (LAS float*)(L + RING_BYTES)};
        pg8::gemm_phase<pg8::EpiConv, pg8::StaticOrder, true, true>(L, g, S, E);
        if (rep_ == 0 && G == 256 && bx >= 128) { const int lane = FL, sgw = (bx - 128) * NWAVES + wave, SNGW = 128 * NWAVES; LAS float* scr = (LAS float*)(L + wave * 16640); int cursor = 0;
            tr_matrix((const float*)args.in[22], DFF, DM, DM, Wdn_t, scr, cursor, sgw, SNGW, lane, ScNat{DM}, nullptr, 1.f); } }
    STAMPP_END(12); SEAM(12);
    STAMPP_BEGIN(14);
    for (int rep_ = 0; rep_ < 1 + (int)((REPEAT_MASK >> 14) & 1u); ++rep_) if (IN(14) && G == 256) { pg8::Gemm g{act, Wdn_t, MTOK, DM, DFF, DFF}; pg8::StaticOrder S; S.init(MTOK, DM, G, bx);
        { pg8::Unit u0; for (int i = 0; S.next(i, u0); ++i) ph_convfix((const bf16_t*)(ws + WS_HLAST), (const float*)(ws + WS_HFIRST), (const float*)args.in[20], act, u0.pm, wave, FL);
          VM_WAIT(); __syncthreads(); }
        pg8::Unit u1; (void)S.next(0, u1); const float osc = 1.f;
        pg8::EpiResOut E{x1b, mod + 10240, (const float*)args.in[23], out, pg8::RowX{(float*)(ws + WS_RX) + 2 * MTOK * 8, (unsigned*)(ctl + CW_RX) + (rep_ * 96 + 64 + u1.pm) * 64, (unsigned*)(ctl + CW_BAR)}, osc};
        pg8::gemm_phase<pg8::EpiResOut, pg8::StaticOrder, true, true>(L, g, S, E); }
    STAMPP_END(14);
#if DBG_STAMP
    xcd_barrier(bar);
    { const float sc_ = 1.f + 1e-3f * (40.f + __uint_as_float(__hip_atomic_load((unsigned*)(ctl + 512), RLX_AGENT)));     const int lane = FL;
      for (size_t i = (size_t)gw * 64 + lane; i < (size_t)MTOK * DM / 4; i += (size_t)NGW * 64) ((f32x4*)out)[i] *= sc_; }
#endif
#undef IN
#undef SEAM
#undef FL
}

#ifndef OPT_MASK
#define OPT_MASK 0xFFFFu
#endif
static int mk_grid = 0;
static void launch_mk(void* const* d_in, float* out, void* ws, int lo, int hi, hipStream_t stream) {
    if (mk_grid == 0) {
        int dev = 0, cus = 0, per_cu = 0;
        (void)hipGetDevice(&dev); (void)hipDeviceGetAttribute(&cus, hipDeviceAttributeMultiprocessorCount, dev);
        (void)hipFuncSetAttribute((const void*)mk_fwd, hipFuncAttributeMaxDynamicSharedMemorySize, LDS_BYTES);
        (void)hipOccupancyMaxActiveBlocksPerMultiprocessor(&per_cu, (const void*)mk_fwd, NWAVES * 64, LDS_BYTES);
        if (per_cu < 1) { fprintf(stderr, "occupancy query says %d blocks/CU\n", per_cu); per_cu = 1; }
        if (per_cu > 1) per_cu = 1;
        mk_grid = cus * per_cu; (void)hipGetLastError();
    }
    (void)hipMemsetAsync((char*)ws + WS_CTL, 0, 1 * MiB, stream);
    Args a{}; for (int i = 0; i < 24; ++i) a.in[i] = d_in[i]; a.out = out; a.ws = (unsigned char*)ws; a.ph_lo = lo; a.ph_hi = hi;
    void* kargs[] = {&a};
#ifndef MK_COOP
#define MK_COOP 1
#endif
#if MK_COOP
    hipError_t e = hipLaunchCooperativeKernel((const void*)mk_fwd, dim3(mk_grid), dim3(NWAVES * 64), kargs, LDS_BYTES, stream);
#else
    (void)kargs; hipLaunchKernelGGL(mk_fwd, dim3(mk_grid), dim3(NWAVES * 64), LDS_BYTES, stream, a); hipError_t e = hipPeekAtLastError();
#endif
    if (e != hipSuccess) fprintf(stderr, "megakernel launch failed: %s (grid %d)\n", hipGetErrorString(e), mk_grid);
}
extern "C" void kernel_launch(void* const* d_in, const int* in_sizes, int n_in, void* d_out, int out_size, void* d_ws, size_t ws_size, hipStream_t stream) {
    const float* x = (const float*)d_in[0]; const float* c = (const float*)d_in[1]; const int* pos = (const int*)d_in[2];
    const float* w_ada = (const float*)d_in[3]; const float* b_ada = (const float*)d_in[4]; const float* g_pre_mix = (const float*)d_in[5];
    const float* w_in = (const float*)d_in[6]; const float* g_q = (const float*)d_in[7]; const float* w_q_up = (const float*)d_in[8];
    const float* g_kv = (const float*)d_in[9]; const float* w_kv_up = (const float*)d_in[10]; const float* w_gate = (const float*)d_in[11];
    const float* b_gate = (const float*)d_in[12]; const float* g_gla = (const float*)d_in[13]; const float* w_a = (const float*)d_in[14];
    const float* w_b = (const float*)d_in[15]; const float* w_mix = (const float*)d_in[16]; const float* g_post_mix = (const float*)d_in[17];
    const float* g_pre_ffn = (const float*)d_in[18]; const float* w_up = (const float*)d_in[19]; const float* conv_w = (const float*)d_in[20];
    const float* conv_b = (const float*)d_in[21]; const float* w_dn = (const float*)d_in[22]; const float* g_post_ffn = (const float*)d_in[23];
    float* out = (float*)d_out; char* ws = (char*)d_ws;
    if (ws_size < 420 * MiB) { fprintf(stderr, "ws too small: %zu\n", ws_size); return; }
    float* mod = (float*)(ws + WS_MOD); float* rstd = (float*)(ws + WS_RSTD); float2* cs = (float2*)(ws + WS_CS);
    bf16_t* h = (bf16_t*)(ws + WS_H); bf16_t* zA = (bf16_t*)(ws + WS_ZA); bf16_t* z = (bf16_t*)(ws + WS_ZB);   bf16_t* Q = (bf16_t*)(ws + WS_Q); bf16_t* Kf = (bf16_t*)(ws + WS_K); bf16_t* V = (bf16_t*)(ws + WS_V);
    bf16_t* om = (bf16_t*)(ws + WS_OM); bf16_t* og = (bf16_t*)(ws + WS_OG); bf16_t* t1 = (bf16_t*)(ws + WS_T1); bf16_t* merged = (bf16_t*)(ws + WS_MERGED);
    bf16_t* y = (bf16_t*)(ws + WS_Y); bf16_t* h2 = (bf16_t*)(ws + WS_H); bf16_t* act = (bf16_t*)(ws + WS_ACT_N); bf16_t* uq = (bf16_t*)(ws + WS_UQ); bf16_t* f = (bf16_t*)(ws + WS_F);
    int pend_lo = -1, pend_hi = -1;
#define FLUSH() do { if (pend_lo >= 0) { launch_mk(d_in, out, d_ws, pend_lo, pend_hi, stream); pend_lo = -1; } } while (0)
#ifndef MK_SPLIT
#define MK_SPLIT 0
#endif
#define PHASE(p, ...) do { if ((OPT_MASK >> (p)) & 1u) { if (pend_lo >= 0 && (pend_hi != (p) || MK_SPLIT)) FLUSH(); if (pend_lo < 0) pend_lo = (p); pend_hi = (p) + 1; } else { FLUSH(); __VA_ARGS__ } } while (0)
    PHASE(0, { n_mod<<<12288 / 256, 256, 0, stream>>>(c, w_ada, b_ada, mod);
        n_cs<<<MTOK * 32 / 256, 256, 0, stream>>>(pos, cs); });
    PHASE(1, { n_normmod<<<MTOK, 256, 0, stream>>>(x, g_pre_mix, mod, 0, 2048, h); });
    PHASE(2, { n_gemm<EpiStore><<<dim3((DIN + 63) / 64, MTOK / 64), 256, 0, stream>>>(h, DM, w_in, DIN, nullptr, 0, MTOK, DIN, DM, EpiStore{z, ZB_LD, 0});   });
    PHASE(3, { n_latrstd<<<MTOK / 4, 256, 0, stream>>>(z, rstd);
        n_gemm<EpiQ><<<dim3(1536 / 64, MTOK / 64), 256, 0, stream>>>(z + OFF_QLAT, ZB_LD, w_q_up, 1536, g_q, 0, MTOK, 1536, 512, EpiQ{Q, rstd});
        n_rope_q<<<MTOK, 256, 0, stream>>>(Q, cs);
        n_gemm<EpiKV><<<dim3(2048 / 64, MTOK / 64), 256, 0, stream>>>(z + OFF_KVLAT, ZB_LD, w_kv_up, 2048, g_kv, 0, MTOK, 2048, 256, EpiKV{Kf, V, rstd});
        n_rope_k<<<MTOK * 32 / 256, 256, 0, stream>>>(z, Kf, cs); });
    PHASE(4, {  });
    PHASE(5, { n_attn<<<NB * 8 * SEQ, 256, 0, stream>>>(Q, Kf, V, om); });
    PHASE(6, { n_gla<<<64, 256, 0, stream>>>(z, w_gate, b_gate, og); });
#if DBG_SCAN
    FLUSH(); n_gla<<<64, 256, 0, stream>>>(z, w_gate, b_gate, og);
    (void)hipMemsetAsync(ws + WS_MOD + 256 * 1024, 0, 64, stream);
    { unsigned* res = (unsigned*)(ws + WS_MOD + 256 * 1024);
      n_countnf<<<1024, 256, 0, stream>>>(ws + 32 * MiB, (size_t)MTOK * 1024, 0, res + 0);
      n_countnf<<<1024, 256, 0, stream>>>(ws + 48 * MiB, (size_t)MTOK * 1024, 0, res + 1);
      n_countnf<<<1024, 256, 0, stream>>>(ws + 64 * MiB, (size_t)512 * 4096, 0, res + 2);
      n_countnf<<<1024, 256, 0, stream>>>(ws + 68 * MiB, (size_t)512 * 256, 1, res + 3);
      n_countnf<<<1024, 256, 0, stream>>>(ws + 252 * MiB, (size_t)MTOK * 2048, 0, res + 4); }
#endif
    PHASE(7, { n_glanorm<<<MTOK, 256, 0, stream>>>(og, zA, g_gla); });
    PHASE(8, { n_gemm<EpiGate><<<dim3(DM / 64, MTOK / 64), 256, 0, stream>>>(om, 1024, w_a, DM, nullptr, 0, MTOK, DM, 1024, EpiGate{t1, zA, OFF_GA, nullptr});
        n_gemm<EpiGate><<<dim3(DM / 64, MTOK / 64), 256, 0, stream>>>(og, DM, w_b, DM, nullptr, 0, MTOK, DM, DM, EpiGate{merged, zA, OFF_GB, t1}); });
    PHASE(9, { n_gemm<EpiStore><<<dim3(DM / 64, MTOK / 64), 256, 0, stream>>>(merged, DM, w_mix, DM, nullptr, 0, MTOK, DM, DM, EpiStore{y, DM, 0}); });
    PHASE(10, { n_resnorm<<<MTOK, 256, 0, stream>>>(x, y, g_post_mix, mod, 4096, out, g_pre_ffn, 6144, 8192, h2); });
    PHASE(11, {  });
    PHASE(12, { for (int q = 0; q < 4; ++q) { const int q0 = q * 2048, r0 = (q0 % SEQ == 0) ? q0 : q0 - 2, r1 = q0 + 2048;
            n_gemm<EpiStore><<<dim3(DFF2 / 64, (r1 - r0 + 63) / 64), 256, 0, stream>>>(h2, DM, w_up, DFF2, nullptr, r0, r1, DFF2, DM, EpiStore{uq, DFF2, r0});
            n_convact<<<dim3(DFF / 256, 2048), 256, 0, stream>>>(uq, r0, q0, conv_w, conv_b, act); } });
    PHASE(13, {  });
    PHASE(14, { n_gemm<EpiStore><<<dim3(DM / 64, MTOK / 64), 256, 0, stream>>>(act, DFF, w_dn, DM, nullptr, 0, MTOK, DM, DFF, EpiStore{f, DM, 0}); });
    PHASE(15, { n_resnorm<<<MTOK, 256, 0, stream>>>(out, f, g_post_ffn, mod, 10240, out, nullptr, 0, 0, nullptr); });
    FLUSH();
#if DBG_SCAN
    n_scale_bits<<<1024, 256, 0, stream>>>(out, (size_t)MTOK * DM, (const unsigned*)(ws + WS_MOD + 256 * 1024), 5);
#endif
}
```

```cpp
#include <hip/hip_runtime.h>
#include <hip/hip_bf16.h>
#include <cstdint>
#include <cstdio>

typedef unsigned short bf16_t;
constexpr int NB = 2, SEQ = 4096, DM = 2048, MTOK = NB * SEQ;
constexpr int DIN = 11088, LDZ = 11264, ZA_LD = 6144, ZB_LD = 5120;
constexpr int OFF_QLAT = 0, OFF_KVLAT = 512, OFF_KROPE = 768, OFF_GQ = 832, OFF_GK = 1856, OFF_GV = 2880, OFF_GLR = 4928  , OFF_GOG = 0, OFF_GA = 2048, OFF_GB = 4096  ;
constexpr int DFF = 5632, DFF2 = 11264;
constexpr float EPSN = 1e-6f;
constexpr float QK_C2 = 0.07216878364870322f * 1.4426950408889634f;
constexpr size_t MiB = 1u << 20;
constexpr size_t WS_CTL = 0, WS_MOD = 1 * MiB, WS_RSTD = 1 * MiB + 512 * 1024, WS_CS = 2 * MiB, WS_PART = 4 * MiB;
constexpr size_t WS_WQ = 8 * MiB, WS_WKV = 10 * MiB, WS_WA = 12 * MiB, WS_WB = 16 * MiB, WS_WMIX = 24 * MiB;
constexpr size_t WS_WIN = 32 * MiB, WS_ZB = 76 * MiB, WS_ZA = 156 * MiB, WS_H = 252 * MiB, WS_Q = 284 * MiB, WS_K = 308 * MiB, WS_V = 332 * MiB, WS_OM = 348 * MiB, WS_OG = 76 * MiB  , WS_MISC = 396 * MiB;
constexpr size_t WS_MERGED = WS_WIN, WS_Y = 284 * MiB, WS_ACT_N = 284 * MiB  , WS_UQ = 196 * MiB  , WS_F = 196 * MiB, WS_T1 = WS_H;

__device__ __forceinline__ int fresh_tid() { int t = threadIdx.x; asm volatile("" : "+v"(t)); return t; }
__device__ __forceinline__ float bf2f(bf16_t v) { return __uint_as_float(((unsigned)v) << 16); }
__device__ __forceinline__ bf16_t f2bf(float f) { unsigned u = __float_as_uint(f); return (bf16_t)((u + 0x7fffu + ((u >> 16) & 1u)) >> 16); }
__device__ __forceinline__ float sigmoidf_(float x) { return 1.f / (1.f + __expf(-x)); }
__device__ __forceinline__ float siluf_(float x) { return x / (1.f + __expf(-x)); }
__device__ __forceinline__ float gelu_tanh(float a) { const float u = 0.7978845608028654f * (a + 0.044715f * a * a * a); return 0.5f * a * (1.f + tanhf(u)); }
__device__ __forceinline__ int rope_pos(int d) { return d < 32 ? (8 * (d >> 2) + (d & 3)) : (8 * ((d - 32) >> 2) + 4 + (d & 3)); }

__device__ __forceinline__ float block_sum256(float v, float* red) {
#pragma unroll
    for (int o = 32; o > 0; o >>= 1) v += __shfl_xor(v, o);
    __syncthreads();
    if ((threadIdx.x & 63) == 0) red[threadIdx.x >> 6] = v;
    __syncthreads();
    return red[0] + red[1] + red[2] + red[3];
}


__global__ void __launch_bounds__(256) n_cmp(const bf16_t* t, const bf16_t* r, size_t n, unsigned* res) {
    unsigned nf = 0; float md = 0.f, mr = 0.f;
    for (size_t i = (size_t)blockIdx.x * 256 + threadIdx.x; i < n; i += (size_t)gridDim.x * 256) { const float a = bf2f(t[i]), b = bf2f(r[i]);
        if (!(fabsf(a) < 1e30f)) { ++nf; } else md = fmaxf(md, fabsf(a - b)); mr = fmaxf(mr, fabsf(b)); }
    if (nf) atomicAdd(res, nf); atomicMax(res + 1, __float_as_uint(md)); atomicMax(res + 2, __float_as_uint(mr));
}
__global__ void n_scale(float* out, size_t n, const unsigned* res) {
    const float md = __uint_as_float(res[1]), mr = __uint_as_float(res[2]); const float rel = md / fmaxf(mr, 1e-20f);
    int code = rel < 1e-2f ? 0 : rel < 3e-2f ? 1 : rel < 0.1f ? 2 : rel < 0.3f ? 3 : rel < 1.f ? 4 : 5; if (res[0]) code = 6 + (res[0] > 1000u) + (res[0] > 1000000u);
    const float f = 1.f + 0.1f * code;
    for (size_t i = (size_t)blockIdx.x * 256 + threadIdx.x; i < n; i += (size_t)gridDim.x * 256) out[i] *= f;
}

__global__ void __launch_bounds__(256) n_countnf(const void* p, size_t n, int isf32, unsigned* res) {
    unsigned nf = 0;
    for (size_t i = (size_t)blockIdx.x * 256 + threadIdx.x; i < n; i += (size_t)gridDim.x * 256) { const float a = isf32 ? ((const float*)p)[i] : bf2f(((const bf16_t*)p)[i]); if (!(fabsf(a) < 1e30f)) ++nf; }
    if (nf) atomicAdd(res, nf);
}
__global__ void n_scale_bits(float* out, size_t n, const unsigned* res, int nres) {
    int code = 0; for (int k = 0; k < nres; ++k) if (res[k]) code |= 1 << k;
    const float f = 1.f + 0.05f * code;
    for (size_t i = (size_t)blockIdx.x * 256 + threadIdx.x; i < n; i += (size_t)gridDim.x * 256) out[i] *= f;
}
__global__ void __launch_bounds__(256) n_mod(const float* c, const float* w_ada, const float* b_ada, float* mod) {
    __shared__ float ca[2][DM];
    for (int i = threadIdx.x; i < 2 * DM; i += 256) ca[i / DM][i % DM] = siluf_(c[i]);
    __syncthreads();
    const int j = blockIdx.x * 256 + threadIdx.x;
    float a0 = b_ada[j], a1 = a0;
    for (int k = 0; k < DM; ++k) { const float w = w_ada[(size_t)k * 12288 + j]; a0 += ca[0][k] * w; a1 += ca[1][k] * w; }
    mod[j] = a0; mod[12288 + j] = a1;
}
__global__ void __launch_bounds__(256) n_cs(const int* pos, float2* cs) {
    const int idx = blockIdx.x * 256 + threadIdx.x; const int m = idx >> 5, i = idx & 31;
    const float inv = 1.0f / powf(10000.0f, (float)(2 * i) / 64.0f);
    const float ang = (float)pos[m] * inv;
    float s, c; sincosf(ang, &s, &c); cs[idx] = make_float2(c, s);
}
__global__ void __launch_bounds__(256) n_normmod(const float* x, const float* g, const float* mod, int off_shift, int off_scale, bf16_t* h) {
    __shared__ float red[4];
    const int m = blockIdx.x, b = m / SEQ; const float* xr = x + (size_t)m * DM;
    float v[8], s = 0.f;
#pragma unroll
    for (int i = 0; i < 8; ++i) { v[i] = xr[threadIdx.x + i * 256]; s += v[i] * v[i]; }
    const float rstd = rsqrtf(block_sum256(s, red) / DM + EPSN);
#pragma unroll
    for (int i = 0; i < 8; ++i) { const int k = threadIdx.x + i * 256;
        h[(size_t)m * DM + k] = f2bf(v[i] * rstd * g[k] * (1.f + mod[b * 12288 + off_scale + k]) + mod[b * 12288 + off_shift + k]); }
}
template <class Epi>
__global__ void __launch_bounds__(256) n_gemm(const bf16_t* A, int lda, const float* W, int ldw, const float* ks, int M0, int M1, int N, int K, Epi epi) {
    __shared__ float As[16][68]; __shared__ float Ws[16][68];
    const int tx = threadIdx.x & 15, ty = threadIdx.x >> 4;
    const int m0 = M0 + blockIdx.y * 64, n0 = blockIdx.x * 64;
    float acc[4][4];
#pragma unroll
    for (int i = 0; i < 4; ++i)
#pragma unroll
        for (int j = 0; j < 4; ++j) acc[i][j] = 0.f;
    for (int k0 = 0; k0 < K; k0 += 16) {
#pragma unroll
        for (int i = 0; i < 4; ++i) { const int e = threadIdx.x + i * 256, r = e >> 4, kk = e & 15, m = m0 + r;
            float a = (m < M1) ? bf2f(A[(size_t)m * lda + k0 + kk]) : 0.f; if (ks) a *= ks[k0 + kk]; As[kk][r] = a; }
#pragma unroll
        for (int i = 0; i < 4; ++i) { const int e = threadIdx.x + i * 256, kk = e >> 6, cc = e & 63, n = n0 + cc;
            Ws[kk][cc] = (n < N) ? W[(size_t)(k0 + kk) * ldw + n] : 0.f; }
        __syncthreads();
#pragma unroll
        for (int kk = 0; kk < 16; ++kk) {
            float a[4], b[4];
#pragma unroll
            for (int i = 0; i < 4; ++i) { a[i] = As[kk][ty * 4 + i]; b[i] = Ws[kk][tx * 4 + i]; }
#pragma unroll
            for (int i = 0; i < 4; ++i)
#pragma unroll
                for (int j = 0; j < 4; ++j) acc[i][j] += a[i] * b[j];
        }
        __syncthreads();
    }
#pragma unroll
    for (int i = 0; i < 4; ++i)
#pragma unroll
        for (int j = 0; j < 4; ++j) { const int m = m0 + ty * 4 + i, n = n0 + tx * 4 + j; if (m < M1 && n < N) epi(m, n, acc[i][j]); }
}
struct EpiStore { bf16_t* C; int ldc; int row_off; __device__ void operator()(int m, int n, float v) const { C[(size_t)(m - row_off) * ldc + n] = f2bf(v); } };
struct EpiQ { bf16_t* Q; const float* rstd; __device__ void operator()(int m, int n, float v) const { Q[(size_t)m * 1536 + n] = f2bf(v * rstd[m]); } };
struct EpiKV { bf16_t* Kf; bf16_t* V; const float* rstd; __device__ void operator()(int m, int n, float v) const {
    const int h = n >> 8, w = n & 255; v *= rstd[MTOK + m];
    if (w < 128) Kf[(size_t)m * 1536 + h * 192 + w] = f2bf(v); else V[(size_t)m * 1024 + h * 128 + (w - 128)] = f2bf(v); } };
struct EpiGate { bf16_t* C; const bf16_t* z; int goff; const bf16_t* add; __device__ void operator()(int m, int n, float v) const {
    float r = v * sigmoidf_(bf2f(z[(size_t)m * ZA_LD + goff + n])); if (add) r += bf2f(add[(size_t)m * DM + n]); C[(size_t)m * DM + n] = f2bf(r); } };

__global__ void __launch_bounds__(256) n_latrstd(const bf16_t* z, float* rstd) {
    const int m = blockIdx.x * 4 + (threadIdx.x >> 6), lane = threadIdx.x & 63; const bf16_t* zr = z + (size_t)m * ZB_LD;
    float s = 0.f, s2 = 0.f;
    for (int i = lane; i < 512; i += 64) { const float v = bf2f(zr[i]); s += v * v; }
    for (int i = lane; i < 256; i += 64) { const float v = bf2f(zr[512 + i]); s2 += v * v; }
#pragma unroll
    for (int o = 32; o > 0; o >>= 1) { s += __shfl_xor(s, o); s2 += __shfl_xor(s2, o); }
    if (lane == 0) { rstd[m] = rsqrtf(s / 512.f + EPSN); rstd[MTOK + m] = rsqrtf(s2 / 256.f + EPSN); }
}
__global__ void __launch_bounds__(256) n_rope_q(bf16_t* Q, const float2* cs) {
    const int m = blockIdx.x, h = threadIdx.x >> 5, i = threadIdx.x & 31; bf16_t* q = Q + (size_t)m * 1536 + h * 192;
    const float x1 = bf2f(q[128 + i]), x2 = bf2f(q[160 + i]); const float2 c = cs[m * 32 + i];
    float nope[4];
#pragma unroll
    for (int j = 0; j < 4; ++j) nope[j] = bf2f(q[i * 4 + j]);
    __syncthreads();
    q[128 + rope_pos(i)] = f2bf((x1 * c.x - x2 * c.y) * QK_C2); q[128 + rope_pos(32 + i)] = f2bf((x2 * c.x + x1 * c.y) * QK_C2);
#pragma unroll
    for (int j = 0; j < 4; ++j) q[i * 4 + j] = f2bf(nope[j] * QK_C2);
}
__global__ void __launch_bounds__(256) n_rope_k(const bf16_t* z, bf16_t* Kf, const float2* cs) {
    const int idx = blockIdx.x * 256 + threadIdx.x, m = idx >> 5, i = idx & 31; const bf16_t* zr = z + (size_t)m * ZB_LD + OFF_KROPE;
    const float x1 = bf2f(zr[i]), x2 = bf2f(zr[32 + i]); const float2 c = cs[m * 32 + i];
    const bf16_t o1 = f2bf(x1 * c.x - x2 * c.y), o2 = f2bf(x2 * c.x + x1 * c.y);
#pragma unroll
    for (int h = 0; h < 8; ++h) { Kf[(size_t)m * 1536 + h * 192 + 128 + rope_pos(i)] = o1; Kf[(size_t)m * 1536 + h * 192 + 128 + rope_pos(32 + i)] = o2; }
}
__global__ void __launch_bounds__(256) n_attn(const bf16_t* Q, const bf16_t* Kf, const bf16_t* V, bf16_t* O) {
    __shared__ float qs[192]; __shared__ float p[SEQ]; __shared__ float red[4]; __shared__ float op[2][128];
    const int t = blockIdx.x % SEQ, h = (blockIdx.x / SEQ) % 8, b = blockIdx.x / (SEQ * 8); const size_t m = (size_t)b * SEQ + t;
    if (threadIdx.x < 192) qs[threadIdx.x] = bf2f(Q[m * 1536 + h * 192 + threadIdx.x]);
    __syncthreads();
    float mx = -1e30f;
    for (int j = threadIdx.x; j <= t; j += 256) { const bf16_t* kr = Kf + ((size_t)b * SEQ + j) * 1536 + h * 192; float s = 0.f;
        for (int d = 0; d < 192; ++d) s += qs[d] * bf2f(kr[d]);
        p[j] = s; mx = fmaxf(mx, s); }
#pragma unroll
    for (int o = 32; o > 0; o >>= 1) mx = fmaxf(mx, __shfl_xor(mx, o));
    if ((threadIdx.x & 63) == 0) red[threadIdx.x >> 6] = mx;
    __syncthreads();
    mx = fmaxf(fmaxf(red[0], red[1]), fmaxf(red[2], red[3]));
    float l = 0.f;
    for (int j = threadIdx.x; j <= t; j += 256) { const float e = exp2f(p[j] - mx); p[j] = e; l += e; }
    l = block_sum256(l, red);
    const int e = threadIdx.x & 127, g = threadIdx.x >> 7; float acc = 0.f;
    for (int j = g; j <= t; j += 2) acc += p[j] * bf2f(V[((size_t)b * SEQ + j) * 1024 + h * 128 + e]);
    op[g][e] = acc; __syncthreads();
    if (threadIdx.x < 128) O[m * 1024 + h * 128 + threadIdx.x] = f2bf((op[0][threadIdx.x] + op[1][threadIdx.x]) / l);
}
__global__ void __launch_bounds__(256) n_gla(const bf16_t* z, const float* wg, const float* bg, bf16_t* og) {
    constexpr int TS = 8;
    __shared__ float al[TS][256], kk[TS][256], qq[TS][256], vv[TS][64], opart[TS][4][64];
    const int bh = blockIdx.x >> 3, eb = blockIdx.x & 7, b = bh >> 2, h = bh & 3; const int e = threadIdx.x & 63, dg = threadIdx.x >> 6;
    float S[64];
#pragma unroll
    for (int i = 0; i < 64; ++i) S[i] = 0.f;
    for (int t0 = 0; t0 < SEQ; t0 += TS) {
        __syncthreads();
        for (int idx = threadIdx.x; idx < TS * 256; idx += 256) { const int tt = idx >> 8, d = idx & 255; const bf16_t* zr = z + ((size_t)b * SEQ + t0 + tt) * ZB_LD;
            float xg = bg[h * 256 + d];
#pragma unroll
            for (int r = 0; r < 16; ++r) xg += bf2f(zr[OFF_GLR + r]) * wg[r * 1024 + h * 256 + d];
            const float ls = fminf(xg, 0.f) - log1pf(__expf(-fabsf(xg)));
            al[tt][d] = __expf(ls * (1.f / 16.f));
            kk[tt][d] = bf2f(zr[OFF_GK + h * 256 + d]); qq[tt][d] = bf2f(zr[OFF_GQ + h * 256 + d]) * 0.0625f; }
        for (int idx = threadIdx.x; idx < TS * 64; idx += 256) { const int tt = idx >> 6, ee = idx & 63;
            vv[tt][ee] = bf2f(z[((size_t)b * SEQ + t0 + tt) * ZB_LD + OFF_GV + h * 512 + eb * 64 + ee]); }
        __syncthreads();
        for (int tt = 0; tt < TS; ++tt) { const float ve = vv[tt][e]; float o = 0.f;
#pragma unroll
            for (int i = 0; i < 64; ++i) { S[i] = al[tt][dg * 64 + i] * S[i] + kk[tt][dg * 64 + i] * ve; o += qq[tt][dg * 64 + i] * S[i]; }
            opart[tt][dg][e] = o; }
        __syncthreads();
        for (int idx = threadIdx.x; idx < TS * 64; idx += 256) { const int tt = idx >> 6, ee = idx & 63;
            og[((size_t)b * SEQ + t0 + tt) * DM + h * 512 + eb * 64 + ee] = f2bf(opart[tt][0][ee] + opart[tt][1][ee] + opart[tt][2][ee] + opart[tt][3][ee]); }
    }
}
__global__ void __launch_bounds__(256) n_glanorm(bf16_t* og, const bf16_t* z, const float* g) {
    const int m = blockIdx.x, h = threadIdx.x >> 6, lane = threadIdx.x & 63; bf16_t* o = og + (size_t)m * DM + h * 512;
    float v[8], s = 0.f;
#pragma unroll
    for (int i = 0; i < 8; ++i) { v[i] = bf2f(o[lane + i * 64]); s += v[i] * v[i]; }
#pragma unroll
    for (int of = 32; of > 0; of >>= 1) s += __shfl_xor(s, of);
    const float rstd = rsqrtf(s / 512.f + EPSN);
#pragma unroll
    for (int i = 0; i < 8; ++i) { const int ee = lane + i * 64; const float nv = v[i] * rstd * g[ee];
        o[ee] = f2bf(nv * siluf_(bf2f(z[(size_t)m * ZA_LD + OFF_GOG + h * 512 + ee]))); }
}
__global__ void __launch_bounds__(256) n_resnorm(const float* xin, const bf16_t* y, const float* g1, const float* mod, int off_gate, float* xout, const float* g2, int off_shift, int off_scale, bf16_t* h2) {
    __shared__ float red[4];
    const int m = blockIdx.x, b = m / SEQ;
    float yv[8], s = 0.f;
#pragma unroll
    for (int i = 0; i < 8; ++i) { yv[i] = bf2f(y[(size_t)m * DM + threadIdx.x + i * 256]); s += yv[i] * yv[i]; }
    const float rstd = rsqrtf(block_sum256(s, red) / DM + EPSN);
    float xv[8], s2 = 0.f;
#pragma unroll
    for (int i = 0; i < 8; ++i) { const int k = threadIdx.x + i * 256; xv[i] = xin[(size_t)m * DM + k] + mod[b * 12288 + off_gate + k] * (yv[i] * rstd * g1[k]); s2 += xv[i] * xv[i];
        xout[(size_t)m * DM + k] = xv[i]; }
    if (h2) { const float r2 = rsqrtf(block_sum256(s2, red) / DM + EPSN);
#pragma unroll
        for (int i = 0; i < 8; ++i) { const int k = threadIdx.x + i * 256;
            h2[(size_t)m * DM + k] = f2bf(xv[i] * r2 * g2[k] * (1.f + mod[b * 12288 + off_scale + k]) + mod[b * 12288 + off_shift + k]); } }
}
__global__ void __launch_bounds__(256) n_convact(const bf16_t* ubuf, int r0, int q0, const float* cw, const float* cb, bf16_t* act) {
    const int m = q0 + blockIdx.y, t = m % SEQ, j = blockIdx.x * 256 + threadIdx.x;
    float ca = cb[j], cv = cb[DFF + j];
#pragma unroll
    for (int i = 0; i < 3; ++i) { const int tt = t - 2 + i; if (tt >= 0) { const bf16_t* ur = ubuf + (size_t)(m - 2 + i - r0) * DFF2;
        ca += cw[i * DFF2 + j] * bf2f(ur[j]); cv += cw[i * DFF2 + DFF + j] * bf2f(ur[DFF + j]); } }
    act[(size_t)m * DFF + j] = f2bf(gelu_tanh(ca) * cv);
}

namespace pg8 {
#define PG8_LAS __attribute__((address_space(3)))
typedef short bf16x8 __attribute__((ext_vector_type(8)));
typedef float f32x4 __attribute__((ext_vector_type(4)));
typedef unsigned u32x4 __attribute__((ext_vector_type(4)));
constexpr int BM = 256, BK = 64, HALF = 128, HTB = HALF * BK * 2  , STAGE_BYTES = 8 * HTB, NXCD = 8, WGM = 8;

__host__ __device__ __forceinline__ int lds_byte(int r, int c) { const int st = (r >> 4) * 2 + (c >> 5), rr = r & 15, cc = c & 31, ob = rr * 64 + cc * 2; return st * 1024 + (ob ^ (((ob >> 9) & 1) << 5)); }
__host__ __device__ __forceinline__ void stage_rc(int b, int& R, int& C) { const int st = b / 1024, sb = b % 1024, swz = sb ^ (((sb >> 9) & 1) << 5); R = (st >> 1) * 16 + swz / 64; C = (st & 1) * 32 + (swz % 64) / 2; }
__host__ __device__ __forceinline__ int perm32(int rho) { const int n = rho >> 4, i = rho & 15; return 8 * (i >> 2) + 4 * n + (i & 3); }

struct Unit { int pm, pn; };
struct Gemm { const bf16_t* A; const bf16_t* Bt; int M, N, K, lda; };
__host__ __device__ __forceinline__ int arow(int R, bool perm) { return perm ? (128 * (R >> 6) + 8 * (R & 15) + ((R >> 4) & 3)) : R; }
typedef float f32x2c_t __attribute__((ext_vector_type(2))); typedef __bf16 bf16x2c_t __attribute__((ext_vector_type(2)));
__device__ __forceinline__ unsigned cvt_pk_bf16(float lo, float hi) { f32x2c_t v = {lo, hi}; bf16x2c_t b = __builtin_convertvector(v, bf16x2c_t); return __builtin_bit_cast(unsigned, b); }
typedef float f32x2 __attribute__((ext_vector_type(2)));
struct StaticOrder {
    int nM, nN, nwg, G, c;
    __host__ __device__ __forceinline__ void init(int M, int N, int G_, int c_) { nM = M / BM; nN = N / BM; nwg = nM * nN; G = G_; c = c_; }
    __host__ __device__ __forceinline__ bool next(int i, Unit& u) const {
        const long L = (long)i * G + c; if (L >= nwg) return false;
        int wgid = (int)L; { const int q = nwg / NXCD, r = nwg % NXCD, xcd = wgid % NXCD, off = wgid / NXCD; wgid = (xcd < r ? xcd * (q + 1) : r * (q + 1) + (xcd - r) * q) + off; }
        const int nig = WGM * nN, gid = wgid / nig, fm = gid * WGM, gsz = (nM - fm) < WGM ? (nM - fm) : WGM;
        u.pm = fm + ((wgid % nig) % gsz); u.pn = (wgid % nig) / gsz; return true;
    }
    __device__ __forceinline__ void a_ready(const Unit&) const {}
    __device__ __forceinline__ void done(const Unit&) const {}
};
template <class Epi, class Sched, bool ALIGN_EPI = false, bool SP2 = false>
__device__ __forceinline__ void gemm_phase(PG8_LAS unsigned char* lds, const Gemm g, const Sched& S, const Epi& E) {
    const int tid = fresh_tid(), wid = __builtin_amdgcn_readfirstlane(tid >> 6), lane = tid & 63, wr = wid >> 2, wc = wid & 3, fr = lane & 15, fq = lane >> 4;
    const int K = g.K, nt = K / BK;
    unsigned voffA[2], voffB[2];
#pragma unroll
    for (int i = 0; i < 2; ++i) { int R, C; stage_rc(tid * 16 + i * 8192, R, C); const int Rb = Epi::PERM ? ((R & ~31) + perm32(R & 31)) : R;
        voffA[i] = (unsigned)(arow(R, Epi::APERM) * g.lda + C) * 2u; voffB[i] = (unsigned)(Rb * K + C) * 2u; }
    const size_t kstep = (size_t)(BK * 2);
    const size_t hstepA = Epi::APERM ? (size_t)4 * g.lda * 2 : (size_t)HALF * g.lda * 2, hstepB = (size_t)HALF * K * 2;
    const size_t tstepA = (size_t)BM * g.lda * 2, tstepB = 2 * hstepB;
    const unsigned ldsw = (unsigned)wid * 1024u;
    const int aoff = lds_byte(wr * 64 + fr, fq * 8), boff = lds_byte(wc * 32 + fr, fq * 8);
#define PG8_SA(b, h) (((b) * 2 + (h)) * HTB)
#define PG8_SB(b, h) ((4 + (b) * 2 + (h)) * HTB)
#define PG8_STAGE(bufoff, gbase, voff) do { _Pragma("unroll") for (int _i = 0; _i < 2; ++_i) \
        __builtin_amdgcn_global_load_lds((const unsigned*)((const char*)(gbase) + (voff)[_i]), (PG8_LAS unsigned*)(lds + (bufoff) + ldsw + _i * 8192), 16, 0, 0); } while (0)
#define PG8_LDA(dst, b, h) do { _Pragma("unroll") for (int m = 0; m < 4; ++m) _Pragma("unroll") for (int k = 0; k < 2; ++k) dst[m][k] = *(const PG8_LAS bf16x8*)(lds + PG8_SA(b, h) + aoff + m * 2048 + k * 1024); } while (0)
#define PG8_LDB(dst, b, h) do { _Pragma("unroll") for (int n = 0; n < 2; ++n) _Pragma("unroll") for (int k = 0; k < 2; ++k) dst[n][k] = *(const PG8_LAS bf16x8*)(lds + PG8_SB(b, h) + boff + n * 2048 + k * 1024); } while (0)
#define PG8_MMA(ai, bj, At, Bt) do { __builtin_amdgcn_s_setprio(1); _Pragma("unroll") for (int m = 0; m < 4; ++m) _Pragma("unroll") for (int n = 0; n < 2; ++n) _Pragma("unroll") for (int k = 0; k < 2; ++k) \
        acc[ai][bj][m][n] = __builtin_amdgcn_mfma_f32_16x16x32_bf16(Bt[n][k], At[m][k], acc[ai][bj][m][n], 0, 0, 0); __builtin_amdgcn_s_setprio(0); } while (0)
#define PG8_WAIT_V(n) asm volatile("s_waitcnt vmcnt(" #n ")" ::: "memory")
#define PG8_WAIT_L(n) asm volatile("s_waitcnt lgkmcnt(" #n ")" ::: "memory")
#define PG8_BAR __builtin_amdgcn_s_barrier()
#define PG8_SCHED __builtin_amdgcn_sched_barrier(0)
    Unit cur, nxt; int ui = 0;
    if (!S.next(0, cur)) return;
    f32x4 acc[2][2][4][2];
#pragma unroll
    for (int a = 0; a < 2; ++a)
#pragma unroll
        for (int b = 0; b < 2; ++b)
#pragma unroll
            for (int m = 0; m < 4; ++m)
#pragma unroll
                for (int n = 0; n < 2; ++n) acc[a][b][m][n] = (f32x4){0.f, 0.f, 0.f, 0.f};
    bf16x8 At[4][2], B0[2][2], B1[2][2];
    const char* cA = (const char*)g.A + (size_t)cur.pm * tstepA; const char* cB = (const char*)g.Bt + (size_t)cur.pn * tstepB;
    S.a_ready(cur);
    if constexpr (SP2) {
        PG8_STAGE(PG8_SB(0, 0), cB, voffB); PG8_STAGE(PG8_SB(0, 1), cB + hstepB, voffB); PG8_STAGE(PG8_SA(0, 0), cA, voffA); PG8_STAGE(PG8_SA(0, 1), cA + hstepA, voffA);
        if (wr == 1) PG8_BAR;
        PG8_WAIT_V(2); PG8_BAR;
        PG8_STAGE(PG8_SB(1, 0), cB + kstep, voffB); PG8_STAGE(PG8_SA(1, 0), cA + kstep, voffA); PG8_STAGE(PG8_SB(1, 1), cB + hstepB + kstep, voffB);
        PG8_WAIT_V(6); PG8_BAR;
    } else {
        PG8_STAGE(PG8_SB(0, 0), cB, voffB); PG8_STAGE(PG8_SA(0, 0), cA, voffA); PG8_STAGE(PG8_SB(0, 1), cB + hstepB, voffB); PG8_STAGE(PG8_SA(0, 1), cA + hstepA, voffA);
        if (wr == 1) PG8_BAR;
        PG8_WAIT_V(4); PG8_BAR;
        PG8_STAGE(PG8_SB(1, 0), cB + kstep, voffB); PG8_STAGE(PG8_SA(1, 0), cA + kstep, voffA); PG8_STAGE(PG8_SB(1, 1), cB + hstepB + kstep, voffB);
        PG8_WAIT_V(6); PG8_BAR;
    }
    for (;;) {
        const bool has_next = S.next(ui + 1, nxt);
        const char* nA = has_next ? (const char*)g.A + (size_t)nxt.pm * tstepA : cA; const char* nB = has_next ? (const char*)g.Bt + (size_t)nxt.pn * tstepB : cB;
        for (int t = 0; t < nt; t += 2) {
            const bool last = (t == nt - 2);
            const char* a1 = cA + (size_t)(t + 1) * kstep;
            const char* a2 = last ? nA : cA + (size_t)(t + 2) * kstep; const char* b2 = last ? nB : cB + (size_t)(t + 2) * kstep;
            const char* a3 = a2 + kstep; const char* b3 = b2 + kstep;
            if (last && has_next) S.a_ready(nxt);
            if constexpr (SP2) {
            PG8_LDB(B0, 0, 0); PG8_LDB(B1, 0, 1); PG8_SCHED; PG8_LDA(At, 0, 0); PG8_STAGE(PG8_SA(1, 1), a1 + hstepA, voffA);
            PG8_WAIT_V(8); PG8_WAIT_L(0); PG8_BAR; PG8_MMA(0, 0, At, B0); PG8_MMA(0, 1, At, B1); PG8_BAR; PG8_SCHED;
            PG8_LDA(At, 0, 1); PG8_STAGE(PG8_SB(0, 0), b2, voffB); PG8_STAGE(PG8_SB(0, 1), b2 + hstepB, voffB); PG8_STAGE(PG8_SA(0, 0), a2, voffA);
            PG8_WAIT_V(8); PG8_WAIT_L(0); PG8_BAR; PG8_MMA(1, 0, At, B0); PG8_MMA(1, 1, At, B1); PG8_BAR; PG8_SCHED;
            PG8_LDB(B0, 1, 0); PG8_LDB(B1, 1, 1); PG8_SCHED; PG8_LDA(At, 1, 0); PG8_STAGE(PG8_SA(0, 1), a2 + hstepA, voffA);
            PG8_WAIT_V(8); PG8_WAIT_L(0); PG8_BAR; PG8_MMA(0, 0, At, B0); PG8_MMA(0, 1, At, B1); PG8_BAR; PG8_SCHED;
            PG8_LDA(At, 1, 1); PG8_STAGE(PG8_SB(1, 0), b3, voffB); PG8_STAGE(PG8_SB(1, 1), b3 + hstepB, voffB); PG8_STAGE(PG8_SA(1, 0), a3, voffA);
            PG8_WAIT_V(8); PG8_WAIT_L(0); PG8_BAR; PG8_MMA(1, 0, At, B0); PG8_MMA(1, 1, At, B1); PG8_BAR; PG8_SCHED;
            } else {
            PG8_LDB(B0, 0, 0); PG8_SCHED; PG8_LDA(At, 0, 0); PG8_STAGE(PG8_SA(1, 1), a1 + hstepA, voffA);
            PG8_WAIT_L(8); PG8_BAR; PG8_WAIT_L(0); PG8_MMA(0, 0, At, B0); PG8_BAR; PG8_SCHED;
            PG8_LDB(B1, 0, 1); PG8_STAGE(PG8_SB(0, 0), b2, voffB);
            PG8_BAR; PG8_WAIT_L(0); PG8_MMA(0, 1, At, B1); PG8_BAR;
            PG8_LDA(At, 0, 1); PG8_STAGE(PG8_SA(0, 0), a2, voffA);
            PG8_BAR; PG8_WAIT_L(0); PG8_MMA(1, 0, At, B0); PG8_BAR; PG8_SCHED;
            PG8_STAGE(PG8_SB(0, 1), b2 + hstepB, voffB);
            PG8_WAIT_V(6); PG8_BAR; PG8_MMA(1, 1, At, B1); PG8_BAR;
            PG8_LDB(B0, 1, 0); PG8_SCHED; PG8_LDA(At, 1, 0); PG8_STAGE(PG8_SA(0, 1), a2 + hstepA, voffA);
            PG8_WAIT_L(8); PG8_BAR; PG8_WAIT_L(0); PG8_MMA(0, 0, At, B0); PG8_BAR; PG8_SCHED;
            PG8_LDB(B1, 1, 1); PG8_STAGE(PG8_SB(1, 0), b3, voffB);
            PG8_BAR; PG8_WAIT_L(0); PG8_MMA(0, 1, At, B1); PG8_BAR;
            PG8_LDA(At, 1, 1); PG8_STAGE(PG8_SA(1, 0), a3, voffA);
            PG8_BAR; PG8_WAIT_L(0); PG8_MMA(1, 0, At, B0); PG8_BAR; PG8_SCHED;
            PG8_STAGE(PG8_SB(1, 1), b3 + hstepB, voffB);
            PG8_WAIT_V(6); PG8_BAR; PG8_MMA(1, 1, At, B1); PG8_BAR;
            }
        }
        if constexpr (ALIGN_EPI) { if (wr == 0) PG8_BAR; }
        if constexpr (!Epi::AFTER_DRAIN) { E(acc, cur, wr, wc, fr, fq); S.done(cur); }
        if (!has_next) break;
#pragma unroll
        for (int a = 0; a < 2; ++a)
#pragma unroll
            for (int b = 0; b < 2; ++b)
#pragma unroll
                for (int m = 0; m < 4; ++m)
#pragma unroll
                    for (int n = 0; n < 2; ++n) acc[a][b][m][n] = (f32x4){0.f, 0.f, 0.f, 0.f};
        cur = nxt; cA = nA; cB = nB; ++ui;
        if constexpr (ALIGN_EPI) { if (wr == 1) PG8_BAR; }
    }
    PG8_WAIT_V(0);
    if constexpr (!ALIGN_EPI) { if (wr == 0) PG8_BAR; }
    PG8_BAR;
    if constexpr (Epi::AFTER_DRAIN) { E.fused(acc, cur, wr, wc, fr, fq, lds, wid, lane); S.done(cur); }
#undef PG8_SA
#undef PG8_SB
#undef PG8_STAGE
#undef PG8_LDA
#undef PG8_LDB
#undef PG8_MMA
#undef PG8_WAIT_V
#undef PG8_WAIT_L
#undef PG8_BAR
#undef PG8_SCHED
}
}

#define GAS __attribute__((address_space(1)))
#define LAS __attribute__((address_space(3)))
typedef unsigned v4u __attribute__((ext_vector_type(4)));
typedef float f32x4 __attribute__((ext_vector_type(4)));
typedef GAS unsigned gu32;
#define RLX_AGENT __ATOMIC_RELAXED, __HIP_MEMORY_SCOPE_AGENT
#define LDS_WAIT() asm volatile("s_waitcnt lgkmcnt(0)" ::: "memory")
#define VM_WAIT() asm volatile("s_waitcnt vmcnt(0)" ::: "memory")
constexpr int NWAVES = 8;
constexpr int RING_BYTES = 131072, LDS_BYTES = 163840, LDSCTL_OFF = LDS_BYTES - 1024, MISC_OFF = LDSCTL_OFF + 320;
constexpr int CW_BAR = 4096, CW_PROG = 20480  , CW_ADA = 16384  ;
__device__ __forceinline__ unsigned pk2(float lo, float hi) { return (unsigned)f2bf(lo) | ((unsigned)f2bf(hi) << 16); }

#define XB_TMO      128
#define XB_XCNT(j)  (256  + 64 * (j))
#define XB_XSUB(j)  (1280 + 64 * (j))
#define XB_XGEN(j)  (2304 + 64 * (j))
#define XB_TOP      3328
#define XB_TOPGEN   3392
#define XCD_BAR_WORDS 3456
#define XB_SPIN_CAP (1u << 18)

__device__ __forceinline__ unsigned xb_ld(unsigned* p)              { return __hip_atomic_load(p, __ATOMIC_RELAXED, __HIP_MEMORY_SCOPE_AGENT); }
__device__ __forceinline__ unsigned xb_add(unsigned* p, unsigned v) { return __hip_atomic_fetch_add(p, v, __ATOMIC_RELAXED, __HIP_MEMORY_SCOPE_AGENT); }
__device__ __forceinline__ unsigned xb_xcc_id() { return (unsigned)__builtin_amdgcn_s_getreg((3 << 11) | 20) & 0xFu; }
#define XB_SPIN(cond, bar) do { unsigned _sp = 0; while (cond) { __builtin_amdgcn_s_sleep(1); \
    if ((++_sp & 255u) == 0u) { if (xb_ld(&(bar)[XB_TMO])) break; if (_sp > XB_SPIN_CAP) { atomicAdd(&(bar)[XB_TMO], 1u); break; } } } } while (0)

struct XcdBarrier {
    unsigned* bar; unsigned x;
    volatile LAS unsigned* st;
};

__device__ __forceinline__ XcdBarrier xcd_barrier_post(unsigned* bar, volatile LAS unsigned* st) {
    XcdBarrier b; b.bar = bar; b.x = xb_xcc_id(); b.st = st;
    if (threadIdx.x == 0) (void)xb_add(&bar[XB_XCNT(b.x)], 1u);
    return b;
}
__device__ __forceinline__ void xcd_barrier_complete(unsigned* bar, unsigned x, unsigned& nloc, unsigned& nx) {
    const unsigned G = gridDim.x * gridDim.y * gridDim.z;
    unsigned sum, cnt, mine, sp = 0u;
    for (;;) {
        sum = 0u; cnt = 0u; mine = 0u;
#pragma unroll
        for (unsigned j = 0; j < 16; ++j) { const unsigned c = xb_ld(&bar[XB_XCNT(j)]); sum += c; cnt += (c > 0u) ? 1u : 0u; mine = (j == x) ? c : mine; }
        if (sum == G) break;
        __builtin_amdgcn_s_sleep(1);
        if ((++sp & 255u) == 0u) { if (xb_ld(&bar[XB_TMO])) break; if (sp > XB_SPIN_CAP) { atomicAdd(&bar[XB_TMO], 1u); break; } }
    }
    nloc = mine > 0u ? mine : 1u; nx = cnt > 0u ? cnt : 1u;
}

__device__ __forceinline__ void xcd_barrier(const XcdBarrier& b) {
    asm volatile("s_waitcnt vmcnt(0)" ::: "memory");
    __syncthreads();
    if (threadIdx.x == 0) {
        unsigned* bar = b.bar;
        __builtin_amdgcn_s_waitcnt(0);
        unsigned nloc = b.st[0], nx = b.st[1];
        if (nloc == 0u) { xcd_barrier_complete(bar, b.x, nloc, nx); b.st[0] = nloc; b.st[1] = nx; }
        const unsigned old = xb_add(&bar[XB_XSUB(b.x)], 1u);
        const unsigned gen = old / nloc;
        if (old + 1u == (gen + 1u) * nloc) {
            __builtin_amdgcn_fence(__ATOMIC_RELEASE, "agent");
            asm volatile("s_waitcnt vmcnt(0)" ::: "memory");
            const unsigned og = xb_add(&bar[XB_TOP], 1u);
            const unsigned tg = og / nx;
            if (og + 1u == (tg + 1u) * nx) xb_add(&bar[XB_TOPGEN], 1u);
            else XB_SPIN(xb_ld(&bar[XB_TOPGEN]) == tg, bar);
            __builtin_amdgcn_fence(__ATOMIC_ACQUIRE, "agent");
            xb_add(&bar[XB_XGEN(b.x)], 1u);
            asm volatile("s_waitcnt vmcnt(0)" ::: "memory");
        } else {
            XB_SPIN(xb_ld(&bar[XB_XGEN(b.x)]) == gen, bar);
            __builtin_amdgcn_fence(__ATOMIC_ACQUIRE, "agent");
            asm volatile("s_waitcnt vmcnt(0)" ::: "memory");
        }
    }
    __syncthreads();
}


__device__ __forceinline__ float wave_sum(float v) {
#pragma unroll
    for (int o = 1; o < 64; o <<= 1) v += __shfl_xor(v, o);
    return v;
}

struct Args { const void* in[24]; float* out; unsigned char* ws; int ph_lo, ph_hi; };

__device__ __forceinline__ void p0_ada(const float* c, const float* w_ada, const float* b_ada, float* mod, LAS float* lds, int cg, int wave, int lane) {
    if (cg >= 192) return;
    LAS float* ct = lds; LAS float* red = lds + 2 * DM;
    const int tid = wave * 64 + lane;
#pragma unroll
    for (int i = 0; i < 8; ++i) ct[tid + 512 * i] = siluf_(c[tid + 512 * i]);
    LDS_WAIT(); __syncthreads();
    const int r = lane >> 4, c4 = (lane & 15) * 4, k0 = wave * 256 + r;
    f32x4 a0[2] = {{0.f, 0.f, 0.f, 0.f}, {0.f, 0.f, 0.f, 0.f}}, a1[2] = {{0.f, 0.f, 0.f, 0.f}, {0.f, 0.f, 0.f, 0.f}};
    const float* wp = w_ada + (size_t)k0 * 12288 + cg * 64 + c4;
#pragma unroll 16
    for (int i = 0; i < 64; ++i) { const f32x4 w = __builtin_nontemporal_load((const f32x4*)(wp + (size_t)(4 * i) * 12288)); const float s0 = ct[k0 + 4 * i], s1 = ct[DM + k0 + 4 * i];
        a0[i & 1] += s0 * w; a1[i & 1] += s1 * w; }
    f32x4 s0 = a0[0] + a0[1], s1 = a1[0] + a1[1];
#pragma unroll
    for (int e = 0; e < 4; ++e) { s0[e] += __shfl_xor(s0[e], 16); s0[e] += __shfl_xor(s0[e], 32); s1[e] += __shfl_xor(s1[e], 16); s1[e] += __shfl_xor(s1[e], 32); }
    if (lane < 16) { *(LAS f32x4*)(red + (wave * 2 + 0) * 64 + c4) = s0; *(LAS f32x4*)(red + (wave * 2 + 1) * 64 + c4) = s1; }
    LDS_WAIT(); __syncthreads();
    if (tid < 128) { const int b = tid >> 6, l = tid & 63; float s = b_ada[cg * 64 + l];
#pragma unroll
        for (int w = 0; w < 8; ++w) s += red[(w * 2 + b) * 64 + l];
        mod[b * 12288 + cg * 64 + l] = s; }
    __syncthreads();
}
__device__ __forceinline__ void p0_cs(const int* pos, float2* cs, int gw, int NGW, int lane) {
    for (int it = gw; it < MTOK * 32 / 64; it += NGW) { const int idx = it * 64 + lane, m = idx >> 5, i = idx & 31;
        const float inv = 1.0f / powf(10000.0f, (float)(2 * i) / 64.0f); const float ang = (float)pos[m] * inv;
        float s, c; sincosf(ang, &s, &c); cs[idx] = make_float2(c, s); }
}
template <class SrcCol>
__device__ __forceinline__ void tr_load(f32x4 (&v)[16], const float* W, int Nsrc, int kb, int nb, int lane, SrcCol sc) {
    const int k0 = 64 * kb + 8 * (lane >> 3), n0 = 64 * nb + 4 * (lane & 7); const int nc0 = sc(n0), nc1 = sc(n0 + 32);
#pragma unroll
    for (int i = 0; i < 8; ++i) { v[2 * i] = (f32x4){0.f, 0.f, 0.f, 0.f}; v[2 * i + 1] = (f32x4){0.f, 0.f, 0.f, 0.f};
        if (nc0 >= 0) v[2 * i] = __builtin_nontemporal_load((const f32x4*)(W + (size_t)(k0 + i) * Nsrc + nc0));
        if (nc1 >= 0) v[2 * i + 1] = __builtin_nontemporal_load((const f32x4*)(W + (size_t)(k0 + i) * Nsrc + nc1)); }
}
__device__ __forceinline__ void tr_proc(const f32x4 (&v)[16], int K, bf16_t* WT, LAS float* scr, int kb, int nb, int lane, const float* kgain, float scale) {
    const int k0 = 64 * kb + 8 * (lane >> 3), n0 = 64 * nb + 4 * (lane & 7);
    float s[8];
#pragma unroll
    for (int i = 0; i < 8; ++i) s[i] = scale;
    if (kgain) { const f32x4 ga = *(const f32x4*)(kgain + k0), gb = *(const f32x4*)(kgain + k0 + 4);
#pragma unroll
        for (int i = 0; i < 4; ++i) { s[i] *= ga[i]; s[4 + i] *= gb[i]; } }
#pragma unroll
    for (int c = 0; c < 8; ++c) { const int h = c >> 2, e = c & 3;
        v4u o; o.x = pg8::cvt_pk_bf16(v[h][e] * s[0], v[2 + h][e] * s[1]); o.y = pg8::cvt_pk_bf16(v[4 + h][e] * s[2], v[6 + h][e] * s[3]); o.z = pg8::cvt_pk_bf16(v[8 + h][e] * s[4], v[10 + h][e] * s[5]); o.w = pg8::cvt_pk_bf16(v[12 + h][e] * s[6], v[14 + h][e] * s[7]);
        *(v4u*)(WT + (size_t)(n0 + 32 * h + e) * K + k0) = o; }
}
struct ScNat { int N; __device__ int operator()(int n) const { return n < N ? n : -1; } };
struct ScIn { __device__ int operator()(int n) const { return n < 6144 ? 4944 + n : (n < DIN ? n - 6144 : -1); } };
struct ScQ { __device__ int operator()(int n) const { const int h = n / 192, w = n % 192; if (w < 128) return n; const int p = w - 128, g = p >> 3, e = p & 7; return h * 192 + 128 + (e < 4 ? 4 * g + e : 32 + 4 * g + (e - 4)); } };
struct ScUp { __device__ int operator()(int n) const { const int pn = n >> 8, r = n & 255; return r < 128 ? 128 * pn + r : DFF + 128 * pn + (r - 128); } };
template <class SrcCol>
__device__ __forceinline__ void tr_matrix(const float* W, int K, int Nsrc, int Ndst, bf16_t* WT, LAS float* scr, int& cursor, int gw, int NGW, int lane, SrcCol sc, const float* kgain, float scale, int item_lo = 0, int item_hi = 0x7fffffff) {
    const int nblk = Ndst / 64, nall = (K / 64) * nblk, nitems = item_hi < nall ? item_hi : nall;
    int it = gw - cursor % NGW; if (it < 0) it += NGW; it += item_lo;
    f32x4 cur[16], nxt[16];
    if (it < nitems) tr_load(cur, W, Nsrc, it / nblk, it % nblk, lane, sc);
    for (; it < nitems; it += NGW) { const int itn = it + NGW;
        if (itn < nitems) tr_load(nxt, W, Nsrc, itn / nblk, itn % nblk, lane, sc);
        tr_proc(cur, K, WT, scr, it / nblk, it % nblk, lane, kgain, scale);
#pragma unroll
        for (int i = 0; i < 16; ++i) cur[i] = nxt[i]; }
    cursor += nitems - item_lo;
}

namespace pg8 {
struct EpiZ {
    static constexpr bool PERM = true, AFTER_DRAIN = false, APERM = false;
    bf16_t* ZA; bf16_t* ZB; float* statq; float* statkv;
    __device__ __forceinline__ void operator()(const f32x4 (&acc)[2][2][4][2], const Unit& u, int wr, int wc, int fr, int fq) const {
        const int row0 = u.pm * BM + wr * 64 + fr, col0 = u.pn * BM + wc * 32 + 8 * fq;
#pragma unroll
        for (int ai = 0; ai < 2; ++ai)
#pragma unroll
            for (int m = 0; m < 4; ++m) { const int row = row0 + ai * HALF + m * 16; bf16_t* rowp = (u.pn < 24) ? ZA + (size_t)row * ZA_LD + col0 : ZB + (size_t)row * ZB_LD + (col0 - 6144); float ss = 0.f;
#pragma unroll
                for (int bj = 0; bj < 2; ++bj) { const f32x4 v0 = acc[ai][bj][m][0], v1 = acc[ai][bj][m][1];
                    u32x4 w; w.x = cvt_pk_bf16(v0[0], v0[1]); w.y = cvt_pk_bf16(v0[2], v0[3]); w.z = cvt_pk_bf16(v1[0], v1[1]); w.w = cvt_pk_bf16(v1[2], v1[3]);
                    *(u32x4*)(rowp + bj * HALF) = w;
                    ss += (v0[0] * v0[0] + v0[1] * v0[1]) + (v0[2] * v0[2] + v0[3] * v0[3]) + (v1[0] * v1[0] + v1[1] * v1[1]) + (v1[2] * v1[2] + v1[3] * v1[3]); }
                if (u.pn >= 24 && u.pn < 27) { ss += __shfl_xor(ss, 16); ss += __shfl_xor(ss, 32);
                    if (fq == 0) { if (u.pn < 26) statq[row * 8 + (u.pn - 24) * 4 + wc] = ss; else statkv[row * 4 + wc] = ss; } } }
    }
};
}


namespace pg8 {
__device__ __forceinline__ u32x4 pack8(const f32x4 v0, const f32x4 v1) { u32x4 w; w.x = cvt_pk_bf16(v0[0], v0[1]); w.y = cvt_pk_bf16(v0[2], v0[3]); w.z = cvt_pk_bf16(v1[0], v1[1]); w.w = cvt_pk_bf16(v1[2], v1[3]); return w; }
__device__ __forceinline__ void unpack8(const u32x4 w, f32x4& a, f32x4& b) {
    a[0] = __uint_as_float(w.x << 16); a[1] = __uint_as_float(w.x & 0xffff0000u); a[2] = __uint_as_float(w.y << 16); a[3] = __uint_as_float(w.y & 0xffff0000u);
    b[0] = __uint_as_float(w.z << 16); b[1] = __uint_as_float(w.z & 0xffff0000u); b[2] = __uint_as_float(w.w << 16); b[3] = __uint_as_float(w.w & 0xffff0000u); }
struct EpiStoreB {
    static constexpr bool PERM = true, AFTER_DRAIN = false, APERM = false;
    bf16_t* C; int ldc;
    __device__ __forceinline__ void operator()(const f32x4 (&acc)[2][2][4][2], const Unit& u, int wr, int wc, int fr, int fq) const {
        const int row0 = u.pm * BM + wr * 64 + fr, col0 = u.pn * BM + wc * 32 + 8 * fq;
#pragma unroll
        for (int ai = 0; ai < 2; ++ai)
#pragma unroll
            for (int m = 0; m < 4; ++m) { bf16_t* rowp = C + (size_t)(row0 + ai * HALF + m * 16) * ldc + col0;
#pragma unroll
                for (int bj = 0; bj < 2; ++bj) *(u32x4*)(rowp + bj * HALF) = pack8(acc[ai][bj][m][0], acc[ai][bj][m][1]); }
    }
};
struct EpiQo {
    static constexpr bool PERM = true, AFTER_DRAIN = false, APERM = false;
    bf16_t* Q; const float* statq; const float2* cs;
    __device__ __forceinline__ void operator()(const f32x4 (&acc)[2][2][4][2], const Unit& u, int wr, int wc, int fr, int fq) const {
        const int row0 = u.pm * BM + wr * 64 + fr, col0 = u.pn * BM + wc * 32 + 8 * fq;
        const int hw0 = (u.pn * BM + wc * 32) % 192, hw1 = (u.pn * BM + HALF + wc * 32) % 192;
        const bool rp0 = hw0 >= 128, rp1 = hw1 >= 128;
#pragma unroll
        for (int aq = 0; aq < 4; ++aq) { const int ai = aq >> 1, mb = (aq & 1) * 2;
            f32x4 s0[4], s1[4]; f32x4 c0[4][2], c1[4][2];
#pragma unroll
            for (int m = mb; m < mb + 2; ++m) { const int row = row0 + ai * HALF + m * 16;
                s0[m] = *(const f32x4*)(statq + row * 8); s1[m] = *(const f32x4*)(statq + row * 8 + 4);
                if (rp0) { const f32x4* c = (const f32x4*)(cs + row * 32 + 4 * (((hw0 - 128) >> 3) + fq)); c0[m][0] = c[0]; c0[m][1] = c[1]; }
                if (rp1) { const f32x4* c = (const f32x4*)(cs + row * 32 + 4 * (((hw1 - 128) >> 3) + fq)); c1[m][0] = c[0]; c1[m][1] = c[1]; } }
#pragma unroll
            for (int m = mb; m < mb + 2; ++m) { const int row = row0 + ai * HALF + m * 16; bf16_t* rowp = Q + (size_t)row * 1536 + col0;
                const float rstd = rsqrtf(((s0[m][0] + s0[m][1]) + (s0[m][2] + s0[m][3]) + (s1[m][0] + s1[m][1]) + (s1[m][2] + s1[m][3])) * (1.f / 512.f) + EPSN);
#pragma unroll
                for (int bj = 0; bj < 2; ++bj) { f32x4 v0 = acc[ai][bj][m][0] * rstd, v1 = acc[ai][bj][m][1] * rstd;
                    if (bj == 0 ? rp0 : rp1) { const f32x4 ca = bj == 0 ? c0[m][0] : c1[m][0], cb = bj == 0 ? c0[m][1] : c1[m][1];
                        const float cx[4] = {ca[0], ca[2], cb[0], cb[2]}, sx[4] = {ca[1], ca[3], cb[1], cb[3]};
#pragma unroll
                        for (int j = 0; j < 4; ++j) { const float x1 = v0[j], x2 = v1[j]; v0[j] = x1 * cx[j] - x2 * sx[j]; v1[j] = x2 * cx[j] + x1 * sx[j]; } }
                    *(u32x4*)(rowp + bj * HALF) = pack8(v0, v1); } } }
    }
};
struct EpiKVo {
    static constexpr bool PERM = true, AFTER_DRAIN = false, APERM = false;
    bf16_t* Kf; bf16_t* V; const float* statkv;
    __device__ __forceinline__ void operator()(const f32x4 (&acc)[2][2][4][2], const Unit& u, int wr, int wc, int fr, int fq) const {
        const int row0 = u.pm * BM + wr * 64 + fr, c0 = wc * 32 + 8 * fq;
        f32x4 st[2][4];
#pragma unroll
        for (int ai = 0; ai < 2; ++ai)
#pragma unroll
            for (int m = 0; m < 4; ++m) st[ai][m] = *(const f32x4*)(statkv + (row0 + ai * HALF + m * 16) * 4);
#pragma unroll
        for (int ai = 0; ai < 2; ++ai)
#pragma unroll
            for (int m = 0; m < 4; ++m) { const int row = row0 + ai * HALF + m * 16; const f32x4 s0 = st[ai][m];
                const float rstd = rsqrtf(((s0[0] + s0[1]) + (s0[2] + s0[3])) * (1.f / 256.f) + EPSN);
                *(u32x4*)(Kf + (size_t)row * 1536 + u.pn * 192 + c0) = pack8(acc[ai][0][m][0] * rstd, acc[ai][0][m][1] * rstd);
                *(u32x4*)(V + (size_t)row * 1024 + u.pn * 128 + c0) = pack8(acc[ai][1][m][0] * rstd, acc[ai][1][m][1] * rstd); }
    }
};
struct EpiGateo {
    static constexpr bool PERM = true, AFTER_DRAIN = false, APERM = false;
    bf16_t* C; const bf16_t* z; int goff; const bf16_t* add;
    __device__ __forceinline__ void operator()(const f32x4 (&acc)[2][2][4][2], const Unit& u, int wr, int wc, int fr, int fq) const {
        const int row0 = u.pm * BM + wr * 64 + fr, col0 = u.pn * BM + wc * 32 + 8 * fq;
#pragma unroll
        for (int aq = 0; aq < 4; ++aq) { const int ai = aq >> 1, mb = (aq & 1) * 2;
            u32x4 gr[4][2], ar[4][2];
#pragma unroll
            for (int m = mb; m < mb + 2; ++m)
#pragma unroll
                for (int bj = 0; bj < 2; ++bj) { const int row = row0 + ai * HALF + m * 16, col = col0 + bj * HALF;
                    gr[m][bj] = *(const u32x4*)(z + (size_t)row * ZA_LD + goff + col); if (add) ar[m][bj] = *(const u32x4*)(add + (size_t)row * DM + col); }
#pragma unroll
            for (int m = mb; m < mb + 2; ++m) { const int row = row0 + ai * HALF + m * 16;
#pragma unroll
                for (int bj = 0; bj < 2; ++bj) { const int col = col0 + bj * HALF;
                    f32x4 g0, g1; unpack8(gr[m][bj], g0, g1);
                    f32x4 v0 = acc[ai][bj][m][0], v1 = acc[ai][bj][m][1];
#pragma unroll
                    for (int j = 0; j < 4; ++j) { v0[j] *= sigmoidf_(g0[j]); v1[j] *= sigmoidf_(g1[j]); }
                    if (add) { f32x4 a0, a1; unpack8(ar[m][bj], a0, a1); v0 += a0; v1 += a1; }
                    *(u32x4*)(C + (size_t)row * DM + col) = pack8(v0, v1); } } }
    }
};
}

__device__ __forceinline__ void ph_kpe(const bf16_t* z, bf16_t* Kf, const float2* cs, int gw, int NGW, int lane) {
    for (int m2 = gw; m2 < MTOK / 2; m2 += NGW) { const int m = m2 * 2 + (lane >> 5), i = lane & 31; const bf16_t* zr = z + (size_t)m * ZB_LD + OFF_KROPE;
        const float x1 = bf2f(zr[i]), x2 = bf2f(zr[32 + i]); const float2 c = cs[m * 32 + i];
        const bf16_t o1 = f2bf(x1 * c.x - x2 * c.y), o2 = f2bf(x2 * c.x + x1 * c.y); const int p1 = rope_pos(i), p2 = rope_pos(32 + i);
#pragma unroll
        for (int h = 0; h < 8; ++h) { Kf[(size_t)m * 1536 + h * 192 + 128 + p1] = o1; Kf[(size_t)m * 1536 + h * 192 + 128 + p2] = o2; } }
}
__device__ __forceinline__ void ph_glanorm(bf16_t* og, const bf16_t* z, const float* g, int gw, int NGW, int lane) {
    const f32x4 ga = *((const f32x4*)g + lane * 2), gb = *((const f32x4*)g + lane * 2 + 1);
    pg8::u32x4 o0, z0, o1, z1, o2, z2, o3, z3;
#define GN_LOAD(O, Z, it_) do { if ((it_) < MTOK * 4) { const int m_ = (it_) >> 2, h_ = (it_) & 3; O = *(const pg8::u32x4*)(og + (size_t)m_ * DM + h_ * 512 + lane * 8); Z = *(const pg8::u32x4*)(z + (size_t)m_ * ZA_LD + OFF_GOG + h_ * 512 + lane * 8); } } while (0)
    int it = gw; GN_LOAD(o0, z0, it); GN_LOAD(o1, z1, it + NGW); GN_LOAD(o2, z2, it + 2 * NGW);
    for (; it < MTOK * 4; it += NGW) { GN_LOAD(o3, z3, it + 3 * NGW);
        const int m = it >> 2, h = it & 3; bf16_t* o = og + (size_t)m * DM + h * 512 + lane * 8;
        f32x4 a, b, za, zb; pg8::unpack8(o0, a, b); pg8::unpack8(z0, za, zb);
        float s = (a[0] * a[0] + a[1] * a[1]) + (a[2] * a[2] + a[3] * a[3]) + (b[0] * b[0] + b[1] * b[1]) + (b[2] * b[2] + b[3] * b[3]);
        const float rstd = rsqrtf(wave_sum(s) * (1.f / 512.f) + EPSN);
#pragma unroll
        for (int j = 0; j < 4; ++j) { a[j] = a[j] * rstd * ga[j] * siluf_(za[j]); b[j] = b[j] * rstd * gb[j] * siluf_(zb[j]); }
        *(pg8::u32x4*)o = pg8::pack8(a, b);
        o0 = o1; z0 = z1; o1 = o2; z1 = z2; o2 = o3; z2 = z3; }
#undef GN_LOAD
}
template <bool H2, bool XB>
__device__ __forceinline__ void ph_resnorm(const float* xin, const bf16_t* y, const float* g1, const float* mod, int off_gate, float* xout, const float* g2, int off_shift, int off_scale, bf16_t* h2, int gw, int NGW, int lane, float oscale) {
    constexpr bool XIN16 = XB && !H2;
    pg8::u32x4 yr[4], yn[4]; f32x4 xr[8], xn[8];
#define RN_LOAD(Y, X, m_) do { _Pragma("unroll") for (int j = 0; j < 4; ++j) { const int e = 8 * (lane + 64 * j); Y[j] = *(const pg8::u32x4*)(y + (size_t)(m_) * DM + e); \
        if (XIN16) X[j] = __builtin_bit_cast(f32x4, *(const pg8::u32x4*)((const bf16_t*)xin + (size_t)(m_) * DM + e)); \
        else { X[2 * j] = __builtin_nontemporal_load((const f32x4*)(xin + (size_t)(m_) * DM + e)); X[2 * j + 1] = __builtin_nontemporal_load((const f32x4*)(xin + (size_t)(m_) * DM + e + 4)); } } } while (0)
    int m = gw; if (m < MTOK) RN_LOAD(yr, xr, m);
    for (; m < MTOK; m += NGW) { const int mn = m + NGW; if (mn < MTOK) RN_LOAD(yn, xn, mn);
        const float* mb = mod + (m / SEQ) * 12288;
        f32x4 ya[4], yb[4]; float s = 0.f;
#pragma unroll
        for (int j = 0; j < 4; ++j) { pg8::unpack8(yr[j], ya[j], yb[j]);
            s += (ya[j][0] * ya[j][0] + ya[j][1] * ya[j][1]) + (ya[j][2] * ya[j][2] + ya[j][3] * ya[j][3]) + (yb[j][0] * yb[j][0] + yb[j][1] * yb[j][1]) + (yb[j][2] * yb[j][2] + yb[j][3] * yb[j][3]); }
        const float rstd = rsqrtf(wave_sum(s) * (1.f / DM) + EPSN); float s2 = 0.f;
#pragma unroll
        for (int j = 0; j < 4; ++j) { const int e = 8 * (lane + 64 * j);
            f32x4 xa, xb; if (XIN16) pg8::unpack8(__builtin_bit_cast(pg8::u32x4, xr[j]), xa, xb); else { xa = xr[2 * j]; xb = xr[2 * j + 1]; }
            ya[j] = xa + *(const f32x4*)(mb + off_gate + e) * (ya[j] * rstd * *(const f32x4*)(g1 + e));
            yb[j] = xb + *(const f32x4*)(mb + off_gate + e + 4) * (yb[j] * rstd * *(const f32x4*)(g1 + e + 4));
            if (XB && H2) *(pg8::u32x4*)((bf16_t*)xout + (size_t)m * DM + e) = pg8::pack8(ya[j], yb[j]); else { *(f32x4*)(xout + (size_t)m * DM + e) = ya[j] * oscale; *(f32x4*)(xout + (size_t)m * DM + e + 4) = yb[j] * oscale; }
            s2 += (ya[j][0] * ya[j][0] + ya[j][1] * ya[j][1]) + (ya[j][2] * ya[j][2] + ya[j][3] * ya[j][3]) + (yb[j][0] * yb[j][0] + yb[j][1] * yb[j][1]) + (yb[j][2] * yb[j][2] + yb[j][3] * yb[j][3]); }
        if (H2) { const float r2 = rsqrtf(wave_sum(s2) * (1.f / DM) + EPSN);
#pragma unroll
            for (int j = 0; j < 4; ++j) { const int e = 8 * (lane + 64 * j);
                const f32x4 ha = ya[j] * r2 * *(const f32x4*)(g2 + e) * (1.f + *(const f32x4*)(mb + off_scale + e)) + *(const f32x4*)(mb + off_shift + e);
                const f32x4 hb = yb[j] * r2 * *(const f32x4*)(g2 + e + 4) * (1.f + *(const f32x4*)(mb + off_scale + e + 4)) + *(const f32x4*)(mb + off_shift + e + 4);
                *(pg8::u32x4*)(h2 + (size_t)m * DM + e) = pg8::pack8(ha, hb); } }
#pragma unroll
        for (int j = 0; j < 4; ++j) { yr[j] = yn[j]; xr[2 * j] = xn[2 * j]; xr[2 * j + 1] = xn[2 * j + 1]; } }
#undef RN_LOAD
}
__device__ __forceinline__ void ph_convact(const bf16_t* u, const float* cw, const float* cb, bf16_t* act, int gw, int NGW, int lane) {
    for (int it = gw; it < 256 * 11; it += NGW) { const int r0 = (it / 11) * 32, j = (it % 11) * 512 + 8 * lane;
        f32x4 wa[3][2], wv[3][2];
#pragma unroll
        for (int k = 0; k < 3; ++k) { wa[k][0] = *(const f32x4*)(cw + k * DFF2 + j); wa[k][1] = *(const f32x4*)(cw + k * DFF2 + j + 4); wv[k][0] = *(const f32x4*)(cw + k * DFF2 + DFF + j); wv[k][1] = *(const f32x4*)(cw + k * DFF2 + DFF + j + 4); }
        const f32x4 ba0 = *(const f32x4*)(cb + j), ba1 = *(const f32x4*)(cb + j + 4), bv0 = *(const f32x4*)(cb + DFF + j), bv1 = *(const f32x4*)(cb + DFF + j + 4);
        f32x4 a2[2], a1[2], v2[2], v1[2];
        if (r0 % SEQ == 0) { a2[0] = a2[1] = a1[0] = a1[1] = v2[0] = v2[1] = v1[0] = v1[1] = (f32x4){0.f, 0.f, 0.f, 0.f}; }
        else { pg8::unpack8(*(const pg8::u32x4*)(u + (size_t)(r0 - 2) * DFF2 + j), a2[0], a2[1]); pg8::unpack8(*(const pg8::u32x4*)(u + (size_t)(r0 - 1) * DFF2 + j), a1[0], a1[1]);
               pg8::unpack8(*(const pg8::u32x4*)(u + (size_t)(r0 - 2) * DFF2 + DFF + j), v2[0], v2[1]); pg8::unpack8(*(const pg8::u32x4*)(u + (size_t)(r0 - 1) * DFF2 + DFF + j), v1[0], v1[1]); }
#pragma unroll 4
        for (int r = 0; r < 32; ++r) { const size_t m = (size_t)r0 + r; f32x4 a0[2], v0[2];
            pg8::unpack8(*(const pg8::u32x4*)(u + m * DFF2 + j), a0[0], a0[1]); pg8::unpack8(*(const pg8::u32x4*)(u + m * DFF2 + DFF + j), v0[0], v0[1]);
            f32x4 ca0 = ba0 + wa[0][0] * a2[0] + wa[1][0] * a1[0] + wa[2][0] * a0[0], ca1 = ba1 + wa[0][1] * a2[1] + wa[1][1] * a1[1] + wa[2][1] * a0[1];
            const f32x4 cv0 = bv0 + wv[0][0] * v2[0] + wv[1][0] * v1[0] + wv[2][0] * v0[0], cv1 = bv1 + wv[0][1] * v2[1] + wv[1][1] * v1[1] + wv[2][1] * v0[1];
#pragma unroll
            for (int q = 0; q < 4; ++q) { ca0[q] = gelu_tanh(ca0[q]) * cv0[q]; ca1[q] = gelu_tanh(ca1[q]) * cv1[q]; }
            *(pg8::u32x4*)(act + m * DFF + j) = pg8::pack8(ca0, ca1);
            a2[0] = a1[0]; a2[1] = a1[1]; a1[0] = a0[0]; a1[1] = a0[1]; v2[0] = v1[0]; v2[1] = v1[1]; v1[0] = v0[0]; v1[1] = v0[1]; } }
}
namespace pg8 {
struct EpiU {
    static constexpr bool PERM = true, AFTER_DRAIN = false, APERM = false;
    bf16_t* U;
    __device__ __forceinline__ void operator()(const f32x4 (&acc)[2][2][4][2], const Unit& u, int wr, int wc, int fr, int fq) const {
        const int row0 = u.pm * BM + wr * 64 + fr, c0 = u.pn * 128 + wc * 32 + 8 * fq;
#pragma unroll
        for (int ai = 0; ai < 2; ++ai)
#pragma unroll
            for (int m = 0; m < 4; ++m) { bf16_t* rowp = U + (size_t)(row0 + ai * HALF + m * 16) * DFF2 + c0;
                *(u32x4*)(rowp) = pack8(acc[ai][0][m][0], acc[ai][0][m][1]); *(u32x4*)(rowp + DFF) = pack8(acc[ai][1][m][0], acc[ai][1][m][1]); }
    }
};
}

namespace pg8 {
__device__ __forceinline__ float dpp_shr1(float v) { return __builtin_bit_cast(float, __builtin_amdgcn_update_dpp(0, __builtin_bit_cast(int, v), 0x111, 0xf, 0xf, true)); }
__device__ __forceinline__ float gelu_fast(float a) { const float u2 = a * (1.5957691216057308f + 0.07135481627f * a * a); return a * __builtin_amdgcn_rcpf(1.f + __builtin_amdgcn_exp2f(-1.4426950408889634f * u2)); }
struct EpiConv {
    static constexpr bool PERM = true, AFTER_DRAIN = false, APERM = true;
    bf16_t* act; const float* cw; const float* cb; bf16_t* hlast; float* hfirst; PG8_LAS float* xch;
    __device__ __forceinline__ void operator()(f32x4 (&acc)[2][2][4][2], const Unit& u, int wr, int wc, int fr, int fq) const {
        const int tok0 = u.pm * BM + 128 * wr + 8 * fr, chb = u.pn * 128 + wc * 32 + 8 * fq, colb = u.pn * BM + wc * 32 + 8 * fq;
        f32x4 cwt[8];
#define EC_LOADW(ch_) do { cwt[0] = *(const f32x4*)(cw + (ch_)); cwt[1] = *(const f32x4*)(cw + DFF2 + (ch_)); cwt[2] = *(const f32x4*)(cw + 2 * DFF2 + (ch_)); cwt[3] = *(const f32x4*)(cb + (ch_)); \
        cwt[4] = *(const f32x4*)(cw + DFF + (ch_)); cwt[5] = *(const f32x4*)(cw + DFF2 + DFF + (ch_)); cwt[6] = *(const f32x4*)(cw + 2 * DFF2 + DFF + (ch_)); cwt[7] = *(const f32x4*)(cb + DFF + (ch_)); } while (0)
        EC_LOADW(chb);
        PG8_LAS float* xp = xch + (wc * 4 + fq) * 32;
        if (wr == 0 && fr == 15) {
#pragma unroll
            for (int n = 0; n < 2; ++n)
#pragma unroll
                for (int e = 0; e < 4; ++e) { xp[n * 4 + e] = acc[1][0][2][n][e]; xp[8 + n * 4 + e] = acc[1][0][3][n][e]; xp[16 + n * 4 + e] = acc[1][1][2][n][e]; xp[24 + n * 4 + e] = acc[1][1][3][n][e]; } }
        asm volatile("s_waitcnt lgkmcnt(0)" ::: "memory"); __builtin_amdgcn_s_barrier(); asm volatile("" ::: "memory");
        if (wr == 1 && fr == 15) {
#pragma unroll
            for (int s = 0; s < 2; ++s) { bf16_t* hp = hlast + ((size_t)u.pm * 2 + s) * DFF2 + colb;
                *(u32x4*)(hp) = pack8(acc[1][0][2 + s][0], acc[1][0][2 + s][1]); *(u32x4*)(hp + HALF) = pack8(acc[1][1][2 + s][0], acc[1][1][2 + s][1]); } }
        unsigned keep[8][2];
#pragma unroll
        for (int n = 0; n < 2; ++n) { if (n == 1) EC_LOADW(chb + 4);
            const f32x4 wa0 = cwt[0], wa1 = cwt[1], wa2 = cwt[2], ba = cwt[3], wv0 = cwt[4], wv1 = cwt[5], wv2 = cwt[6], bv = cwt[7];
            f32x4 pa6, pa7, pv6, pv7;
#pragma unroll
            for (int e = 0; e < 4; ++e) { pa6[e] = dpp_shr1(acc[1][0][2][n][e]); pa7[e] = dpp_shr1(acc[1][0][3][n][e]); pv6[e] = dpp_shr1(acc[1][1][2][n][e]); pv7[e] = dpp_shr1(acc[1][1][3][n][e]); }
            if (wr == 1 && fr == 0) {
#pragma unroll
                for (int e = 0; e < 4; ++e) { pa6[e] = xp[n * 4 + e]; pa7[e] = xp[8 + n * 4 + e]; pv6[e] = xp[16 + n * 4 + e]; pv7[e] = xp[24 + n * 4 + e]; } }
            f32x4 a2 = pa6, a1 = pa7, v2 = pv6, v1 = pv7;
#pragma unroll
            for (int s = 0; s < 8; ++s) { const f32x4 a0 = acc[s >> 2][0][s & 3][n], v0 = acc[s >> 2][1][s & 3][n];
                f32x4 ca = ba + wa0 * a2 + wa1 * a1 + wa2 * a0; const f32x4 cv = bv + wv0 * v2 + wv1 * v1 + wv2 * v0;
                if (s < 2 && wr == 0 && fr == 0) { float* hp = hfirst + ((size_t)u.pm * 2 + s) * DFF2 + colb + 4 * n; *(f32x4*)hp = ca; *(f32x4*)(hp + HALF) = cv; }
#pragma unroll
                for (int e = 0; e < 4; ++e) ca[e] = gelu_fast(ca[e]) * cv[e];
                const unsigned lo = cvt_pk_bf16(ca[0], ca[1]), hi = cvt_pk_bf16(ca[2], ca[3]);
                if (n == 0) { keep[s][0] = lo; keep[s][1] = hi; }
                else { u32x4 w; w.x = keep[s][0]; w.y = keep[s][1]; w.z = lo; w.w = hi; *(u32x4*)(act + (size_t)(tok0 + s) * DFF + chb) = w; }
                a2 = a1; a1 = a0; v2 = v1; v1 = v0; } }
#undef EC_LOADW
    }
};
}
namespace pg8 {
struct RowX { float* slots; unsigned* cnt; unsigned* bar; };
__device__ __forceinline__ void rowx_publish(const f32x4 (&acc)[2][2][4][2], const RowX& X, const Unit& u, int wr, int wc, int fr, int fq, PG8_LAS float* part, int tid) {
#pragma unroll
    for (int ai = 0; ai < 2; ++ai)
#pragma unroll
        for (int m = 0; m < 4; ++m) { float s = 0.f;
#pragma unroll
            for (int bj = 0; bj < 2; ++bj)
#pragma unroll
                for (int n = 0; n < 2; ++n) { const f32x4 v = acc[ai][bj][m][n]; s += (v[0] * v[0] + v[1] * v[1]) + (v[2] * v[2] + v[3] * v[3]); }
            part[(wc * 4 + fq) * 272 + wr * 64 + ai * HALF + m * 16 + fr] = s; }
    asm volatile("s_waitcnt lgkmcnt(0)" ::: "memory"); __syncthreads();
    if (tid < 256) { float t = 0.f;
#pragma unroll
        for (int s = 0; s < 16; ++s) t += part[s * 272 + tid];
        __hip_atomic_store(X.slots + ((size_t)u.pm * BM + tid) * 8 + u.pn, t, RLX_AGENT); }
    asm volatile("s_waitcnt vmcnt(0)" ::: "memory"); __syncthreads();
    if (tid == 0) (void)xb_add(X.cnt, 1u);
}
__device__ __forceinline__ void rowx_wait(const RowX& X, const Unit& u, PG8_LAS float* rs, int tid) {
    if (tid == 0) { XB_SPIN(xb_ld(X.cnt) < 8u, X.bar); }
    __syncthreads();
    if (tid < 256) { unsigned* sp = (unsigned*)(X.slots + ((size_t)u.pm * BM + tid) * 8); float t = 0.f;
#pragma unroll
        for (int j = 0; j < 8; ++j) t += __uint_as_float(xb_ld(sp + j));
        rs[tid] = rsqrtf(t * (1.f / DM) + EPSN); }
    asm volatile("s_waitcnt lgkmcnt(0)" ::: "memory"); __syncthreads();
}
struct EpiResOut {
    static constexpr bool PERM = true, AFTER_DRAIN = true, APERM = false;
    const bf16_t* x1b; const float* gate; const float* g; float* out; RowX X; float oscale;
    __device__ __forceinline__ void fused(f32x4 (&acc)[2][2][4][2], const Unit& u, int wr, int wc, int fr, int fq, PG8_LAS unsigned char* lds, int wid, int lane) const {
        const int tid = wid * 64 + lane; PG8_LAS float* part = (PG8_LAS float*)lds; PG8_LAS float* rs = part + 16 * 272;
        rowx_publish(acc, X, u, wr, wc, fr, fq, part, tid);
        const int lrow0 = wr * 64 + fr, row0 = u.pm * BM + lrow0, col0 = u.pn * BM + wc * 32 + 8 * fq; const float* gb = gate + (u.pm / 16) * 12288;
        f32x4 gg[2][2];
#pragma unroll
        for (int bj = 0; bj < 2; ++bj)
#pragma unroll
            for (int n = 0; n < 2; ++n) gg[bj][n] = *(const f32x4*)(gb + col0 + bj * HALF + 4 * n) * *(const f32x4*)(g + col0 + bj * HALF + 4 * n);
        u32x4 xr[2][2][2];
#define RO_LOAD(buf, aq_) do { _Pragma("unroll") for (int mm = 0; mm < 2; ++mm) _Pragma("unroll") for (int bj = 0; bj < 2; ++bj) \
            xr[buf][mm][bj] = *(const u32x4*)(x1b + (size_t)(row0 + ((aq_) >> 1) * HALF + (((aq_) & 1) * 2 + mm) * 16) * DM + col0 + bj * HALF); } while (0)
        RO_LOAD(0, 0);
        rowx_wait(X, u, rs, tid);
#pragma unroll
        for (int aq = 0; aq < 4; ++aq) { const int ai = aq >> 1, mb = (aq & 1) * 2;
            if (aq + 1 < 4) RO_LOAD((aq + 1) & 1, aq + 1);
            __builtin_amdgcn_sched_barrier(0);
#pragma unroll
            for (int mm = 0; mm < 2; ++mm) { const int m = mb + mm, row = row0 + ai * HALF + m * 16; const float r = rs[lrow0 + ai * HALF + m * 16];
#pragma unroll
                for (int bj = 0; bj < 2; ++bj) { f32x4 xa, xb; unpack8(xr[aq & 1][mm][bj], xa, xb); float* op = out + (size_t)row * DM + col0 + bj * HALF;
                    *(f32x4*)op = (xa + gg[bj][0] * (acc[ai][bj][m][0] * r)) * oscale; *(f32x4*)(op + 4) = (xb + gg[bj][1] * (acc[ai][bj][m][1] * r)) * oscale; } }
            __builtin_amdgcn_sched_barrier(0); }
#undef RO_LOAD
    }
};
struct EpiResMid {
    static constexpr bool PERM = true, AFTER_DRAIN = true, APERM = false;
    const float* x; const float* mod; const float* g1; const float* g2; bf16_t* x1b; bf16_t* h2; RowX X1, X2;
    __device__ __forceinline__ void fused(f32x4 (&acc)[2][2][4][2], const Unit& u, int wr, int wc, int fr, int fq, PG8_LAS unsigned char* lds, int wid, int lane) const {
        const int tid = wid * 64 + lane; PG8_LAS float* part = (PG8_LAS float*)lds; PG8_LAS float* rs = part + 16 * 272;
        rowx_publish(acc, X1, u, wr, wc, fr, fq, part, tid);
        const int lrow0 = wr * 64 + fr, row0 = u.pm * BM + lrow0, col0 = u.pn * BM + wc * 32 + 8 * fq; const float* mb_ = mod + (u.pm / 16) * 12288;
        { f32x4 gg[2][2];
#pragma unroll
          for (int bj = 0; bj < 2; ++bj)
#pragma unroll
              for (int n = 0; n < 2; ++n) gg[bj][n] = *(const f32x4*)(mb_ + 4096 + col0 + bj * HALF + 4 * n) * *(const f32x4*)(g1 + col0 + bj * HALF + 4 * n);
          f32x4 xr[2][2][2];
#define RM_LOAD(buf, aq_) do { _Pragma("unroll") for (int bj = 0; bj < 2; ++bj) { const float* xp = x + (size_t)(row0 + ((aq_) >> 2) * HALF + ((aq_) & 3) * 16) * DM + col0 + bj * HALF; \
              xr[buf][bj][0] = __builtin_nontemporal_load((const f32x4*)xp); xr[buf][bj][1] = __builtin_nontemporal_load((const f32x4*)xp + 1); } } while (0)
          RM_LOAD(0, 0);
          rowx_wait(X1, u, rs, tid);
#pragma unroll
          for (int aq = 0; aq < 8; ++aq) { const int ai = aq >> 2, m = aq & 3;
              if (aq + 1 < 8) RM_LOAD((aq + 1) & 1, aq + 1);
              __builtin_amdgcn_sched_barrier(0);
              const float r = rs[lrow0 + ai * HALF + m * 16];
#pragma unroll
              for (int bj = 0; bj < 2; ++bj)
#pragma unroll
                  for (int n = 0; n < 2; ++n) acc[ai][bj][m][n] = xr[aq & 1][bj][n] + gg[bj][n] * (acc[ai][bj][m][n] * r);
              __builtin_amdgcn_sched_barrier(0); } }
#undef RM_LOAD
        __syncthreads();
        rowx_publish(acc, X2, u, wr, wc, fr, fq, part, tid);
#pragma unroll
        for (int ai = 0; ai < 2; ++ai)
#pragma unroll
            for (int m = 0; m < 4; ++m)
#pragma unroll
                for (int bj = 0; bj < 2; ++bj) *(u32x4*)(x1b + (size_t)(row0 + ai * HALF + m * 16) * DM + col0 + bj * HALF) = pack8(acc[ai][bj][m][0], acc[ai][bj][m][1]);
        rowx_wait(X2, u, rs, tid);
#pragma unroll
        for (int bj = 0; bj < 2; ++bj) { f32x4 gs[2], sh[2];
#pragma unroll
            for (int n = 0; n < 2; ++n) { const int c = col0 + bj * HALF + 4 * n; gs[n] = *(const f32x4*)(g2 + c) * (1.f + *(const f32x4*)(mb_ + 8192 + c)); sh[n] = *(const f32x4*)(mb_ + 6144 + c); }
#pragma unroll
            for (int ai = 0; ai < 2; ++ai)
#pragma unroll
                for (int m = 0; m < 4; ++m) { const float r = rs[lrow0 + ai * HALF + m * 16];
                    *(u32x4*)(h2 + (size_t)(row0 + ai * HALF + m * 16) * DM + col0 + bj * HALF) = pack8(acc[ai][bj][m][0] * r * gs[0] + sh[0], acc[ai][bj][m][1] * r * gs[1] + sh[1]); } }
    }
};
}
__device__ __forceinline__ void ph_convfix(const bf16_t* hlast, const float* hfirst, const float* cw, bf16_t* act, int pm, int wave, int lane) {
    if (pm % 16 == 0) return;
    for (int it = wave; it < 2 * 22; it += 8) { const int s = it / 22, seg = it % 22;
        const int ch = seg * 256 + 4 * lane, pn = ch >> 7, col = pn * 256 + (ch & 127);
        f32x4 ca = *(const f32x4*)(hfirst + ((size_t)pm * 2 + s) * DFF2 + col), cv = *(const f32x4*)(hfirst + ((size_t)pm * 2 + s) * DFF2 + col + 128);
        const bf16_t* h0 = hlast + ((size_t)(pm - 1) * 2) * DFF2 + col; const bf16_t* h1 = h0 + DFF2;
        const uint2 a0r = *(const uint2*)h0, a1r = *(const uint2*)h1, v0r = *(const uint2*)(h0 + 128), v1r = *(const uint2*)(h1 + 128);
        f32x4 a0, a1, v0, v1;
        a0[0] = __uint_as_float(a0r.x << 16); a0[1] = __uint_as_float(a0r.x & 0xffff0000u); a0[2] = __uint_as_float(a0r.y << 16); a0[3] = __uint_as_float(a0r.y & 0xffff0000u);
        a1[0] = __uint_as_float(a1r.x << 16); a1[1] = __uint_as_float(a1r.x & 0xffff0000u); a1[2] = __uint_as_float(a1r.y << 16); a1[3] = __uint_as_float(a1r.y & 0xffff0000u);
        v0[0] = __uint_as_float(v0r.x << 16); v0[1] = __uint_as_float(v0r.x & 0xffff0000u); v0[2] = __uint_as_float(v0r.y << 16); v0[3] = __uint_as_float(v0r.y & 0xffff0000u);
        v1[0] = __uint_as_float(v1r.x << 16); v1[1] = __uint_as_float(v1r.x & 0xffff0000u); v1[2] = __uint_as_float(v1r.y << 16); v1[3] = __uint_as_float(v1r.y & 0xffff0000u);
        const f32x4 wa0 = *(const f32x4*)(cw + ch), wa1 = *(const f32x4*)(cw + DFF2 + ch), wv0 = *(const f32x4*)(cw + DFF + ch), wv1 = *(const f32x4*)(cw + DFF2 + DFF + ch);
        if (s == 0) { ca += wa0 * a0 + wa1 * a1; cv += wv0 * v0 + wv1 * v1; } else { ca += wa0 * a1; cv += wv0 * v1; }
#pragma unroll
        for (int e = 0; e < 4; ++e) ca[e] = pg8::gelu_fast(ca[e]) * cv[e];
        uint2 w; w.x = pg8::cvt_pk_bf16(ca[0], ca[1]); w.y = pg8::cvt_pk_bf16(ca[2], ca[3]);
        *(uint2*)(act + ((size_t)pm * 256 + s) * DFF + ch) = w; }
}
namespace att {
typedef short bf16x8 __attribute__((ext_vector_type(8)));
typedef short s16x4 __attribute__((ext_vector_type(4)));
typedef float f32x16 __attribute__((ext_vector_type(16)));
typedef __attribute__((address_space(3))) const unsigned char* lcp;
constexpr int KROW = 400, VROW = 320, KBYTES = 64 * KROW, VBYTES = 64 * VROW, BUFB = KBYTES + VBYTES;
constexpr size_t WS_ATTP = 108 * MiB, WS_ATTML = 68 * MiB + 512 * 1024;
__device__ __forceinline__ int crow(int r, int hi) { return (r & 3) + 8 * (r >> 2) + 4 * hi; }
__device__ __forceinline__ s16x4 vtr(lcp p) { typedef short v4i16_t __attribute__((ext_vector_type(4))); return __builtin_bit_cast(s16x4, __builtin_amdgcn_ds_read_tr16_b64_v4i16((__attribute__((address_space(3))) v4i16_t*)p)); }
__device__ __forceinline__ float hswap_max(float x) { auto rr = __builtin_amdgcn_permlane32_swap(__float_as_uint(x), __float_as_uint(x), false, false); return fmaxf(__uint_as_float(rr[0]), __uint_as_float(rr[1])); }
__device__ __forceinline__ float hswap_add(float x) { auto rr = __builtin_amdgcn_permlane32_swap(__float_as_uint(x), __float_as_uint(x), false, false); return __uint_as_float(rr[0]) + __uint_as_float(rr[1]); }
__device__ __forceinline__ bf16x8 packp(const f32x16& p, int b) { pg8::u32x4 w; w.x = pg8::cvt_pk_bf16(p[b], p[b + 1]); w.y = pg8::cvt_pk_bf16(p[b + 2], p[b + 3]); w.z = pg8::cvt_pk_bf16(p[b + 4], p[b + 5]); w.w = pg8::cvt_pk_bf16(p[b + 6], p[b + 7]); return __builtin_bit_cast(bf16x8, w); }

__device__ __forceinline__ void segment(LAS unsigned char* L, const bf16_t* Q, const bf16_t* Kf, const bf16_t* V, int b, int h, int qblk, int t0, int t1, bf16_t* outp, int ostride, float2* ml, int wave, int lane_) {
    const int tid = fresh_tid(), lane = tid & 63, r32 = lane & 31, hh = lane >> 5;
    const size_t rowbase = (size_t)b * SEQ; const int R0 = qblk * 256, qrow = R0 + 32 * wave + r32;
    bf16x8 qf[12];
    { const bf16_t* qp = Q + (rowbase + qrow) * 1536 + h * 192 + 8 * hh;
#pragma unroll
      for (int d0 = 0; d0 < 12; ++d0) qf[d0] = *(const bf16x8*)(qp + 16 * d0); }
    f32x16 O[4];
#pragma unroll
    for (int d0 = 0; d0 < 4; ++d0)
#pragma unroll
        for (int r = 0; r < 16; ++r) O[d0][r] = 0.f;
    float m = -1e30f, l = 0.f;
    const int srow = tid >> 3, sch = tid & 7;
    const int kgo = srow * 1536 + sch * 8, klo = srow * KROW + sch * 16, vgo = srow * 1024 + sch * 8, vlo = KBYTES + srow * VROW + sch * 16;
    const bf16_t* Kh = Kf + rowbase * 1536 + h * 192; const bf16_t* Vh = V + rowbase * 1024 + h * 128;
    pg8::u32x4 skA[3], svA[2], skB[3], svB[2];
#define ATT_LOAD(sk, sv, t) do { _Pragma("unroll") for (int i = 0; i < 3; ++i) sk[i] = *(const pg8::u32x4*)(Kh + (size_t)(t) * 64 * 1536 + kgo + 64 * i); \
                         _Pragma("unroll") for (int i = 0; i < 2; ++i) sv[i] = *(const pg8::u32x4*)(Vh + (size_t)(t) * 64 * 1024 + vgo + 64 * i); } while (0)
#define ATT_WRITE(sk, sv, buf) do { _Pragma("unroll") for (int i = 0; i < 3; ++i) *(LAS pg8::u32x4*)(L + (buf) * BUFB + klo + 128 * i) = sk[i]; \
                            _Pragma("unroll") for (int i = 0; i < 2; ++i) *(LAS pg8::u32x4*)(L + (buf) * BUFB + vlo + 128 * i) = sv[i]; } while (0)
    typedef __attribute__((address_space(3))) const bf16x8* lfp;
#define AT_SB() __builtin_amdgcn_sched_barrier(0)
#define AT_RDK(dst, d0) do { dst[0] = *(lfp)(ka + (d0) * 32); dst[1] = *(lfp)(ka + 32 * KROW + (d0) * 32); dst[2] = *(lfp)(ka + ((d0) + 1) * 32); dst[3] = *(lfp)(ka + 32 * KROW + ((d0) + 1) * 32); } while (0)
#define AT_MMK(src, d0) do { p0 = __builtin_amdgcn_mfma_f32_32x32x16_bf16(src[0], qf[d0], p0, 0, 0, 0); p1 = __builtin_amdgcn_mfma_f32_32x32x16_bf16(src[1], qf[d0], p1, 0, 0, 0); \
            p0 = __builtin_amdgcn_mfma_f32_32x32x16_bf16(src[2], qf[(d0) + 1], p0, 0, 0, 0); p1 = __builtin_amdgcn_mfma_f32_32x32x16_bf16(src[3], qf[(d0) + 1], p1, 0, 0, 0); } while (0)
#define AT_RDV(dst, d0) do { _Pragma("unroll") for (int ks = 0; ks < 4; ++ks) { const s16x4 lo_ = vtr(va + (16 * ks) * VROW + 64 * (d0)), hi_ = vtr(va + (16 * ks + 8) * VROW + 64 * (d0)); \
            dst[ks] = (bf16x8){lo_[0], lo_[1], lo_[2], lo_[3], hi_[0], hi_[1], hi_[2], hi_[3]}; } } while (0)
#define AT_MMV(src, d0) do { _Pragma("unroll") for (int ks = 0; ks < 4; ++ks) O[d0] = __builtin_amdgcn_mfma_f32_32x32x16_bf16(src[ks], pf[ks], O[d0], 0, 0, 0); } while (0)
#define AT_PV(slot) do { lcp va = (lcp)(L + (slot) * BUFB + KBYTES) + (4 * hh + ((lane & 15) >> 2)) * VROW + (16 * ((lane >> 4) & 1) + 4 * (lane & 3)) * 2; bf16x8 v0[4], v1[4]; \
            AT_RDV(v0, 0); AT_SB(); AT_RDV(v1, 1); AT_SB(); AT_MMV(v0, 0); AT_SB(); AT_RDV(v0, 2); AT_SB(); AT_MMV(v1, 1); AT_SB(); AT_RDV(v1, 3); AT_SB(); AT_MMV(v0, 2); AT_SB(); AT_MMV(v1, 3); AT_SB(); } while (0)
    const bool lag = wave >= 4; bool pend = false; int pslot = 0; bf16x8 pf[4];
    constexpr int AHEAD = 1;
    ATT_LOAD(skA, svA, t0); ATT_WRITE(skA, svA, 0);
    if (AHEAD == 2 && t0 + 1 < t1) ATT_LOAD(skB, svB, t0 + 1);
    __syncthreads();
    int cur = 0;
    auto step = [&](const int t, pg8::u32x4 (&lk)[3], pg8::u32x4 (&lv)[2], pg8::u32x4 (&wk)[3], pg8::u32x4 (&wv)[2]) __attribute__((always_inline)) {
        const bool more = (t + 1 < t1);
        if (t + AHEAD < t1) ATT_LOAD(lk, lv, t + AHEAD);
        if (lag && pend) { AT_PV(pslot); pend = false; }
        if (64 * t <= R0 + 32 * wave + 31) {
            lcp Kb = (lcp)(L + cur * BUFB);
            f32x16 p0, p1;
#pragma unroll
            for (int r = 0; r < 16; ++r) { p0[r] = 0.f; p1[r] = 0.f; }
            lcp ka = Kb + r32 * KROW + hh * 16;
            { bf16x8 fa[4], fb[4];
              AT_RDK(fa, 0); AT_SB();
              AT_RDK(fb, 2); AT_SB(); AT_MMK(fa, 0); AT_SB();
              AT_RDK(fa, 4); AT_SB(); AT_MMK(fb, 2); AT_SB();
              AT_RDK(fb, 6); AT_SB(); AT_MMK(fa, 4); AT_SB();
              AT_RDK(fa, 8); AT_SB(); AT_MMK(fb, 6); AT_SB();
              AT_RDK(fb, 10); AT_SB(); AT_MMK(fa, 8); AT_SB();
              AT_MMK(fb, 10); AT_SB(); }
            if (64 * t + 63 > R0 + 32 * wave) {
                const float NEG = -__builtin_inff();
#pragma unroll
                for (int r = 0; r < 16; ++r) { const int key = 64 * t + crow(r, hh); if (key > qrow) p0[r] = NEG; if (key + 32 > qrow) p1[r] = NEG; }
            }
            float mxa[4];
#pragma unroll
            for (int q = 0; q < 4; ++q) mxa[q] = fmaxf(p0[q], p1[q]);
#pragma unroll
            for (int r = 4; r < 16; ++r) mxa[r & 3] = fmaxf(mxa[r & 3], fmaxf(p0[r], p1[r]));
            float mx = fmaxf(fmaxf(mxa[0], mxa[1]), fmaxf(mxa[2], mxa[3]));
            mx = hswap_max(mx);
            if (__any(mx > m + 8.f)) { const float mn = fmaxf(m, mx), alpha = __builtin_amdgcn_exp2f(m - mn); m = mn; l *= alpha;
#pragma unroll
                for (int d0 = 0; d0 < 4; ++d0)
#pragma unroll
                    for (int r = 0; r < 16; ++r) O[d0][r] *= alpha; }
            float psa[4] = {0.f, 0.f, 0.f, 0.f};
#pragma unroll
            for (int r = 0; r < 16; ++r) { p0[r] = __builtin_amdgcn_exp2f(p0[r] - m); p1[r] = __builtin_amdgcn_exp2f(p1[r] - m); psa[r & 3] += p0[r] + p1[r]; }
            l += (psa[0] + psa[1]) + (psa[2] + psa[3]);
            pf[0] = packp(p0, 0); pf[1] = packp(p0, 8); pf[2] = packp(p1, 0); pf[3] = packp(p1, 8);
            AT_SB();
            if (lag) { pend = true; pslot = cur; } else AT_PV(cur);
        }
        const int nx = cur == 2 ? 0 : cur + 1;
        if (more) ATT_WRITE(wk, wv, nx);
        __syncthreads();
        cur = nx;
    };
    if (AHEAD == 2) { for (int t = t0; t < t1; t += 2) { step(t, skA, svA, skB, svB); if (t + 1 < t1) step(t + 1, skB, svB, skA, svA); } }
    else { for (int t = t0; t < t1; ++t) step(t, skA, svA, skA, svA); }
    if (lag && pend) AT_PV(pslot);
#undef AT_PV
#undef AT_SB
#undef AT_RDK
#undef AT_MMK
#undef AT_RDV
#undef AT_MMV
#undef ATT_LOAD
#undef ATT_WRITE
    const float lt = hswap_add(l), inv = lt > 0.f ? 1.f / lt : 0.f;
    bf16_t* op = outp + (size_t)(32 * wave + r32) * ostride + 4 * hh;
#pragma unroll
    for (int d0 = 0; d0 < 4; ++d0)
#pragma unroll
        for (int g = 0; g < 4; ++g) { uint2 w; w.x = pg8::cvt_pk_bf16(O[d0][4 * g] * inv, O[d0][4 * g + 1] * inv); w.y = pg8::cvt_pk_bf16(O[d0][4 * g + 2] * inv, O[d0][4 * g + 3] * inv);
            *(uint2*)(op + 32 * d0 + 8 * g) = w; }
    if (ml && hh == 0) ml[32 * wave + r32] = make_float2(m, lt);
}
constexpr int ATT_NCU = 13;
__device__ __forceinline__ int att_B(int j) {
    constexpr int T[14] = {0, 45, 88, 131, 176, 219, 262, 305, 348, 391, 432, 475, 515, 544};
    int r = T[13];
#pragma unroll
    for (int k = 12; k >= 0; --k) r = (j <= k) ? T[k] : r;
    return r; }
static_assert(ATT_NCU == 13, "att_B table is for 13 CUs per (b,h)");
__device__ __forceinline__ int att_off(int u) { return 64 * u - 2 * u * (u - 1); }
__device__ __forceinline__ void phase(LAS unsigned char* L, const bf16_t* Q, const bf16_t* Kf, const bf16_t* V, bf16_t* om, unsigned char* ws, int bh, int j, int wave, int lane) {
    bf16_t* PO = (bf16_t*)(ws + WS_ATTP); float2* PML = (float2*)(ws + WS_ATTML);
    const int b = bh >> 3, h = bh & 7, lo = att_B(j), hi = att_B(j + 1);
    int pos = lo, u = 0;
    while (att_off(u + 1) <= pos) ++u;
    while (pos < hi) { const int off = att_off(u), n = 4 * (16 - u), t0 = pos - off, t1 = (hi - off < n) ? hi - off : n, qb = 15 - u;
        if (t0 == 0 && t1 == n) segment(L, Q, Kf, V, b, h, qb, 0, n, om + ((size_t)b * SEQ + 256 * qb) * 1024 + h * 128, 1024, nullptr, wave, lane);
        else { const int slot = bh * (2 * ATT_NCU) + (t0 > 0 ? 2 * j - 1 : 2 * j);
            segment(L, Q, Kf, V, b, h, qb, t0, t1, PO + (size_t)slot * 256 * 128, 128, PML + slot * 256, wave, lane); }
        pos = off + t1; ++u; }
}
constexpr int CB_ITEMS = 16 * 10 * 64;
__device__ __forceinline__ int cb_unit(int ci) { return ci < 8 ? ci : (ci == 8 ? 10 : 12); }
__device__ __forceinline__ void combine(bf16_t* om, unsigned char* ws, int gw, int NGW, int lane) {
    const bf16_t* PO = (const bf16_t*)(ws + WS_ATTP); const float2* PML = (const float2*)(ws + WS_ATTML);
    const int rsub = lane >> 4, c8 = (lane & 15) * 8;
#define CB_LOAD(NP, ML, POV, DST, it_) do { NP = 0; if ((it_) < CB_ITEMS) { const int q_ = (it_) >> 6, rg = (it_) & 63, bh = q_ / 10, u = cb_unit(q_ - bh * 10), b = bh >> 3, h = bh & 7; \
        const int off = att_off(u), n = 4 * (16 - u); int jf = 0, jl = 0; \
        _Pragma("unroll") for (int jj = 1; jj < ATT_NCU; ++jj) { if (att_B(jj) <= off) jf = jj; if (att_B(jj) < off + n) jl = jj; } \
        if (jf != jl) { const int row = rg * 4 + rsub; NP = jl - jf + 1; DST = om + ((size_t)b * SEQ + 256 * (15 - u) + row) * 1024 + h * 128 + c8; \
            _Pragma("unroll") for (int p = 0; p < 3; ++p) if (jf + p <= jl) { const int jj = jf + p, slot = bh * (2 * ATT_NCU) + (p == 0 ? 2 * jj : 2 * jj - 1); \
                ML[p] = PML[slot * 256 + row]; POV[p] = *(const pg8::u32x4*)(PO + ((size_t)slot * 256 + row) * 128 + c8); } } } } while (0)
    int npA, npB; float2 mlA[3], mlB[3]; pg8::u32x4 poA[3], poB[3]; bf16_t* dA; bf16_t* dB;
#define CB_PROC(NP, ML, POV, DST) do { if (NP) { float mm = ML[0].x; _Pragma("unroll") for (int p = 1; p < 3; ++p) if (p < NP) mm = fmaxf(mm, ML[p].x); \
        f32x4 o0 = {0.f, 0.f, 0.f, 0.f}, o1 = o0; float wsum = 0.f; \
        _Pragma("unroll") for (int p = 0; p < 3; ++p) if (p < NP) { const float w = ML[p].y * __builtin_amdgcn_exp2f(ML[p].x - mm); f32x4 a, c; pg8::unpack8(POV[p], a, c); o0 += w * a; o1 += w * c; wsum += w; } \
        const float inv = 1.f / wsum; *(pg8::u32x4*)(DST) = pg8::pack8(o0 * inv, o1 * inv); } } while (0)
    int it = gw;
    CB_LOAD(npA, mlA, poA, dA, it);
    for (; it < CB_ITEMS; it += 2 * NGW) {
        CB_LOAD(npB, mlB, poB, dB, it + NGW);
        CB_PROC(npA, mlA, poA, dA);
        CB_LOAD(npA, mlA, poA, dA, it + 2 * NGW);
        CB_PROC(npB, mlB, poB, dB);
    }
#undef CB_LOAD
#undef CB_PROC
}
}
namespace gla {
typedef short bf16x8 __attribute__((ext_vector_type(8)));
typedef float f32x16 __attribute__((ext_vector_type(16)));
typedef __attribute__((address_space(3))) const unsigned char* lcp;
constexpr size_t WS_IMG = 32 * MiB, WS_VT = 252 * MiB;
constexpr int IMG_STRIDE = 73728;
constexpr int PROW = 528;
constexpr int L_GL = 0, L_TOT = 4096, L_BLAST = 5120, L_QB = 8192, L_KB = L_QB + 64 * PROW, L_VS = L_KB + 64 * PROW;
__device__ __forceinline__ int crow(int r, int hi) { return (r & 3) + 8 * (r >> 2) + 4 * hi; }
__device__ __forceinline__ unsigned pk(float lo, float hi) { return pg8::cvt_pk_bf16(lo, hi); }
__device__ __forceinline__ bf16x8 packs(const f32x16& p, int b) { pg8::u32x4 w; w.x = pk(p[b], p[b + 1]); w.y = pk(p[b + 2], p[b + 3]); w.z = pk(p[b + 4], p[b + 5]); w.w = pk(p[b + 6], p[b + 7]); return __builtin_bit_cast(bf16x8, w); }

__device__ __forceinline__ void prep_item(LAS unsigned char* L, const bf16_t* z, const float* wg, const float* bg, unsigned char* ws, int bh, int c, int wave, int lane_) {
    const int tid = fresh_tid(), lane = tid & 63, b = bh >> 2, h = bh & 3; const size_t rb = (size_t)b * SEQ + 64 * c; const int ic = bh * 64 + c;
    unsigned char* img = ws + WS_IMG + (size_t)ic * IMG_STRIDE; bf16_t* vT = (bf16_t*)(ws + WS_VT);
    LAS float* GL = (LAS float*)(L + L_GL); LAS float* TOT = (LAS float*)(L + L_TOT); LAS float* BLAST = (LAS float*)(L + L_BLAST);
    pg8::u32x4 rq[4], rk[4], rv[4];
#pragma unroll
    for (int i = 0; i < 4; ++i) { const int q = tid + 512 * i, tok = q >> 5, ch = q & 31; rq[i] = *(const pg8::u32x4*)(z + (rb + tok) * ZB_LD + OFF_GQ + h * 256 + ch * 8); rk[i] = *(const pg8::u32x4*)(z + (rb + tok) * ZB_LD + OFF_GK + h * 256 + ch * 8);
        rv[i] = *(const pg8::u32x4*)(z + (rb + tok) * ZB_LD + OFF_GV + h * 512 + ch * 8); }
    for (int i = 0; i < 2; ++i) { const int idx = tid + 512 * i, tok = idx >> 4, r = idx & 15; GL[idx] = bf2f(z[(rb + tok) * ZB_LD + OFF_GLR + r]); }
    __syncthreads();
    const int d = tid & 255, half = tid >> 8;
    float wgc[16];
#pragma unroll
    for (int r = 0; r < 16; ++r) wgc[r] = wg[r * 1024 + h * 256 + d];
    const float bias = bg[h * 256 + d];
    float bl[32]; float run = 0.f;
#pragma unroll
    for (int i = 0; i < 32; ++i) { const int tok = 32 * half + i; float xg = bias;
#pragma unroll
        for (int r = 0; r < 16; ++r) xg += GL[tok * 16 + r] * wgc[r];
        const float ls = fminf(xg, 0.f) - __logf(1.f + __expf(-fabsf(xg)));
        run += ls * (1.f / 16.f); bl[i] = run; }
    if (half == 0) TOT[d] = run;
#pragma unroll
    for (int i = 0; i < 4; ++i) { const int q = tid + 512 * i, tok = q >> 5, ch = q & 31; *(LAS pg8::u32x4*)(L + L_QB + tok * PROW + ch * 16) = rq[i]; *(LAS pg8::u32x4*)(L + L_KB + tok * PROW + ch * 16) = rk[i]; *(LAS pg8::u32x4*)(L + L_VS + tok * PROW + ch * 16) = rv[i];
        rv[i] = *(const pg8::u32x4*)(z + (rb + tok) * ZB_LD + OFF_GV + h * 512 + 256 + ch * 8); }
    __syncthreads();
    if (half == 1) { const float t0 = TOT[d];
#pragma unroll
        for (int i = 0; i < 32; ++i) bl[i] += t0;
        BLAST[d] = bl[31]; }
    __syncthreads();
    const float blast = BLAST[d];
    if (half == 0) *(float*)(img + 70 * 1024 + d * 4) = __expf(blast);
#pragma unroll
    for (int g = 0; g < 4; ++g) { float klv[8];
#pragma unroll
        for (int j = 0; j < 8; ++j) { const int i = 8 * g + j, tok = 32 * half + i;
            const float qv = bf2f(*(const LAS bf16_t*)(L + L_QB + tok * PROW + d * 2)), kv = bf2f(*(const LAS bf16_t*)(L + L_KB + tok * PROW + d * 2));
            *(LAS bf16_t*)(L + L_QB + tok * PROW + d * 2) = f2bf(qv * 0.0625f * __expf(bl[i]));
            *(LAS bf16_t*)(L + L_KB + tok * PROW + d * 2) = f2bf(kv * __expf(-bl[i]));
            klv[j] = kv * __expf(blast - bl[i]); }
        pg8::u32x4 w; w.x = pk(klv[0], klv[1]); w.y = pk(klv[2], klv[3]); w.z = pk(klv[4], klv[5]); w.w = pk(klv[6], klv[7]);
        *(pg8::u32x4*)(img + (38 + (d >> 4) * 2 + half) * 1024 + (g * 16 + (d & 15)) * 16) = w; }
    __syncthreads();
#pragma unroll
    for (int i = 0; i < 4; ++i) { const int q = tid + 512 * i, tok = q >> 5, ch = q & 31, t = ch >> 2, gq = ch & 3;
        typedef unsigned u32x2_t __attribute__((ext_vector_type(2)));
        const u32x2_t lo = *(const LAS u32x2_t*)(L + L_QB + tok * PROW + (32 * t + 4 * gq) * 2), hi = *(const LAS u32x2_t*)(L + L_QB + tok * PROW + (32 * t + 16 + 4 * gq) * 2);
        pg8::u32x4 w; w.x = lo.x; w.y = lo.y; w.z = hi.x; w.w = hi.y;
        *(pg8::u32x4*)(img + ((tok >> 4) * 8 + t) * 1024 + (gq * 16 + (tok & 15)) * 16) = w; }
    if (wave < 4) { const int ti = wave >> 1, tj = wave & 1, r32 = lane & 31, hh = lane >> 5; f32x16 C;
#pragma unroll
        for (int r = 0; r < 16; ++r) C[r] = 0.f;
        if (tj <= ti) { lcp ka = (lcp)(L + L_KB + (32 * tj + r32) * PROW + hh * 16); lcp qa = (lcp)(L + L_QB + (32 * ti + r32) * PROW + hh * 16);
#pragma unroll
            for (int s = 0; s < 16; ++s) { const bf16x8 kf = *(const __attribute__((address_space(3))) bf16x8*)(ka + s * 32), qf = *(const __attribute__((address_space(3))) bf16x8*)(qa + s * 32);
                C = __builtin_amdgcn_mfma_f32_32x32x16_bf16(kf, qf, C, 0, 0, 0); } }
        const int irow = 32 * ti + r32;
#pragma unroll
        for (int g = 0; g < 4; ++g) { float v[4];
#pragma unroll
            for (int q = 0; q < 4; ++q) { const int j = 32 * tj + crow(4 * g + q, hh); v[q] = (j <= irow) ? C[4 * g + q] : 0.f; }
            uint2 w; w.x = pk(v[0], v[1]); w.y = pk(v[2], v[3]);
            const int tt = irow >> 4, P = tt < 2 ? 32 + tt : 34 + (tt - 2) * 2 + tj;
            if (tj <= ti) *(uint2*)(img + P * 1024 + (g * 16 + (irow & 15)) * 16 + hh * 8) = w; } }
    for (int e0 = 0; e0 < 512; e0 += 256) {
        if (e0) {
#pragma unroll
            for (int i = 0; i < 4; ++i) { const int q = tid + 512 * i, tok = q >> 5, ch = q & 31; *(LAS pg8::u32x4*)(L + L_VS + tok * PROW + ch * 16) = rv[i]; }
            __syncthreads(); }
#pragma unroll
        for (int g = 0; g < 4; ++g) { unsigned short t8[8];
#pragma unroll
            for (int j = 0; j < 8; ++j) t8[j] = *(const LAS bf16_t*)(L + L_VS + (32 * half + 8 * g + j) * PROW + d * 2);
            pg8::u32x4 w; w.x = t8[0] | ((unsigned)t8[1] << 16); w.y = t8[2] | ((unsigned)t8[3] << 16); w.z = t8[4] | ((unsigned)t8[5] << 16); w.w = t8[6] | ((unsigned)t8[7] << 16);
            *(pg8::u32x4*)(vT + ((size_t)ic * 512 + e0 + d) * 64 + 32 * half + 8 * g) = w; }
        __syncthreads();
    }
}
__device__ __forceinline__ void prep_phase(LAS unsigned char* L, const bf16_t* z, const float* wg, const float* bg, unsigned char* ws, int vcu, int G, int wave, int lane) {
    for (int it = vcu; it < 512; it += G) prep_item(L, z, wg, bg, ws, it >> 6, it & 63, wave, lane);
}
typedef float f32x4a __attribute__((ext_vector_type(4)));
constexpr int SC_NP = 71, SC_BUF = SC_NP * 1024;
template <int MODE>
__device__ __forceinline__ void scan_chunk(LAS unsigned char* L, f32x4a (&S)[16], const bf16x8 vf0, const bf16x8 vf1, const int c, bf16_t* ogp, const int lane, const int g4) {
        const int buf = c & 1;
        lcp F = (lcp)(L + buf * SC_BUF + lane * 16);
#define SC_FRAG(p) (*(const __attribute__((address_space(3))) bf16x8*)(F + (p) * 1024))
        f32x4a OT[4];
#pragma unroll
        for (int tt = 0; tt < 4; ++tt) OT[tt] = (f32x4a){0.f, 0.f, 0.f, 0.f};
#define SC_SB() __builtin_amdgcn_sched_barrier(0)
#define SC_RDQ(dst, t) do { _Pragma("unroll") for (int tt = 0; tt < 4; ++tt) dst[tt] = SC_FRAG(tt * 8 + (t)); } while (0)
#define SC_SF(t) ({ pg8::u32x4 w_; w_.x = pk(S[2 * (t)][0], S[2 * (t)][1]); w_.y = pk(S[2 * (t)][2], S[2 * (t)][3]); w_.z = pk(S[2 * (t) + 1][0], S[2 * (t) + 1][1]); w_.w = pk(S[2 * (t) + 1][2], S[2 * (t) + 1][3]); __builtin_bit_cast(bf16x8, w_); })
#define SC_MMQ(src, t) do { const bf16x8 sf_ = SC_SF(t); __builtin_amdgcn_s_setprio(1); _Pragma("unroll") for (int tt = 0; tt < 4; ++tt) OT[tt] = __builtin_amdgcn_mfma_f32_16x16x32_bf16(sf_, src[tt], OT[tt], 0, 0, 0); __builtin_amdgcn_s_setprio(0); } while (0)
        { bf16x8 qa[4], qb_[4], fa[6];
          SC_RDQ(qa, 0); SC_SB();
#pragma unroll
          for (int t = 0; t < 8; t += 2) { SC_RDQ(qb_, t + 1); SC_SB(); SC_MMQ(qa, t); SC_SB();
              if (t + 2 < 8) { SC_RDQ(qa, t + 2); } else {
#pragma unroll
                  for (int k = 0; k < 6; ++k) fa[k] = SC_FRAG(32 + k); }
              SC_SB(); SC_MMQ(qb_, t + 1); SC_SB(); }
          OT[0] = __builtin_amdgcn_mfma_f32_16x16x32_bf16(vf0, fa[0], OT[0], 0, 0, 0);
          OT[1] = __builtin_amdgcn_mfma_f32_16x16x32_bf16(vf0, fa[1], OT[1], 0, 0, 0);
          OT[2] = __builtin_amdgcn_mfma_f32_16x16x32_bf16(vf0, fa[2], OT[2], 0, 0, 0); OT[2] = __builtin_amdgcn_mfma_f32_16x16x32_bf16(vf1, fa[3], OT[2], 0, 0, 0);
          OT[3] = __builtin_amdgcn_mfma_f32_16x16x32_bf16(vf0, fa[4], OT[3], 0, 0, 0); OT[3] = __builtin_amdgcn_mfma_f32_16x16x32_bf16(vf1, fa[5], OT[3], 0, 0, 0); }
        const __attribute__((address_space(3))) float* E = (const __attribute__((address_space(3))) float*)(L + buf * SC_BUF + 70 * 1024);
#define SC_RDK(kd, ed, q) do { _Pragma("unroll") for (int i_ = 0; i_ < 4; ++i_) { kd[2 * i_] = SC_FRAG(38 + ((q) * 4 + i_) * 2); kd[2 * i_ + 1] = SC_FRAG(39 + ((q) * 4 + i_) * 2); \
            ed[i_] = *(const __attribute__((address_space(3))) f32x4a*)(E + 16 * ((q) * 4 + i_) + 4 * g4); } } while (0)
#define SC_UPD(kd, ed, q) do { _Pragma("unroll") for (int i_ = 0; i_ < 4; ++i_) { const int dt_ = (q) * 4 + i_; S[dt_] = S[dt_] * ed[i_]; } __builtin_amdgcn_s_setprio(1); \
            _Pragma("unroll") for (int i_ = 0; i_ < 4; ++i_) { const int dt_ = (q) * 4 + i_; S[dt_] = __builtin_amdgcn_mfma_f32_16x16x32_bf16(kd[2 * i_], vf0, S[dt_], 0, 0, 0); S[dt_] = __builtin_amdgcn_mfma_f32_16x16x32_bf16(kd[2 * i_ + 1], vf1, S[dt_], 0, 0, 0); } __builtin_amdgcn_s_setprio(0); } while (0)
        { bf16x8 ka[8], kb_[8]; f32x4a ea[4], eb_[4];
          SC_RDK(ka, ea, 0); SC_SB();
#pragma unroll
          for (int tt = 0; tt < 4; ++tt) { uint2 w; w.x = pk(OT[tt][0], OT[tt][1]); w.y = pk(OT[tt][2], OT[tt][3]);
              if (MODE != 2 || c < 1) *(uint2*)(ogp + (size_t)(64 * c + 16 * tt) * DM) = w; }
          SC_RDK(kb_, eb_, 1); SC_SB(); SC_UPD(ka, ea, 0); SC_SB();
          SC_RDK(ka, ea, 2); SC_SB(); SC_UPD(kb_, eb_, 1); SC_SB();
          SC_RDK(kb_, eb_, 3); SC_SB(); SC_UPD(ka, ea, 2); SC_SB();
          SC_UPD(kb_, eb_, 3); }
#undef SC_SB
#undef SC_RDQ
#undef SC_SF
#undef SC_MMQ
#undef SC_RDK
#undef SC_UPD
#undef SC_FRAG
}
template <int MODE>
__device__ __forceinline__ void scan_phase(LAS unsigned char* L, unsigned char* ws, bf16_t* og, int bh, int sub, int wave, int lane_) {
    const int lane = fresh_tid() & 63;
    const bf16_t* vT = (const bf16_t*)(ws + WS_VT);
    const int nsl = sub < 2 ? 6 : 5, slice = (sub < 2 ? 6 * sub : 12 + 5 * (sub - 2)) + wave, b = bh >> 2, h = bh & 3, l15 = lane & 15, g4 = lane >> 4; const bool comp = wave < nsl;
    const unsigned char* img = ws + WS_IMG + (size_t)bh * 64 * IMG_STRIDE + lane * 16;
#define SC_BARRIER() do { asm volatile("" ::: "memory"); __builtin_amdgcn_s_barrier(); asm volatile("" ::: "memory"); } while (0)
    if (!comp) { const int dw = wave - nsl, ndma = 8 - nsl;
#define SC_DMA(c, buf) do { for (int p = dw; p < SC_NP; p += ndma) \
        __builtin_amdgcn_global_load_lds((const unsigned*)(img + (size_t)(c) * IMG_STRIDE + p * 1024), (LAS unsigned*)(L + (buf) * SC_BUF + p * 1024), 16, 0, 0); } while (0)
        SC_DMA(0, 0); asm volatile("s_waitcnt vmcnt(0)" ::: "memory"); SC_BARRIER();
        for (int c = 0; c < 64; ++c) { if (c + 1 < 64 && (MODE != 1 || c < 1)) SC_DMA(c + 1, (c & 1) ^ 1); asm volatile("s_waitcnt vmcnt(0)" ::: "memory"); SC_BARRIER(); }
#undef SC_DMA
        return; }
    f32x4a S[16];
#pragma unroll
    for (int dt = 0; dt < 16; ++dt) S[dt] = (f32x4a){0.f, 0.f, 0.f, 0.f};
    const bf16_t* vbase = vT + ((size_t)bh * 64 * 512 + 16 * slice + l15) * 64 + 8 * g4;
    bf16x8 va0 = *(const bf16x8*)(vbase), va1 = *(const bf16x8*)(vbase + 32);
    { pg8::u32x4 t0 = __builtin_bit_cast(pg8::u32x4, va0), t1 = __builtin_bit_cast(pg8::u32x4, va1); asm volatile("" : "+v"(t0), "+v"(t1)); va0 = __builtin_bit_cast(bf16x8, t0); va1 = __builtin_bit_cast(bf16x8, t1); }
    SC_BARRIER();
    bf16_t* ogp = og + ((size_t)b * SEQ + l15) * DM + h * 512 + 16 * slice + 4 * g4;
    for (int c = 0; c < 64; c += 2) {
        bf16x8 vb0 = *(const bf16x8*)(vbase + (size_t)(c + 1) * 512 * 64), vb1 = *(const bf16x8*)(vbase + (size_t)(c + 1) * 512 * 64 + 32);
        scan_chunk<MODE>(L, S, va0, va1, c, ogp, lane, g4);
        SC_BARRIER();
        { const int cn = c + 2 < 64 ? c + 2 : 63; va0 = *(const bf16x8*)(vbase + (size_t)cn * 512 * 64); va1 = *(const bf16x8*)(vbase + (size_t)cn * 512 * 64 + 32); }
        scan_chunk<MODE>(L, S, vb0, vb1, c + 1, ogp, lane, g4);
        SC_BARRIER();
    }
#undef SC_BARRIER
}
}
#ifndef EXTRA_BARRIERS
#define EXTRA_BARRIERS 0
#endif
#ifndef STAMP_Q
#define STAMP_Q 10.f
#endif
#ifndef DBG_STAMP
#define DBG_STAMP 0
#endif
#ifndef REP0_PART
#define REP0_PART 0
#endif
#ifndef REP5_ROLE
#define REP5_ROLE 0
#endif
#ifndef REPEAT_MASK
#define REPEAT_MASK 0u
#endif
#ifndef SCAN_DIAG
#define SCAN_DIAG 0
#endif
#ifndef DBG_SCAN
#define DBG_SCAN 0
#endif
#if DBG_SCAN
#define DBG_SCAN_OUT ((bf16_t*)(ws + WS_Q))
#else
#define DBG_SCAN_OUT og
#endif
constexpr size_t WS_HLAST = 1 * MiB + 512 * 1024, WS_HFIRST = 4 * MiB;
constexpr size_t WS_RX = 7 * MiB;
constexpr int CW_RX = 24576;
constexpr int WUP_EARLY = 1920, WUP_SCAN = 384;
constexpr size_t WS_WUP = 376 * MiB, WS_WDN = 134 * MiB;
__global__ void __launch_bounds__(NWAVES * 64, 2) mk_fwd(Args args) {
    extern __shared__ __attribute__((aligned(16))) unsigned char lds[];
    LAS unsigned char* L = (LAS unsigned char*)lds;
    volatile LAS unsigned* MISC = (volatile LAS unsigned*)(L + MISC_OFF);
    const int tid = threadIdx.x, wave = __builtin_amdgcn_readfirstlane(tid >> 6);
#define FL (fresh_tid() & 63)
#define STAMPP_BEGIN(ph) unsigned long long tsp_##ph = 0; if (DBG_STAMP == 10 + (ph) && bx == 0) tsp_##ph = __builtin_amdgcn_s_memrealtime();
#define STAMPP_END(ph) do { if (DBG_STAMP == 10 + (ph) && bx == 0) { __syncthreads(); if (threadIdx.x == 0) { const float us_ = STAMP_Q * (float)(int)((float)(__builtin_amdgcn_s_memrealtime() - tsp_##ph) * 0.01f / STAMP_Q + 0.5f); __hip_atomic_store((unsigned*)(ctl + 512), __float_as_uint(us_), RLX_AGENT); } } } while (0)
#define STAMP_BEGIN(id, cond) unsigned long long ts_##id = 0; if (DBG_STAMP == (id) && (cond)) ts_##id = __builtin_amdgcn_s_memrealtime();
#define STAMP_END(id, cond) do { if (DBG_STAMP == (id) && (cond)) { __syncthreads(); if (threadIdx.x == 0) { const float us_ = STAMP_Q * (float)(int)((float)(__builtin_amdgcn_s_memrealtime() - ts_##id) * 0.01f / STAMP_Q + 0.5f);     __hip_atomic_store((unsigned*)(ctl + 512), __float_as_uint(us_), RLX_AGENT); } } } while (0)
    const int G = gridDim.x, bx = blockIdx.x; const int vcu = (G % 8 == 0) ? (bx % 8) * (G / 8) + bx / 8 : bx;
    const int gw = vcu * NWAVES + wave, NGW = G * NWAVES;
    unsigned char* ws = args.ws;
    gu32* ctl = (gu32*)(ws + WS_CTL);
    for (int u = tid; u < (LDS_BYTES - LDSCTL_OFF) / 4; u += NWAVES * 64) ((LAS unsigned*)(L + LDSCTL_OFF))[u] = 0u;
    __syncthreads();
    XcdBarrier bar = xcd_barrier_post((unsigned*)(ctl + CW_BAR), MISC + 8);
    const int lo = args.ph_lo, hi = args.ph_hi;
#define IN(k) (lo <= (k) && (k) < hi)
#define SEAM(k) do { if (IN(k) && IN((k) + 1)) { unsigned long long tb_ = 0; if (DBG_STAMP == 40 + (k) && bx == 0) tb_ = __builtin_amdgcn_s_memrealtime(); xcd_barrier(bar); \
        if (DBG_STAMP == 40 + (k) && bx == 0 && threadIdx.x == 0) { const float us_ = STAMP_Q * (float)(int)((float)(__builtin_amdgcn_s_memrealtime() - tb_) * 0.01f / STAMP_Q + 0.5f); __hip_atomic_store((unsigned*)(ctl + 512), __float_as_uint(us_), RLX_AGENT); } } } while (0)
    const float* x = (const float*)args.in[0]; float* out = args.out;
    float* mod = (float*)(ws + WS_MOD); float2* cs = (float2*)(ws + WS_CS);
    float* statq = (float*)(ws + WS_RSTD); float* statkv = statq + MTOK * 8;
    bf16_t* hbuf = (bf16_t*)(ws + WS_H); bf16_t* zA = (bf16_t*)(ws + WS_ZA); bf16_t* zB = (bf16_t*)(ws + WS_ZB);
    bf16_t* Win_t = (bf16_t*)(ws + WS_WIN); bf16_t* Wq_t = (bf16_t*)(ws + WS_WQ); bf16_t* Wkv_t = (bf16_t*)(ws + WS_WKV);
    bf16_t* Wa_t = (bf16_t*)(ws + WS_WA); bf16_t* Wb_t = (bf16_t*)(ws + WS_WB); bf16_t* Wmix_t = (bf16_t*)(ws + WS_WMIX);
    bf16_t* Wup_t = (bf16_t*)(ws + WS_WUP); bf16_t* Wdn_t = (bf16_t*)(ws + WS_WDN);
    bf16_t* Q = (bf16_t*)(ws + WS_Q); bf16_t* Kf = (bf16_t*)(ws + WS_K); bf16_t* V = (bf16_t*)(ws + WS_V);
    bf16_t* om = (bf16_t*)(ws + WS_OM); bf16_t* og = (bf16_t*)(ws + WS_OG); bf16_t* t1 = (bf16_t*)(ws + WS_T1); bf16_t* merged = (bf16_t*)(ws + WS_MERGED);
    bf16_t* y = (bf16_t*)(ws + WS_Y); bf16_t* h2 = (bf16_t*)(ws + WS_H); bf16_t* act = (bf16_t*)(ws + WS_ACT_N); bf16_t* f = (bf16_t*)(ws + WS_F); bf16_t* x1b = (bf16_t*)(ws + WS_F);

    STAMPP_BEGIN(0);
    for (int rep_ = 0; rep_ < 1 + (int)((REPEAT_MASK >> 0) & 1u); ++rep_) if (IN(0)) { const int lane = FL;
        if (rep_ == 0 || REP0_PART == 1) p0_ada((const float*)args.in[1], (const float*)args.in[3], (const float*)args.in[4], mod, (LAS float*)L, vcu, wave, FL);
        LAS float* scr = (LAS float*)(L + wave * 16640);
        int cursor = 0;
        if (rep_ == 0 || REP0_PART == 3) {
            if (G == 256) { if (vcu >= 192) tr_matrix((const float*)args.in[6], DM, DIN, LDZ, Win_t, scr, cursor, gw - 1536, 512, lane, ScIn{}, nullptr, 1.f, 0, 2560);
                            else tr_matrix((const float*)args.in[6], DM, DIN, LDZ, Win_t, scr, cursor, gw, 1536, lane, ScIn{}, nullptr, 1.f, 2560, 0x7fffffff); }
            else tr_matrix((const float*)args.in[6], DM, DIN, LDZ, Win_t, scr, cursor, gw, NGW, lane, ScIn{}, nullptr, 1.f); }
    }
    STAMPP_END(0); SEAM(0);
    STAMPP_BEGIN(1);
    for (int rep_ = 0; rep_ < 1 + (int)((REPEAT_MASK >> 1) & 1u); ++rep_) if (IN(1)) {
        const float* g = (const float*)args.in[5]; const int lane = FL;
        f32x4 v[8], vn[8];
        int m = gw; if (m < MTOK) {
#pragma unroll
            for (int j = 0; j < 8; ++j) v[j] = __builtin_nontemporal_load((const f32x4*)(x + (size_t)m * DM) + lane + 64 * j); }
        for (; m < MTOK; m += NGW) { const int b = m / SEQ, mn = m + NGW;
            if (mn < MTOK) {
#pragma unroll
                for (int j = 0; j < 8; ++j) vn[j] = __builtin_nontemporal_load((const f32x4*)(x + (size_t)mn * DM) + lane + 64 * j); }
            float s = 0.f;
#pragma unroll
            for (int j = 0; j < 8; ++j) s += (v[j].x * v[j].x + v[j].y * v[j].y) + (v[j].z * v[j].z + v[j].w * v[j].w);
            const float rstd = rsqrtf(wave_sum(s) * (1.f / DM) + EPSN);
            const f32x4* gp = (const f32x4*)g + lane; const f32x4* shp = (const f32x4*)(mod + b * 12288) + lane; const f32x4* scp = (const f32x4*)(mod + b * 12288 + 2048) + lane;
            unsigned long long* o8 = (unsigned long long*)(hbuf + (size_t)m * DM) + lane;
#pragma unroll
            for (int j = 0; j < 8; ++j) { const f32x4 r = v[j] * rstd * gp[64 * j] * (1.f + scp[64 * j]) + shp[64 * j];
                o8[64 * j] = (unsigned long long)pk2(r.x, r.y) | ((unsigned long long)pk2(r.z, r.w) << 32); }
#pragma unroll
            for (int j = 0; j < 8; ++j) v[j] = vn[j]; }
    }
    STAMPP_END(1); SEAM(1);
    STAMPP_BEGIN(2);
    for (int rep_ = 0; rep_ < 1 + (int)((REPEAT_MASK >> 2) & 1u); ++rep_) if (IN(2)) {
        pg8::Gemm g{hbuf, Win_t, MTOK, LDZ, DM, DM}; pg8::StaticOrder S; S.init(MTOK, LDZ, G, bx);
        pg8::EpiZ E{zA, zB, statq, statkv};
        pg8::gemm_phase<pg8::EpiZ, pg8::StaticOrder, true, true>(L, g, S, E);
        if (rep_ == 0 && G == 256 && bx >= 128) { const int lane = FL, sgw = (bx - 128) * NWAVES + wave, SNGW = 128 * NWAVES; LAS float* scr = (LAS float*)(L + wave * 16640); int cursor = 0;
            p0_cs((const int*)args.in[2], cs, sgw, SNGW, lane);
            tr_matrix((const float*)args.in[8], 512, 1536, 1536, Wq_t, scr, cursor, sgw, SNGW, lane, ScQ{}, (const float*)args.in[7], QK_C2);
            tr_matrix((const float*)args.in[10], 256, 2048, 2048, Wkv_t, scr, cursor, sgw, SNGW, lane, ScNat{2048}, (const float*)args.in[9], 1.f);
            tr_matrix((const float*)args.in[14], 1024, DM, DM, Wa_t, scr, cursor, sgw, SNGW, lane, ScNat{DM}, nullptr, 1.f);
            tr_matrix((const float*)args.in[15], DM, DM, DM, Wb_t, scr, cursor, sgw, SNGW, lane, ScNat{DM}, nullptr, 1.f);
            tr_matrix((const float*)args.in[16], DM, DM, DM, Wmix_t, scr, cursor, sgw, SNGW, lane, ScNat{DM}, nullptr, 1.f);
            tr_matrix((const float*)args.in[19], DM, DFF2, DFF2, Wup_t, scr, cursor, sgw, SNGW, lane, ScUp{}, nullptr, 1.f, 0, WUP_EARLY); }
    }
    STAMPP_END(2); SEAM(2);
    STAMPP_BEGIN(3);
    for (int rep_ = 0; rep_ < 1 + (int)((REPEAT_MASK >> 3) & 1u); ++rep_) if (IN(3)) {
        { pg8::Gemm g{zB + OFF_QLAT, Wq_t, MTOK, 1536, 512, ZB_LD}; pg8::StaticOrder S; S.init(MTOK, 1536, G, bx);
          pg8::EpiQo E{Q, statq, cs}; pg8::gemm_phase<pg8::EpiQo, pg8::StaticOrder, true, true>(L, g, S, E); }
        { pg8::Gemm g{zB + OFF_KVLAT, Wkv_t, MTOK, 2048, 256, ZB_LD}; pg8::StaticOrder S; S.init(MTOK, 2048, G, bx);
          pg8::EpiKVo E{Kf, V, statkv}; pg8::gemm_phase<pg8::EpiKVo, pg8::StaticOrder, true, true>(L, g, S, E); }
        ph_kpe(zB, Kf, cs, gw, NGW, FL);
    }
    STAMPP_END(3);
    STAMPP_BEGIN(4);
    for (int rep_ = 0; rep_ < 1 + (int)((REPEAT_MASK >> 4) & 1u); ++rep_) if (IN(4)) gla::prep_phase(L, zB, (const float*)args.in[11], (const float*)args.in[12], ws, vcu, G, wave, FL);
    STAMPP_END(4); SEAM(4);
    STAMPP_BEGIN(5);
    for (int rep_ = 0; rep_ < 1 + (int)((REPEAT_MASK >> 5) & 1u); ++rep_) if (IN(5)) {
        const int xg = vcu >> 5, jj = vcu & 31;
        if (G != 256) {   }
        else if (jj < 6) {
#if SCAN_DIAG
            { STAMP_BEGIN(4, vcu == 0) gla::scan_phase<SCAN_DIAG>(L, ws, DBG_SCAN_OUT, xg, jj, wave, FL); STAMP_END(4, vcu == 0); __syncthreads(); }
#endif
            STAMP_BEGIN(2, vcu == 0) if (rep_ == 0 || REP5_ROLE != 2) gla::scan_phase<0>(L, ws, DBG_SCAN_OUT, xg, jj, wave, FL); STAMP_END(2, vcu == 0);
            if (rep_ == 0) { __syncthreads(); const int lane = FL, sgw = (xg * 6 + jj) * NWAVES + wave, SNGW = 48 * NWAVES; LAS float* scr = (LAS float*)(L + wave * 16640); int cursor = 0;
                tr_matrix((const float*)args.in[19], DM, DFF2, DFF2, Wup_t, scr, cursor, sgw, SNGW, lane, ScUp{}, nullptr, 1.f, WUP_EARLY, WUP_EARLY + WUP_SCAN); } }
        else { STAMP_BEGIN(1, vcu == 6) STAMP_BEGIN(3, vcu == 6) if (rep_ == 0 || REP5_ROLE != 1) att::phase(L, Q, Kf, V, om, ws, 2 * xg + (jj - 6) / 13, (jj - 6) % 13, wave, FL); STAMP_END(1, vcu == 6);
            if (rep_ == 0) { const int lane = FL, agw = (xg * 26 + (jj - 6)) * NWAVES + wave, ANGW = 208 * NWAVES; LAS float* scr = (LAS float*)(L + wave * 16640); int cursor = 0;
                tr_matrix((const float*)args.in[19], DM, DFF2, DFF2, Wup_t, scr, cursor, agw, ANGW, lane, ScUp{}, nullptr, 1.f, WUP_EARLY + WUP_SCAN, 0x7fffffff); }
            STAMP_END(3, vcu == 6); }
    }
    STAMPP_END(5); SEAM(5);
    STAMPP_BEGIN(7);
    for (int rep_ = 0; rep_ < 1 + (int)((REPEAT_MASK >> 7) & 1u); ++rep_) if (IN(7)) { att::combine(om, ws, gw, NGW, FL); ph_glanorm(og, zA, (const float*)args.in[13], gw, NGW, FL); }
    STAMPP_END(7); SEAM(7);
    STAMPP_BEGIN(8);
    for (int rep_ = 0; rep_ < 1 + (int)((REPEAT_MASK >> 8) & 1u); ++rep_) if (IN(8)) {
        { pg8::Gemm g{om, Wa_t, MTOK, DM, 1024, 1024}; pg8::StaticOrder S; S.init(MTOK, DM, G, bx);
          pg8::EpiGateo E{t1, zA, OFF_GA, nullptr}; pg8::gemm_phase<pg8::EpiGateo, pg8::StaticOrder, true, true>(L, g, S, E); }
        { pg8::Gemm g{og, Wb_t, MTOK, DM, DM, DM}; pg8::StaticOrder S; S.init(MTOK, DM, G, bx);
          pg8::EpiGateo E{merged, zA, OFF_GB, t1}; pg8::gemm_phase<pg8::EpiGateo, pg8::StaticOrder, true, true>(L, g, S, E); }
    }
    STAMPP_END(8); SEAM(8);
    for (int xb_ = 0; xb_ < EXTRA_BARRIERS; ++xb_) xcd_barrier(bar);
    STAMPP_BEGIN(9);
    for (int rep_ = 0; rep_ < 1 + (int)((REPEAT_MASK >> 9) & 1u); ++rep_) if (IN(9) && G == 256) { pg8::Gemm g{merged, Wmix_t, MTOK, DM, DM, DM}; pg8::StaticOrder S; S.init(MTOK, DM, G, bx);
        pg8::Unit u0; (void)S.next(0, u0); float* rx = (float*)(ws + WS_RX); unsigned* cw = (unsigned*)(ctl + CW_RX); unsigned* bw = (unsigned*)(ctl + CW_BAR);
        pg8::EpiResMid E{x, mod, (const float*)args.in[17], (const float*)args.in[18], x1b, h2, pg8::RowX{rx, cw + (rep_ * 96 + u0.pm) * 64, bw}, pg8::RowX{rx + MTOK * 8, cw + (rep_ * 96 + 32 + u0.pm) * 64, bw}};
        pg8::gemm_phase<pg8::EpiResMid, pg8::StaticOrder, true, true>(L, g, S, E); }
    STAMPP_END(9); SEAM(9);
    STAMPP_BEGIN(12);
    for (int rep_ = 0; rep_ < 1 + (int)((REPEAT_MASK >> 12) & 1u); ++rep_) if (IN(12)) { pg8::Gemm g{h2, Wup_t, MTOK, DFF2, DM, DM}; pg8::StaticOrder S; S.init(MTOK, DFF2, G, bx);
        pg8::EpiConv E{act, (const float*)args.in[20], (const float*)args.in[21], (bf16_t*)(ws + WS_HLAST), (float*)(ws + WS_HFIRST), (LAS float*)(L + RING_BYTES)};
        pg8::gemm_phase<pg8::EpiConv, pg8::StaticOrder, true, true>(L, g, S, E);
        if (rep_ == 0 && G == 256 && bx >= 128) { const int lane = FL, sgw = (bx - 128) * NWAVES + wave, SNGW = 128 * NWAVES; LAS float* scr = (LAS float*)(L + wave * 16640); int cursor = 0;
            tr_matrix((const float*)args.in[22], DFF, DM, DM, Wdn_t, scr, cursor, sgw, SNGW, lane, ScNat{DM}, nullptr, 1.f); } }
    STAMPP_END(12); SEAM(12);
    STAMPP_BEGIN(14);
    for (int rep_ = 0; rep_ < 1 + (int)((REPEAT_MASK >> 14) & 1u); ++rep_) if (IN(14) && G == 256) { pg8::Gemm g{act, Wdn_t, MTOK, DM, DFF, DFF}; pg8::StaticOrder S; S.init(MTOK, DM, G, bx);
        { pg8::Unit u0; for (int i = 0; S.next(i, u0); ++i) ph_convfix((const bf16_t*)(ws + WS_HLAST), (const float*)(ws + WS_HFIRST), (const float*)args.in[20], act, u0.pm, wave, FL);
          VM_WAIT(); __syncthreads(); }
        pg8::Unit u1; (void)S.next(0, u1); const float osc = 1.f;
        pg8::EpiResOut E{x1b, mod + 10240, (const float*)args.in[23], out, pg8::RowX{(float*)(ws + WS_RX) + 2 * MTOK * 8, (unsigned*)(ctl + CW_RX) + (rep_ * 96 + 64 + u1.pm) * 64, (unsigned*)(ctl + CW_BAR)}, osc};
        pg8::gemm_phase<pg8::EpiResOut, pg8::StaticOrder, true, true>(L, g, S, E); }
    STAMPP_END(14);
#if DBG_STAMP
    xcd_barrier(bar);
    { const float sc_ = 1.f + 1e-3f * (40.f + __uint_as_float(__hip_atomic_load((unsigned*)(ctl + 512), RLX_AGENT)));     const int lane = FL;
      for (size_t i = (size_t)gw * 64 + lane; i < (size_t)MTOK * DM / 4; i += (size_t)NGW * 64) ((f32x4*)out)[i] *= sc_; }
#endif
#undef IN
#undef SEAM
#undef FL
}

#ifndef OPT_MASK
#define OPT_MASK 0xFFFFu
#endif
static int mk_grid = 0;
static void launch_mk(void* const* d_in, float* out, void* ws, int lo, int hi, hipStream_t stream) {
    if (mk_grid == 0) {
        int dev = 0, cus = 0, per_cu = 0;
        (void)hipGetDevice(&dev); (void)hipDeviceGetAttribute(&cus, hipDeviceAttributeMultiprocessorCount, dev);
        (void)hipFuncSetAttribute((const void*)mk_fwd, hipFuncAttributeMaxDynamicSharedMemorySize, LDS_BYTES);
        (void)hipOccupancyMaxActiveBlocksPerMultiprocessor(&per_cu, (const void*)mk_fwd, NWAVES * 64, LDS_BYTES);
        if (per_cu < 1) { fprintf(stderr, "occupancy query says %d blocks/CU\n", per_cu); per_cu = 1; }
        if (per_cu > 1) per_cu = 1;
        mk_grid = cus * per_cu; (void)hipGetLastError();
    }
    (void)hipMemsetAsync((char*)ws + WS_CTL, 0, 1 * MiB, stream);
    Args a{}; for (int i = 0; i < 24; ++i) a.in[i] = d_in[i]; a.out = out; a.ws = (unsigned char*)ws; a.ph_lo = lo; a.ph_hi = hi;
    void* kargs[] = {&a};
#ifndef MK_COOP
#define MK_COOP 1
#endif
#if MK_COOP
    hipError_t e = hipLaunchCooperativeKernel((const void*)mk_fwd, dim3(mk_grid), dim3(NWAVES * 64), kargs, LDS_BYTES, stream);
#else
    (void)kargs; hipLaunchKernelGGL(mk_fwd, dim3(mk_grid), dim3(NWAVES * 64), LDS_BYTES, stream, a); hipError_t e = hipPeekAtLastError();
#endif
    if (e != hipSuccess) fprintf(stderr, "megakernel launch failed: %s (grid %d)\n", hipGetErrorString(e), mk_grid);
}
extern "C" void kernel_launch(void* const* d_in, const int* in_sizes, int n_in, void* d_out, int out_size, void* d_ws, size_t ws_size, hipStream_t stream) {
    const float* x = (const float*)d_in[0]; const float* c = (const float*)d_in[1]; const int* pos = (const int*)d_in[2];
    const float* w_ada = (const float*)d_in[3]; const float* b_ada = (const float*)d_in[4]; const float* g_pre_mix = (const float*)d_in[5];
    const float* w_in = (const float*)d_in[6]; const float* g_q = (const float*)d_in[7]; const float* w_q_up = (const float*)d_in[8];
    const float* g_kv = (const float*)d_in[9]; const float* w_kv_up = (const float*)d_in[10]; const float* w_gate = (const float*)d_in[11];
    const float* b_gate = (const float*)d_in[12]; const float* g_gla = (const float*)d_in[13]; const float* w_a = (const float*)d_in[14];
    const float* w_b = (const float*)d_in[15]; const float* w_mix = (const float*)d_in[16]; const float* g_post_mix = (const float*)d_in[17];
    const float* g_pre_ffn = (const float*)d_in[18]; const float* w_up = (const float*)d_in[19]; const float* conv_w = (const float*)d_in[20];
    const float* conv_b = (const float*)d_in[21]; const float* w_dn = (const float*)d_in[22]; const float* g_post_ffn = (const float*)d_in[23];
    float* out = (float*)d_out; char* ws = (char*)d_ws;
    if (ws_size < 420 * MiB) { fprintf(stderr, "ws too small: %zu\n", ws_size); return; }
    float* mod = (float*)(ws + WS_MOD); float* rstd = (float*)(ws + WS_RSTD); float2* cs = (float2*)(ws + WS_CS);
    bf16_t* h = (bf16_t*)(ws + WS_H); bf16_t* zA = (bf16_t*)(ws + WS_ZA); bf16_t* z = (bf16_t*)(ws + WS_ZB);   bf16_t* Q = (bf16_t*)(ws + WS_Q); bf16_t* Kf = (bf16_t*)(ws + WS_K); bf16_t* V = (bf16_t*)(ws + WS_V);
    bf16_t* om = (bf16_t*)(ws + WS_OM); bf16_t* og = (bf16_t*)(ws + WS_OG); bf16_t* t1 = (bf16_t*)(ws + WS_T1); bf16_t* merged = (bf16_t*)(ws + WS_MERGED);
    bf16_t* y = (bf16_t*)(ws + WS_Y); bf16_t* h2 = (bf16_t*)(ws + WS_H); bf16_t* act = (bf16_t*)(ws + WS_ACT_N); bf16_t* uq = (bf16_t*)(ws + WS_UQ); bf16_t* f = (bf16_t*)(ws + WS_F);
    int pend_lo = -1, pend_hi = -1;
#define FLUSH() do { if (pend_lo >= 0) { launch_mk(d_in, out, d_ws, pend_lo, pend_hi, stream); pend_lo = -1; } } while (0)
#ifndef MK_SPLIT
#define MK_SPLIT 0
#endif
#define PHASE(p, ...) do { if ((OPT_MASK >> (p)) & 1u) { if (pend_lo >= 0 && (pend_hi != (p) || MK_SPLIT)) FLUSH(); if (pend_lo < 0) pend_lo = (p); pend_hi = (p) + 1; } else { FLUSH(); __VA_ARGS__ } } while (0)
    PHASE(0, { n_mod<<<12288 / 256, 256, 0, stream>>>(c, w_ada, b_ada, mod);
        n_cs<<<MTOK * 32 / 256, 256, 0, stream>>>(pos, cs); });
    PHASE(1, { n_normmod<<<MTOK, 256, 0, stream>>>(x, g_pre_mix, mod, 0, 2048, h); });
    PHASE(2, { n_gemm<EpiStore><<<dim3((DIN + 63) / 64, MTOK / 64), 256, 0, stream>>>(h, DM, w_in, DIN, nullptr, 0, MTOK, DIN, DM, EpiStore{z, ZB_LD, 0});   });
    PHASE(3, { n_latrstd<<<MTOK / 4, 256, 0, stream>>>(z, rstd);
        n_gemm<EpiQ><<<dim3(1536 / 64, MTOK / 64), 256, 0, stream>>>(z + OFF_QLAT, ZB_LD, w_q_up, 1536, g_q, 0, MTOK, 1536, 512, EpiQ{Q, rstd});
        n_rope_q<<<MTOK, 256, 0, stream>>>(Q, cs);
        n_gemm<EpiKV><<<dim3(2048 / 64, MTOK / 64), 256, 0, stream>>>(z + OFF_KVLAT, ZB_LD, w_kv_up, 2048, g_kv, 0, MTOK, 2048, 256, EpiKV{Kf, V, rstd});
        n_rope_k<<<MTOK * 32 / 256, 256, 0, stream>>>(z, Kf, cs); });
    PHASE(4, {  });
    PHASE(5, { n_attn<<<NB * 8 * SEQ, 256, 0, stream>>>(Q, Kf, V, om); });
    PHASE(6, { n_gla<<<64, 256, 0, stream>>>(z, w_gate, b_gate, og); });
#if DBG_SCAN
    FLUSH(); n_gla<<<64, 256, 0, stream>>>(z, w_gate, b_gate, og);
    (void)hipMemsetAsync(ws + WS_MOD + 256 * 1024, 0, 64, stream);
    { unsigned* res = (unsigned*)(ws + WS_MOD + 256 * 1024);
      n_countnf<<<1024, 256, 0, stream>>>(ws + 32 * MiB, (size_t)MTOK * 1024, 0, res + 0);
      n_countnf<<<1024, 256, 0, stream>>>(ws + 48 * MiB, (size_t)MTOK * 1024, 0, res + 1);
      n_countnf<<<1024, 256, 0, stream>>>(ws + 64 * MiB, (size_t)512 * 4096, 0, res + 2);
      n_countnf<<<1024, 256, 0, stream>>>(ws + 68 * MiB, (size_t)512 * 256, 1, res + 3);
      n_countnf<<<1024, 256, 0, stream>>>(ws + 252 * MiB, (size_t)MTOK * 2048, 0, res + 4); }
#endif
    PHASE(7, { n_glanorm<<<MTOK, 256, 0, stream>>>(og, zA, g_gla); });
    PHASE(8, { n_gemm<EpiGate><<<dim3(DM / 64, MTOK / 64), 256, 0, stream>>>(om, 1024, w_a, DM, nullptr, 0, MTOK, DM, 1024, EpiGate{t1, zA, OFF_GA, nullptr});
        n_gemm<EpiGate><<<dim3(DM / 64, MTOK / 64), 256, 0, stream>>>(og, DM, w_b, DM, nullptr, 0, MTOK, DM, DM, EpiGate{merged, zA, OFF_GB, t1}); });
    PHASE(9, { n_gemm<EpiStore><<<dim3(DM / 64, MTOK / 64), 256, 0, stream>>>(merged, DM, w_mix, DM, nullptr, 0, MTOK, DM, DM, EpiStore{y, DM, 0}); });
    PHASE(10, { n_resnorm<<<MTOK, 256, 0, stream>>>(x, y, g_post_mix, mod, 4096, out, g_pre_ffn, 6144, 8192, h2); });
    PHASE(11, {  });
    PHASE(12, { for (int q = 0; q < 4; ++q) { const int q0 = q * 2048, r0 = (q0 % SEQ == 0) ? q0 : q0 - 2, r1 = q0 + 2048;
            n_gemm<EpiStore><<<dim3(DFF2 / 64, (r1 - r0 + 63) / 64), 256, 0, stream>>>(h2, DM, w_up, DFF2, nullptr, r0, r1, DFF2, DM, EpiStore{uq, DFF2, r0});
            n_convact<<<dim3(DFF / 256, 2048), 256, 0, stream>>>(uq, r0, q0, conv_w, conv_b, act); } });
    PHASE(13, {  });
    PHASE(14, { n_gemm<EpiStore><<<dim3(DM / 64, MTOK / 64), 256, 0, stream>>>(act, DFF, w_dn, DM, nullptr, 0, MTOK, DM, DFF, EpiStore{f, DM, 0}); });
    PHASE(15, { n_resnorm<<<MTOK, 256, 0, stream>>>(out, f, g_post_ffn, mod, 10240, out, nullptr, 0, 0, nullptr); });
    FLUSH();
#if DBG_SCAN
    n_scale_bits<<<1024, 256, 0, stream>>>(out, (size_t)MTOK * DM, (const unsigned*)(ws + WS_MOD + 256 * 1024), 5);
#endif
}
```
